# Optimizing an MI355X kernel written in HIP

```python
import jax, jax.numpy as jnp
from jax import lax
import numpy as np

D_MODEL = 1024
BATCH = 16
SEQ = 2048
DEPTH = 1

CONV_WIDTH = D_MODEL // 2
CONV_K = 3
NSA_HEADS = 8
NSA_KV_GROUPS = 2
NSA_HEAD_DIM = 64
NSA_Q_WIDTH = NSA_HEADS * NSA_HEAD_DIM
NSA_KV_WIDTH = NSA_KV_GROUPS * NSA_HEAD_DIM
MIX_WIDTH = CONV_WIDTH + NSA_Q_WIDTH
N_BRANCH = 3
CMP_BLOCK = 32
CMP_STRIDE = 16
SEL_BLOCK = 64
SEL_TOPN = 16
WINDOW = 512
Q_BLOCK = 64
SPLIT_SIZES = (CONV_WIDTH, CONV_WIDTH, CONV_WIDTH, NSA_Q_WIDTH,
               N_BRANCH * 2 * NSA_KV_WIDTH, N_BRANCH * NSA_HEADS)
IN_COLS = sum(SPLIT_SIZES)

MEM_TOKENS = 256
X_HEADS = 4
X_HEAD_DIM = D_MODEL // X_HEADS

PEER_HEADS = 8
PEER_NKEYS = 128
PEER_EXPERTS = PEER_NKEYS * PEER_NKEYS
PEER_QDIM = 256
PEER_TOPK = 16
PEER_TOKEN_CHUNK = 128

EPS = 1e-6

kernel_name = "hymba_conv_nsa_peer_layer"


def rms_norm(x, w):
    xf = x.astype(jnp.float32)
    y = xf * lax.rsqrt(jnp.mean(xf * xf, axis=-1, keepdims=True) + EPS)
    return (y * w.astype(jnp.float32)).astype(x.dtype)


def masked_softmax(s, mask):
    s = jnp.where(mask, s.astype(jnp.float32), -jnp.inf)
    m = jnp.max(s, axis=-1, keepdims=True)
    m = jnp.where(jnp.isfinite(m), m, 0.0)
    e = jnp.exp(s - m)
    d = jnp.sum(e, axis=-1, keepdims=True)
    return e / jnp.where(d > 0, d, 1.0)


def short_conv_mixer(b_gate, c_gate, h, conv_w, conv_b):
    u = c_gate * h
    y = lax.conv_general_dilated(u, conv_w[:, None, :], window_strides=(1,),
                                 padding=((CONV_K - 1, 0),),
                                 dimension_numbers=('NWC', 'WIO', 'NWC'),
                                 feature_group_count=CONV_WIDTH)
    return b_gate * (y + conv_b)


def compress_blocks(t, pe, w1, w2):
    B, S, G, dh = t.shape
    n_cmp = (S - CMP_BLOCK) // CMP_STRIDE + 1
    idx = np.arange(n_cmp)[:, None] * CMP_STRIDE + np.arange(CMP_BLOCK)[None, :]
    blk = t[:, idx] + pe[None, None, :, None, :]
    blk = jnp.moveaxis(blk, 3, 2).reshape(B, n_cmp, G, CMP_BLOCK * dh)
    hid = jax.nn.gelu(blk @ w1, approximate=False)
    return hid @ w2


def nsa_mixer(q, kv, gates, cmp_pe, cmp_w1, cmp_w2, q_norm_w, k_norm_w):
    B, S = q.shape[0], q.shape[1]
    G, R, dh = NSA_KV_GROUPS, NSA_HEADS // NSA_KV_GROUPS, NSA_HEAD_DIM
    n_sel = S // SEL_BLOCK
    n_top = min(SEL_TOPN, n_sel)
    n_qb = S // Q_BLOCK
    q = rms_norm(q.reshape(B, S, G, R, dh), q_norm_w) * dh ** -0.5
    gates = gates.reshape(B, S, G, R, N_BRANCH)
    k_c, v_c, k_s, v_s, k_w, v_w = [t.reshape(B, S, G, dh)
                                    for t in jnp.split(kv, 2 * N_BRANCH, axis=-1)]
    k_cmp = rms_norm(compress_blocks(k_c, cmp_pe[0], cmp_w1[0], cmp_w2[0]), k_norm_w[0])
    v_cmp = compress_blocks(v_c, cmp_pe[1], cmp_w1[1], cmp_w2[1])
    n_cmp = k_cmp.shape[1]
    cmp_start = np.arange(n_cmp) * CMP_STRIDE
    cmp_last = cmp_start + CMP_BLOCK - 1
    sel_start = np.arange(n_sel) * SEL_BLOCK
    sel_map = jnp.asarray(((cmp_start[:, None] < sel_start[None, :] + SEL_BLOCK) &
                           (cmp_start[:, None] + CMP_BLOCK > sel_start[None, :])).astype(np.float32))
    to_blocks = lambda t: t.reshape(B, n_sel, SEL_BLOCK, G, dh).transpose(0, 3, 1, 2, 4)
    k_sb = to_blocks(rms_norm(k_s, k_norm_w[1]))
    v_sb = to_blocks(v_s)
    pad = ((0, 0), (WINDOW, 0), (0, 0), (0, 0))
    k_wp = jnp.pad(rms_norm(k_w, k_norm_w[2]), pad)
    v_wp = jnp.pad(v_w, pad)
    bi = jnp.arange(B)[:, None, None, None]
    gi = jnp.arange(G)[None, :, None, None]
    blk_ids = jnp.arange(n_sel)

    def query_block(i):
        t0 = i * Q_BLOCK
        tq = t0 + jnp.arange(Q_BLOCK)
        qb = lax.dynamic_slice_in_dim(q, t0, Q_BLOCK, axis=1)
        gb = lax.dynamic_slice_in_dim(gates, t0, Q_BLOCK, axis=1)
        s_c = jnp.einsum('bqgrd,bngd->bgrqn', qb, k_cmp)
        p_c = masked_softmax(s_c, cmp_last[None, :] <= tq[:, None])
        o_c = jnp.einsum('bgrqn,bngd->bqgrd', p_c.astype(v_cmp.dtype), v_cmp)
        imp = jnp.einsum('bgrqn,nj->bgqj', p_c, sel_map)
        cur = (tq // SEL_BLOCK)[:, None]
        future = blk_ids[None, :] > cur
        forced = (blk_ids[None, :] == 0) | (blk_ids[None, :] == cur) | (blk_ids[None, :] == cur - 1)
        imp = jnp.where(future, -jnp.inf, jnp.where(forced, jnp.inf, imp))
        _, sel = lax.top_k(imp, n_top)
        ks = k_sb[bi, gi, sel]
        vs = v_sb[bi, gi, sel]
        s_s = jnp.einsum('bqgrd,bgqkld->bgrqkl', qb, ks).reshape(B, G, R, Q_BLOCK, n_top * SEL_BLOCK)
        pos = sel[..., None] * SEL_BLOCK + jnp.arange(SEL_BLOCK)
        m_s = (pos <= tq[None, None, :, None, None]).reshape(B, G, 1, Q_BLOCK, n_top * SEL_BLOCK)
        p_s = masked_softmax(s_s, m_s).reshape(B, G, R, Q_BLOCK, n_top, SEL_BLOCK)
        o_s = jnp.einsum('bgrqkl,bgqkld->bqgrd', p_s.astype(vs.dtype), vs)
        kw = lax.dynamic_slice_in_dim(k_wp, t0, WINDOW + Q_BLOCK, axis=1)
        vw = lax.dynamic_slice_in_dim(v_wp, t0, WINDOW + Q_BLOCK, axis=1)
        sk = t0 - WINDOW + jnp.arange(WINDOW + Q_BLOCK)
        diff = tq[:, None] - sk[None, :]
        m_w = (sk[None, :] >= 0) & (diff >= 0) & (diff < WINDOW)
        s_w = jnp.einsum('bqgrd,bkgd->bgrqk', qb, kw)
        p_w = masked_softmax(s_w, m_w)
        o_w = jnp.einsum('bgrqk,bkgd->bqgrd', p_w.astype(vw.dtype), vw)
        return o_c * gb[..., 0:1] + o_s * gb[..., 1:2] + o_w * gb[..., 2:3]

    out = lax.map(query_block, jnp.arange(n_qb))
    return out.transpose(1, 0, 2, 3, 4, 5).reshape(B, S, NSA_Q_WIDTH)


def memory_cross_attention(h, mem, mem_norm_w, wq, wk, wv, wo, q_norm_w, k_norm_w):
    B, S, D = h.shape
    M = mem.shape[1]
    q = rms_norm((h @ wq).reshape(B, S, X_HEADS, X_HEAD_DIM), q_norm_w) * X_HEAD_DIM ** -0.5
    mn = rms_norm(mem, mem_norm_w)
    k = rms_norm((mn @ wk).reshape(B, M, X_HEADS, X_HEAD_DIM), k_norm_w)
    v = (mn @ wv).reshape(B, M, X_HEADS, X_HEAD_DIM)
    s = jnp.einsum('bshd,bmhd->bhsm', q, k).astype(jnp.float32)
    p = jax.nn.softmax(s, axis=-1).astype(v.dtype)
    o = jnp.einsum('bhsm,bmhd->bshd', p, v).reshape(B, S, D)
    return o @ wo


def peer_ffn(h, wq, keys, w_down, w_up):
    B, S, D = h.shape
    K = PEER_TOPK
    q = (h @ wq).reshape(B, S, PEER_HEADS, 2, PEER_QDIM // 2)
    sc = jnp.einsum('bshcd,hcnd->bshcn', q, keys).astype(jnp.float32)
    top_s, top_i = lax.top_k(sc, K)
    cand_s = (top_s[..., 0, :, None] + top_s[..., 1, None, :]).reshape(B, S, PEER_HEADS, K * K)
    cand_i = (top_i[..., 0, :, None] * PEER_NKEYS + top_i[..., 1, None, :]).reshape(B, S, PEER_HEADS, K * K)
    best_s, best_j = lax.top_k(cand_s, K)
    experts = jnp.take_along_axis(cand_i, best_j, axis=-1)
    gates = jax.nn.softmax(best_s, axis=-1).astype(h.dtype)
    n_chunks = (B * S) // PEER_TOKEN_CHUNK
    hc = h.reshape(n_chunks, PEER_TOKEN_CHUNK, D)
    ec = experts.reshape(n_chunks, PEER_TOKEN_CHUNK, PEER_HEADS, K)
    gc = gates.reshape(n_chunks, PEER_TOKEN_CHUNK, PEER_HEADS, K)

    def chunk(args):
        xt, e, g = args
        u = w_down[e]
        a = jax.nn.gelu(jnp.einsum('td,thkd->thk', xt, u), approximate=False)
        v = w_up[e]
        return jnp.einsum('thk,thkd->td', g * a, v)

    return lax.map(chunk, (hc, ec, gc)).reshape(B, S, D)


def setup_inputs(seed: int = 0) -> dict:
    key = jax.random.key(seed)
    ks = jax.random.split(key, 28)
    L, D = DEPTH, D_MODEL
    nrm = lambda k, shape, scale: jax.random.normal(k, shape, jnp.float32) * scale
    gain = lambda k, shape: 1.0 + 0.01 * jax.random.normal(k, shape, jnp.float32)
    return {
        "x": nrm(ks[0], (BATCH, SEQ, D), 1.0),
        "mem": nrm(ks[1], (BATCH, MEM_TOKENS, D), 1.0),
        "mix_norm_w": gain(ks[2], (L, D)),
        "w_in": nrm(ks[3], (L, D, IN_COLS), D ** -0.5),
        "conv_w": nrm(ks[4], (L, CONV_K, CONV_WIDTH), CONV_K ** -0.5),
        "conv_b": nrm(ks[5], (L, CONV_WIDTH), 0.01),
        "cmp_pe": nrm(ks[6], (L, 2, CMP_BLOCK, NSA_HEAD_DIM), 0.1),
        "cmp_w1": nrm(ks[7], (L, 2, CMP_BLOCK * NSA_HEAD_DIM, NSA_HEAD_DIM), (CMP_BLOCK * NSA_HEAD_DIM) ** -0.5),
        "cmp_w2": nrm(ks[8], (L, 2, NSA_HEAD_DIM, NSA_HEAD_DIM), NSA_HEAD_DIM ** -0.5),
        "q_norm_w": gain(ks[9], (L, NSA_HEAD_DIM)),
        "k_norm_w": gain(ks[10], (L, N_BRANCH, NSA_HEAD_DIM)),
        "w_out": nrm(ks[11], (L, MIX_WIDTH, D), MIX_WIDTH ** -0.5),
        "xattn_norm_w": gain(ks[12], (L, D)),
        "mem_norm_w": gain(ks[13], (L, D)),
        "xq": nrm(ks[14], (L, D, D), D ** -0.5),
        "xk": nrm(ks[15], (L, D, D), D ** -0.5),
        "xv": nrm(ks[16], (L, D, D), D ** -0.5),
        "xo": nrm(ks[17], (L, D, D), D ** -0.5),
        "xq_norm_w": gain(ks[18], (L, X_HEAD_DIM)),
        "xk_norm_w": gain(ks[19], (L, X_HEAD_DIM)),
        "ffn_norm_w": gain(ks[20], (L, D)),
        "peer_wq": nrm(ks[21], (L, D, PEER_HEADS * PEER_QDIM), D ** -0.5),
        "peer_keys": nrm(ks[22], (L, PEER_HEADS, 2, PEER_NKEYS, PEER_QDIM // 2), (PEER_QDIM // 2) ** -0.5),
        "peer_down": nrm(ks[23], (L, PEER_EXPERTS, D), D ** -0.5),
        "peer_up": nrm(ks[24], (L, PEER_EXPERTS, D), PEER_HEADS ** -0.5),
    }


def reference(x, mem, mix_norm_w, w_in, conv_w, conv_b, cmp_pe, cmp_w1, cmp_w2, q_norm_w, k_norm_w,
              w_out, xattn_norm_w, mem_norm_w, xq, xk, xv, xo, xq_norm_w, xk_norm_w,
              ffn_norm_w, peer_wq, peer_keys, peer_down, peer_up):
    offsets = np.cumsum(SPLIT_SIZES)[:-1].tolist()
    for l in range(DEPTH):
        hn = rms_norm(x, mix_norm_w[l])
        b_g, c_g, h_c, q, kv, g_lin = jnp.split(hn @ w_in[l], offsets, axis=-1)
        y_conv = short_conv_mixer(b_g, c_g, h_c, conv_w[l], conv_b[l])
        y_nsa = nsa_mixer(q, kv, jax.nn.sigmoid(g_lin), cmp_pe[l], cmp_w1[l], cmp_w2[l],
                          q_norm_w[l], k_norm_w[l])
        x = x + jnp.concatenate([y_conv, y_nsa], axis=-1) @ w_out[l]
        x = x + memory_cross_attention(rms_norm(x, xattn_norm_w[l]), mem, mem_norm_w[l],
                                       xq[l], xk[l], xv[l], xo[l], xq_norm_w[l], xk_norm_w[l])
        x = x + peer_ffn(rms_norm(x, ffn_norm_w[l]), peer_wq[l], peer_keys[l], peer_down[l], peer_up[l])
    return x
```

```cpp
#include <hip/hip_runtime.h>
#include <cstdio>
#include <cstdint>
#include <cmath>
namespace pg8 {
#define PG8_LAS __attribute__((address_space(3)))
typedef unsigned short bf16_t;
typedef short bf16x8 __attribute__((ext_vector_type(8)));
typedef float f32x4 __attribute__((ext_vector_type(4)));
typedef unsigned u32x4 __attribute__((ext_vector_type(4)));
constexpr int BM = 256, BK = 64, HALF = 128, HTB = HALF * BK * 2  , STAGE_BYTES = 8 * HTB, NXCD = 8, WGM = 8;

__host__ __device__ __forceinline__ int lds_byte(int r, int c) { const int st = (r >> 4) * 2 + (c >> 5), rr = r & 15, cc = c & 31, ob = rr * 64 + cc * 2; return st * 1024 + (ob ^ (((ob >> 9) & 1) << 5)); }
__host__ __device__ __forceinline__ void stage_rc(int b, int& R, int& C) { const int st = b / 1024, sb = b % 1024, swz = sb ^ (((sb >> 9) & 1) << 5); R = (st >> 1) * 16 + swz / 64; C = (st & 1) * 32 + (swz % 64) / 2; }
__host__ __device__ __forceinline__ int perm32(int rho) { const int n = rho >> 4, i = rho & 15; return 8 * (i >> 2) + 4 * n + (i & 3); }

struct Unit { int pm, pn; };
struct Gemm { const bf16_t* A; const bf16_t* Bt; int M, N, K; };

struct StaticOrder {
    int nM, nN, nwg, G, c;
    __host__ __device__ void init(int M, int N, int G_, int c_) { nM = M / BM; nN = N / BM; nwg = nM * nN; G = G_; c = c_; }
    __host__ __device__ bool next(int i, Unit& u) const {
        const long L = (long)i * G + c; if (L >= nwg) return false;
        int wgid = (int)L; { const int q = nwg / NXCD, r = nwg % NXCD, xcd = wgid % NXCD, off = wgid / NXCD; wgid = (xcd < r ? xcd * (q + 1) : r * (q + 1) + (xcd - r) * q) + off; }
        const int nig = WGM * nN, gid = wgid / nig, fm = gid * WGM, gsz = (nM - fm) < WGM ? (nM - fm) : WGM;
        u.pm = fm + ((wgid % nig) % gsz); u.pn = (wgid % nig) / gsz; return true;
    }
    __device__ __forceinline__ void a_ready(const Unit&) const {}
    __device__ __forceinline__ void done(const Unit&) const {}
};

__device__ __forceinline__ unsigned cvt_pk_bf16(float lo, float hi) { unsigned r; asm volatile("v_cvt_pk_bf16_f32 %0, %1, %2" : "=v"(r) : "v"(lo), "v"(hi)); return r; }
typedef float f32x2 __attribute__((ext_vector_type(2)));
__device__ __forceinline__ f32x2 gelu_pk(f32x2 v) {
    const f32x2 av = __builtin_elementwise_abs(v), d = av * 0.2316418882f + 1.0f;
    f32x2 t; t.x = __builtin_amdgcn_rcpf(d.x); t.y = __builtin_amdgcn_rcpf(d.y);
    f32x2 q = t * 0.5307027145f + (-0.7265760135f); q = q * t + 0.7107068705f; q = q * t + (-0.142248368f); q = q * t + 0.127414796f; q = q * t;
    const f32x2 s = (v * v) * (-0.72134752044f);
    f32x2 e; e.x = __builtin_amdgcn_exp2f(s.x); e.y = __builtin_amdgcn_exp2f(s.y);
    const f32x2 m = v * (q * e), r = v - m;
    f32x2 o; o.x = v.x < 0.f ? m.x : r.x; o.y = v.y < 0.f ? m.y : r.y; return o;
}

template <int ACT  > struct EpiBf16 {
    static constexpr bool PERM = true, AFTER_DRAIN = false; static_assert(ACT == 0 || ACT == 1, "EpiBf16: ACT is 0 (none) or 1 (gelu_pk)");
    bf16_t* O; int ldc; const float* bias; int split_cols; size_t split_stride; float scale0;
    __device__ __forceinline__ void operator()(const f32x4 (&acc)[2][2][4][2], const Unit& u, int wr, int wc, int fr, int fq) const {
        const int row0 = u.pm * BM + wr * 64 + fr; int colt = u.pn * BM; bf16_t* base = O;
        float sc = 1.f; if (split_cols) { const int t = colt / split_cols; base += (size_t)t * split_stride; colt -= t * split_cols; if (t == 0) sc = scale0; }
        const int col0 = colt + wc * 32 + 8 * fq, bcol0 = u.pn * BM + wc * 32 + 8 * fq;
        f32x4 bv[2][2];
#pragma unroll
        for (int bj = 0; bj < 2; ++bj)
#pragma unroll
            for (int n = 0; n < 2; ++n) bv[bj][n] = bias ? *(const f32x4*)(bias + bcol0 + bj * HALF + 4 * n) : (f32x4){0.f, 0.f, 0.f, 0.f};
#pragma unroll
        for (int ai = 0; ai < 2; ++ai)
#pragma unroll
            for (int m = 0; m < 4; ++m) { bf16_t* rowp = base + (size_t)(row0 + ai * HALF + m * 16) * ldc + col0;
#pragma unroll
                for (int bj = 0; bj < 2; ++bj) { f32x4 v0 = acc[ai][bj][m][0] + bv[bj][0], v1 = acc[ai][bj][m][1] + bv[bj][1];
                    if (ACT == 1) { f32x2 a = gelu_pk((f32x2){v0[0], v0[1]}), b = gelu_pk((f32x2){v0[2], v0[3]}), c = gelu_pk((f32x2){v1[0], v1[1]}), d = gelu_pk((f32x2){v1[2], v1[3]});
                        v0 = (f32x4){a.x, a.y, b.x, b.y}; v1 = (f32x4){c.x, c.y, d.x, d.y}; }
                    v0 = v0 * sc; v1 = v1 * sc; u32x4 w; w.x = cvt_pk_bf16(v0[0], v0[1]); w.y = cvt_pk_bf16(v0[2], v0[3]); w.z = cvt_pk_bf16(v1[0], v1[1]); w.w = cvt_pk_bf16(v1[2], v1[3]);
                    *(u32x4*)(rowp + bj * HALF) = w; } }
    }
};

struct EpiResF32 {
    static constexpr bool PERM = false, AFTER_DRAIN = false;
    const float* base; float* out; int ldc;
    __device__ __forceinline__ void operator()(const f32x4 (&acc)[2][2][4][2], const Unit& u, int wr, int wc, int fr, int fq) const {
        const int row0 = u.pm * BM + wr * 64 + fr, col0 = u.pn * BM + wc * 32 + 4 * fq;
#pragma unroll
        for (int ai = 0; ai < 2; ++ai)
#pragma unroll
            for (int m = 0; m < 4; ++m) { const size_t off = (size_t)(row0 + ai * HALF + m * 16) * ldc + col0;
#pragma unroll
                for (int bj = 0; bj < 2; ++bj)
#pragma unroll
                    for (int n = 0; n < 2; ++n) { const f32x4 b = *(const f32x4*)(base + off + bj * HALF + n * 16); *(f32x4*)(out + off + bj * HALF + n * 16) = b + acc[ai][bj][m][n]; } }
    }
};
template <bool BASE_BF16> struct EpiResBf16N {
    static constexpr bool PERM = false, AFTER_DRAIN = false;
    const void* base; bf16_t* xn; float* ssp; int ldc;
    __device__ __forceinline__ void operator()(const f32x4 (&acc)[2][2][4][2], const Unit& u, int wr, int wc, int fr, int fq) const {
        typedef unsigned u32x2 __attribute__((ext_vector_type(2)));
        const int row0 = u.pm * BM + wr * 64 + fr, col0 = u.pn * BM + wc * 32 + 4 * fq;
#pragma unroll
        for (int ai = 0; ai < 2; ++ai)
#pragma unroll
            for (int m = 0; m < 4; ++m) { const int row = row0 + ai * HALF + m * 16; const size_t off = (size_t)row * ldc + col0; float ss = 0.f;
#pragma unroll
                for (int bj = 0; bj < 2; ++bj)
#pragma unroll
                    for (int n = 0; n < 2; ++n) { f32x4 b;
                        if (BASE_BF16) { const u32x2 r = *(const u32x2*)((const bf16_t*)base + off + bj * HALF + n * 16);
                            b = (f32x4){__uint_as_float(r.x << 16), __uint_as_float(r.x & 0xffff0000u), __uint_as_float(r.y << 16), __uint_as_float(r.y & 0xffff0000u)}; }
                        else b = *(const f32x4*)((const float*)base + off + bj * HALF + n * 16);
                        const f32x4 v = b + acc[ai][bj][m][n];
                        ss += (v[0] * v[0] + v[1] * v[1]) + (v[2] * v[2] + v[3] * v[3]);
                        u32x2 w; w.x = cvt_pk_bf16(v[0], v[1]); w.y = cvt_pk_bf16(v[2], v[3]); *(u32x2*)(xn + off + bj * HALF + n * 16) = w; }
                ss += __shfl_xor(ss, 16); ss += __shfl_xor(ss, 32);
                if (fq == 0) ssp[(size_t)row * 16 + u.pn * 4 + wc] = ss; }
    }
};
struct EpiI8Bf16 {
    static constexpr bool PERM = true, AFTER_DRAIN = false;
    bf16_t* O; int ldc; const float* sa; const float* sb;
    __device__ __forceinline__ void operator()(const f32x4 (&acc)[2][2][4][2], const Unit& u, int wr, int wc, int fr, int fq) const {
        typedef int i32x4 __attribute__((ext_vector_type(4)));
        const int row0 = u.pm * BM + wr * 64 + fr, col0 = u.pn * BM + wc * 32 + 8 * fq;
        f32x4 sbv[2][2];
#pragma unroll
        for (int bj = 0; bj < 2; ++bj)
#pragma unroll
            for (int n = 0; n < 2; ++n) sbv[bj][n] = *(const f32x4*)(sb + col0 + bj * HALF + 4 * n);
#pragma unroll
        for (int ai = 0; ai < 2; ++ai)
#pragma unroll
            for (int m = 0; m < 4; ++m) { const int row = row0 + ai * HALF + m * 16; const float sr = sa[row]; bf16_t* rowp = O + (size_t)row * ldc + col0;
#pragma unroll
                for (int bj = 0; bj < 2; ++bj) {
                    const f32x4 v0 = __builtin_convertvector(__builtin_bit_cast(i32x4, acc[ai][bj][m][0]), f32x4) * sr * sbv[bj][0];
                    const f32x4 v1 = __builtin_convertvector(__builtin_bit_cast(i32x4, acc[ai][bj][m][1]), f32x4) * sr * sbv[bj][1];
                    u32x4 w; w.x = cvt_pk_bf16(v0[0], v0[1]); w.y = cvt_pk_bf16(v0[2], v0[3]); w.z = cvt_pk_bf16(v1[0], v1[1]); w.w = cvt_pk_bf16(v1[2], v1[3]);
                    *(u32x4*)(rowp + bj * HALF) = w; } }
    }
};

template <class Epi, class Sched, bool ALIGN_EPI = false, bool SP2 = false, bool I8 = false>
__device__ __forceinline__ void gemm_phase(PG8_LAS unsigned char* lds, const Gemm g, const Sched& S, const Epi& E) {
    const int tid = threadIdx.x, wid = __builtin_amdgcn_readfirstlane(tid >> 6), lane = tid & 63, wr = wid >> 2, wc = wid & 3, fr = lane & 15, fq = lane >> 4;
    const int K = g.K, nt = K / BK;
    unsigned voffA[2], voffB[2];
#pragma unroll
    for (int i = 0; i < 2; ++i) { int R, C; stage_rc(tid * 16 + i * 8192, R, C); const int Rb = Epi::PERM ? ((R & ~31) + perm32(R & 31)) : R;
        voffA[i] = (unsigned)(R * K + C) * 2u; voffB[i] = (unsigned)(Rb * K + C) * 2u; }
    const size_t kstep = (size_t)(BK * 2);
    const size_t hstep = (size_t)HALF * K * 2;
    const size_t tstep = 2 * hstep;
    const unsigned ldsw = (unsigned)wid * 1024u;
    const int aoff = lds_byte(wr * 64 + fr, fq * 8), boff = lds_byte(wc * 32 + fr, fq * 8);
    typedef int i32x4 __attribute__((ext_vector_type(4)));
    auto mma16 = [](const bf16x8& b, const bf16x8& a, const f32x4& c) __attribute__((always_inline)) -> f32x4 {
        if constexpr (I8) return __builtin_bit_cast(f32x4, __builtin_amdgcn_mfma_i32_16x16x64_i8(__builtin_bit_cast(i32x4, b), __builtin_bit_cast(i32x4, a), __builtin_bit_cast(i32x4, c), 0, 0, 0));
        else return __builtin_amdgcn_mfma_f32_16x16x32_bf16(b, a, c, 0, 0, 0);
    };
#define PG8_SA(b, h) (((b) * 2 + (h)) * HTB)
#define PG8_SB(b, h) ((4 + (b) * 2 + (h)) * HTB)
#define PG8_STAGE(bufoff, gbase, voff) do { _Pragma("unroll") for (int _i = 0; _i < 2; ++_i) \
        __builtin_amdgcn_global_load_lds((const unsigned*)((const char*)(gbase) + (voff)[_i]), (PG8_LAS unsigned*)(lds + (bufoff) + ldsw + _i * 8192), 16, 0, 0); } while (0)
#define PG8_LDA(dst, b, h) do { _Pragma("unroll") for (int m = 0; m < 4; ++m) _Pragma("unroll") for (int k = 0; k < 2; ++k) dst[m][k] = *(const PG8_LAS bf16x8*)(lds + PG8_SA(b, h) + aoff + m * 2048 + k * 1024); } while (0)
#define PG8_LDB(dst, b, h) do { _Pragma("unroll") for (int n = 0; n < 2; ++n) _Pragma("unroll") for (int k = 0; k < 2; ++k) dst[n][k] = *(const PG8_LAS bf16x8*)(lds + PG8_SB(b, h) + boff + n * 2048 + k * 1024); } while (0)
#define PG8_MMA(ai, bj, At, Bt) do { __builtin_amdgcn_s_setprio(1); _Pragma("unroll") for (int m = 0; m < 4; ++m) _Pragma("unroll") for (int n = 0; n < 2; ++n) _Pragma("unroll") for (int k = 0; k < 2; ++k) \
        acc[ai][bj][m][n] = mma16(Bt[n][k], At[m][k], acc[ai][bj][m][n]); __builtin_amdgcn_s_setprio(0); } while (0)
#define PG8_WAIT_V(n) asm volatile("s_waitcnt vmcnt(" #n ")" ::: "memory")
#define PG8_WAIT_L(n) asm volatile("s_waitcnt lgkmcnt(" #n ")" ::: "memory")
#define PG8_BAR __builtin_amdgcn_s_barrier()
#define PG8_SCHED __builtin_amdgcn_sched_barrier(0)
    Unit cur, nxt; int ui = 0;
    if (!S.next(0, cur)) return;
    f32x4 acc[2][2][4][2];
#pragma unroll
    for (int a = 0; a < 2; ++a)
#pragma unroll
        for (int b = 0; b < 2; ++b)
#pragma unroll
            for (int m = 0; m < 4; ++m)
#pragma unroll
                for (int n = 0; n < 2; ++n) acc[a][b][m][n] = (f32x4){0.f, 0.f, 0.f, 0.f};
    bf16x8 At[4][2], B0[2][2], B1[2][2];
    const char* cA = (const char*)g.A + (size_t)cur.pm * tstep; const char* cB = (const char*)g.Bt + (size_t)cur.pn * tstep;
    S.a_ready(cur);
    if constexpr (SP2) {
        PG8_STAGE(PG8_SB(0, 0), cB, voffB); PG8_STAGE(PG8_SB(0, 1), cB + hstep, voffB); PG8_STAGE(PG8_SA(0, 0), cA, voffA); PG8_STAGE(PG8_SA(0, 1), cA + hstep, voffA);
        if (wr == 1) PG8_BAR;
        PG8_WAIT_V(2); PG8_BAR;
        PG8_STAGE(PG8_SB(1, 0), cB + kstep, voffB); PG8_STAGE(PG8_SA(1, 0), cA + kstep, voffA); PG8_STAGE(PG8_SB(1, 1), cB + hstep + kstep, voffB);
        PG8_WAIT_V(6); PG8_BAR;
    } else {
        PG8_STAGE(PG8_SB(0, 0), cB, voffB); PG8_STAGE(PG8_SA(0, 0), cA, voffA); PG8_STAGE(PG8_SB(0, 1), cB + hstep, voffB); PG8_STAGE(PG8_SA(0, 1), cA + hstep, voffA);
        if (wr == 1) PG8_BAR;
        PG8_WAIT_V(4); PG8_BAR;
        PG8_STAGE(PG8_SB(1, 0), cB + kstep, voffB); PG8_STAGE(PG8_SA(1, 0), cA + kstep, voffA); PG8_STAGE(PG8_SB(1, 1), cB + hstep + kstep, voffB);
        PG8_WAIT_V(6); PG8_BAR;
    }
    for (;;) {
        const bool has_next = S.next(ui + 1, nxt);
        const char* nA = has_next ? (const char*)g.A + (size_t)nxt.pm * tstep : cA; const char* nB = has_next ? (const char*)g.Bt + (size_t)nxt.pn * tstep : cB;
        for (int t = 0; t < nt; t += 2) {
            const bool last = (t == nt - 2);
            const char* a1 = cA + (size_t)(t + 1) * kstep;
            const char* a2 = last ? nA : cA + (size_t)(t + 2) * kstep; const char* b2 = last ? nB : cB + (size_t)(t + 2) * kstep;
            const char* a3 = a2 + kstep; const char* b3 = b2 + kstep;
            if (last && has_next) S.a_ready(nxt);
            if constexpr (SP2) {
            PG8_LDB(B0, 0, 0); PG8_LDB(B1, 0, 1); PG8_SCHED; PG8_LDA(At, 0, 0); PG8_STAGE(PG8_SA(1, 1), a1 + hstep, voffA);
            PG8_WAIT_V(8); PG8_WAIT_L(0); PG8_BAR; PG8_MMA(0, 0, At, B0); PG8_MMA(0, 1, At, B1); PG8_BAR; PG8_SCHED;
            PG8_LDA(At, 0, 1); PG8_STAGE(PG8_SB(0, 0), b2, voffB); PG8_STAGE(PG8_SB(0, 1), b2 + hstep, voffB); PG8_STAGE(PG8_SA(0, 0), a2, voffA);
            PG8_WAIT_V(8); PG8_WAIT_L(0); PG8_BAR; PG8_MMA(1, 0, At, B0); PG8_MMA(1, 1, At, B1); PG8_BAR; PG8_SCHED;
            PG8_LDB(B0, 1, 0); PG8_LDB(B1, 1, 1); PG8_SCHED; PG8_LDA(At, 1, 0); PG8_STAGE(PG8_SA(0, 1), a2 + hstep, voffA);
            PG8_WAIT_V(8); PG8_WAIT_L(0); PG8_BAR; PG8_MMA(0, 0, At, B0); PG8_MMA(0, 1, At, B1); PG8_BAR; PG8_SCHED;
            PG8_LDA(At, 1, 1); PG8_STAGE(PG8_SB(1, 0), b3, voffB); PG8_STAGE(PG8_SB(1, 1), b3 + hstep, voffB); PG8_STAGE(PG8_SA(1, 0), a3, voffA);
            PG8_WAIT_V(8); PG8_WAIT_L(0); PG8_BAR; PG8_MMA(1, 0, At, B0); PG8_MMA(1, 1, At, B1); PG8_BAR; PG8_SCHED;
            } else {
            PG8_LDB(B0, 0, 0); PG8_SCHED; PG8_LDA(At, 0, 0); PG8_STAGE(PG8_SA(1, 1), a1 + hstep, voffA);
            PG8_WAIT_L(8); PG8_BAR; PG8_WAIT_L(0); PG8_MMA(0, 0, At, B0); PG8_BAR; PG8_SCHED;
            PG8_LDB(B1, 0, 1); PG8_STAGE(PG8_SB(0, 0), b2, voffB);
            PG8_BAR; PG8_WAIT_L(0); PG8_MMA(0, 1, At, B1); PG8_BAR;
            PG8_LDA(At, 0, 1); PG8_STAGE(PG8_SA(0, 0), a2, voffA);
            PG8_BAR; PG8_WAIT_L(0); PG8_MMA(1, 0, At, B0); PG8_BAR; PG8_SCHED;
            PG8_STAGE(PG8_SB(0, 1), b2 + hstep, voffB);
            PG8_WAIT_V(6); PG8_BAR; PG8_MMA(1, 1, At, B1); PG8_BAR;
            PG8_LDB(B0, 1, 0); PG8_SCHED; PG8_LDA(At, 1, 0); PG8_STAGE(PG8_SA(0, 1), a2 + hstep, voffA);
            PG8_WAIT_L(8); PG8_BAR; PG8_WAIT_L(0); PG8_MMA(0, 0, At, B0); PG8_BAR; PG8_SCHED;
            PG8_LDB(B1, 1, 1); PG8_STAGE(PG8_SB(1, 0), b3, voffB);
            PG8_BAR; PG8_WAIT_L(0); PG8_MMA(0, 1, At, B1); PG8_BAR;
            PG8_LDA(At, 1, 1); PG8_STAGE(PG8_SA(1, 0), a3, voffA);
            PG8_BAR; PG8_WAIT_L(0); PG8_MMA(1, 0, At, B0); PG8_BAR; PG8_SCHED;
            PG8_STAGE(PG8_SB(1, 1), b3 + hstep, voffB);
            PG8_WAIT_V(6); PG8_BAR; PG8_MMA(1, 1, At, B1); PG8_BAR;
            }
        }
        if constexpr (ALIGN_EPI) { if (wr == 0) PG8_BAR; }
        if constexpr (!Epi::AFTER_DRAIN) { E(acc, cur, wr, wc, fr, fq); S.done(cur); }
        if (!has_next) break;
#pragma unroll
        for (int a = 0; a < 2; ++a)
#pragma unroll
            for (int b = 0; b < 2; ++b)
#pragma unroll
                for (int m = 0; m < 4; ++m)
#pragma unroll
                    for (int n = 0; n < 2; ++n) acc[a][b][m][n] = (f32x4){0.f, 0.f, 0.f, 0.f};
        cur = nxt; cA = nA; cB = nB; ++ui;
        if constexpr (ALIGN_EPI) { if (wr == 1) PG8_BAR; }
    }
    PG8_WAIT_V(0);
    if constexpr (!ALIGN_EPI) { if (wr == 0) PG8_BAR; }
    PG8_BAR;
    if constexpr (Epi::AFTER_DRAIN) { E.fused(acc, cur, wr, wc, fr, fq, lds, wid, lane); S.done(cur); }
#undef PG8_SA
#undef PG8_SB
#undef PG8_STAGE
#undef PG8_LDA
#undef PG8_LDB
#undef PG8_MMA
#undef PG8_WAIT_V
#undef PG8_WAIT_L
#undef PG8_BAR
#undef PG8_SCHED
}
}

constexpr int NB = 16, SEQ = 2048, DM = 1024, NTOK = NB * SEQ;
constexpr int INC = 2840, INP = 3072;
constexpr int C_B = 0, C_C = 512, C_H = 1024, C_Q = 1536, C_KC = 2048, C_VC = 2176, C_KS = 2304, C_VS = 2432, C_KW = 2560, C_VW = 2688, C_G = 2816;
constexpr int MEMT = 256, NMEM = NB * MEMT;
constexpr int NEXP = 16384;
constexpr int PEER_ROW_BYTES = 1280;
constexpr float EPS = 1e-6f;
constexpr float LOG2E = 1.4426950408889634f;
constexpr int NWAVES = 8, NTHR = 512;
constexpr int NPHASE = 13;

constexpr size_t MiB = 1u << 20;
constexpr size_t WS_CTL = 0, CTL_ZERO_BYTES = 1 * MiB;
constexpr size_t WS_WIN = 2 * MiB, WS_WOUT = 8 * MiB, WS_XQT = 10 * MiB, WS_XKVT = 12 * MiB, WS_XOT = 16 * MiB, WS_PWQT = 18 * MiB;
constexpr size_t WS_PKEYS = 22 * MiB, WS_B1P = 23 * MiB, WS_KCMP = 24 * MiB, WS_VCMP = 24 * MiB + 512 * 1024;
constexpr size_t WS_MN = 26 * MiB, WS_XKV = 34 * MiB;
constexpr size_t WS_CW1T = 22 * MiB + 512 * 1024;
constexpr size_t WS_SA1 = 23 * MiB + 256 * 1024, WS_SB1 = 23 * MiB + 384 * 1024, WS_CMX = 23 * MiB + 448 * 1024;
constexpr size_t WS_PSC = 23 * MiB + 256 * 1024;
constexpr size_t WS_SH = 54 * MiB, WS_SBQ = 54 * MiB + 128 * 1024, WS_CMXQ = 54 * MiB + 256 * 1024;
constexpr size_t WS_SSP1 = 50 * MiB, WS_SSP2 = 52 * MiB;
constexpr size_t WS_PDOWN = 64 * MiB, WS_PUP = 96 * MiB, WS_HN = 128 * MiB, WS_YMIX = 192 * MiB;
constexpr size_t WS_PROJ = 256 * MiB, WS_XQ = 256 * MiB, WS_PQ = 320 * MiB, WS_PIDX = 448 * MiB, WS_PGATE = 464 * MiB, WS_END = 480 * MiB;
constexpr int CW_BAR = 4096;

constexpr int RING_BYTES = 131072;
constexpr int MISC_OFF = 163584;
constexpr int LDS_BYTES = 163840;

#define GAS __attribute__((address_space(1)))
#define LAS __attribute__((address_space(3)))
#define DI __device__ __forceinline__
typedef unsigned short bf16;
typedef unsigned v4u __attribute__((ext_vector_type(4)));
typedef unsigned v2u __attribute__((ext_vector_type(2)));
typedef float f32x4 __attribute__((ext_vector_type(4)));
typedef float f32x16 __attribute__((ext_vector_type(16)));
typedef short bf16x8 __attribute__((ext_vector_type(8)));
typedef short s16x4 __attribute__((ext_vector_type(4)));
typedef float f32x2_t __attribute__((ext_vector_type(2)));
typedef __bf16 bf16x2_t __attribute__((ext_vector_type(2)));
#define RLX_AGENT __ATOMIC_RELAXED, __HIP_MEMORY_SCOPE_AGENT
#define LDS_WAIT() asm volatile("s_waitcnt lgkmcnt(0)" ::: "memory")
#define MFMA32(a, b, c) __builtin_amdgcn_mfma_f32_32x32x16_bf16((a), (b), (c), 0, 0, 0)

DI unsigned pk2(float lo, float hi) { f32x2_t v = {lo, hi}; bf16x2_t b = __builtin_convertvector(v, bf16x2_t); return __builtin_bit_cast(unsigned, b); }
DI bf16 f2bf(float f) { return (bf16)(pk2(f, 0.f) & 0xffffu); }
DI float bf2f(bf16 b) { return __uint_as_float((unsigned)b << 16); }
DI float bflo(unsigned u) { return __uint_as_float(u << 16); }
DI float bfhi(unsigned u) { return __uint_as_float(u & 0xffff0000u); }
DI float rlane(float v, int l);
DI float wave_sum(float v) {
    v += __uint_as_float((unsigned)__builtin_amdgcn_update_dpp(0, (int)__float_as_uint(v), 0xB1, 0xF, 0xF, true));
    v += __uint_as_float((unsigned)__builtin_amdgcn_update_dpp(0, (int)__float_as_uint(v), 0x4E, 0xF, 0xF, true));
    v += __uint_as_float((unsigned)__builtin_amdgcn_update_dpp(0, (int)__float_as_uint(v), 0x141, 0xF, 0xF, true));
    v += __uint_as_float((unsigned)__builtin_amdgcn_update_dpp(0, (int)__float_as_uint(v), 0x140, 0xF, 0xF, true));
    return (rlane(v, 0) + rlane(v, 16)) + (rlane(v, 32) + rlane(v, 48));
}
DI float rlane(float v, int l)   { return __uint_as_float((unsigned)__builtin_amdgcn_readlane((int)__float_as_uint(v), l)); }
DI int crow(int i, int h) { return (i & 3) + 8 * (i >> 2) + 4 * h; }
DI float gelu_erf(float v) { return 0.5f * v * (1.0f + erff(v * 0.70710678118654752f)); }

#define XB_TMO      128
#define XB_XCNT(j)  (256  + 64 * (j))
#define XB_XSUB(j)  (1280 + 64 * (j))
#define XB_XGEN(j)  (2304 + 64 * (j))
#define XB_TOP      3328
#define XB_TOPGEN   3392
#define XCD_BAR_WORDS 3456
#define XB_SPIN_CAP (1u << 22)

DI unsigned xb_ld(unsigned* p)              { return __hip_atomic_load(p, __ATOMIC_RELAXED, __HIP_MEMORY_SCOPE_AGENT); }
DI unsigned xb_add(unsigned* p, unsigned v) { return __hip_atomic_fetch_add(p, v, __ATOMIC_RELAXED, __HIP_MEMORY_SCOPE_AGENT); }
DI unsigned xb_xcc_id() { return (unsigned)__builtin_amdgcn_s_getreg((3 << 11) | 20) & 0xFu; }
#define XB_SPIN(cond, bar) do { unsigned _sp = 0; while (cond) { __builtin_amdgcn_s_sleep(1); \
    if ((++_sp & 255u) == 0u) { if (xb_ld(&(bar)[XB_TMO])) break; if (_sp > XB_SPIN_CAP) { atomicAdd(&(bar)[XB_TMO], 1u); break; } } } } while (0)

struct XcdBarrier { unsigned* bar; unsigned x; volatile LAS unsigned* st; };

DI XcdBarrier xcd_barrier_post(unsigned* bar, volatile LAS unsigned* st) {
    XcdBarrier b; b.bar = bar; b.x = xb_xcc_id(); b.st = st;
    if (threadIdx.x == 0) (void)xb_add(&bar[XB_XCNT(b.x)], 1u);
    return b;
}
DI void xcd_barrier_complete(unsigned* bar, unsigned x, unsigned& nloc, unsigned& nx) {
    const unsigned G = gridDim.x * gridDim.y * gridDim.z;
    unsigned sum, cnt, mine, sp = 0u;
    for (;;) {
        sum = 0u; cnt = 0u; mine = 0u;
#pragma unroll
        for (unsigned j = 0; j < 16; ++j) { const unsigned c = xb_ld(&bar[XB_XCNT(j)]); sum += c; cnt += (c > 0u) ? 1u : 0u; mine = (j == x) ? c : mine; }
        if (sum == G) break;
        __builtin_amdgcn_s_sleep(1);
        if ((++sp & 255u) == 0u) { if (xb_ld(&bar[XB_TMO])) break; if (sp > XB_SPIN_CAP) { atomicAdd(&bar[XB_TMO], 1u); break; } }
    }
    nloc = mine > 0u ? mine : 1u; nx = cnt > 0u ? cnt : 1u;
}
DI void xcd_barrier(const XcdBarrier& b) {
    asm volatile("s_waitcnt vmcnt(0)" ::: "memory");
    __syncthreads();
    if (threadIdx.x == 0) {
        unsigned* bar = b.bar;
        __builtin_amdgcn_s_waitcnt(0);
        unsigned nloc = b.st[0], nx = b.st[1];
        if (nloc == 0u) { xcd_barrier_complete(bar, b.x, nloc, nx); b.st[0] = nloc; b.st[1] = nx; }
        const unsigned old = xb_add(&bar[XB_XSUB(b.x)], 1u);
        const unsigned gen = old / nloc;
        if (old + 1u == (gen + 1u) * nloc) {
            __builtin_amdgcn_fence(__ATOMIC_RELEASE, "agent");
            asm volatile("s_waitcnt vmcnt(0)" ::: "memory");
            const unsigned og = xb_add(&bar[XB_TOP], 1u);
            const unsigned tg = og / nx;
            if (og + 1u == (tg + 1u) * nx) xb_add(&bar[XB_TOPGEN], 1u);
            else XB_SPIN(xb_ld(&bar[XB_TOPGEN]) == tg, bar);
            __builtin_amdgcn_fence(__ATOMIC_ACQUIRE, "agent");
            xb_add(&bar[XB_XGEN(b.x)], 1u);
            asm volatile("s_waitcnt vmcnt(0)" ::: "memory");
        } else {
            XB_SPIN(xb_ld(&bar[XB_XGEN(b.x)]) == gen, bar);
            __builtin_amdgcn_fence(__ATOMIC_ACQUIRE, "agent");
            asm volatile("s_waitcnt vmcnt(0)" ::: "memory");
        }
    }
    __syncthreads();
}

DI void transpose_item(const float* W, int K, int N, int Npad, bf16* WT, int row_off, LAS float* scr, int item, int lane, const float* ks = nullptr) {
    const int nblk = Npad / 32, kb = item / nblk, nb = item % nblk, k0 = 64 * kb, n0 = 32 * nb;
    {
        const int kr = lane >> 3, nq = n0 + 4 * (lane & 7);
        f32x4 v[8];
#pragma unroll
        for (int i = 0; i < 8; ++i) v[i] = (nq < N) ? *(const f32x4*)(W + (size_t)(k0 + 8 * i + kr) * N + nq) : (f32x4){0.f, 0.f, 0.f, 0.f};
#pragma unroll
        for (int i = 0; i < 8; ++i) { const float sc = ks ? ks[k0 + 8 * i + kr] : 1.0f; LAS float* d = scr + (8 * i + kr) * 33 + 4 * (lane & 7);
            d[0] = v[i].x * sc; d[1] = v[i].y * sc; d[2] = v[i].z * sc; d[3] = v[i].w * sc; }
    }
    LDS_WAIT(); asm volatile("" ::: "memory");
    const int c = lane & 7;
#pragma unroll
    for (int j = 0; j < 4; ++j) { const int n = (lane >> 3) + 8 * j; const LAS float* s = scr + (8 * c) * 33 + n;
        v4u o; o.x = pk2(s[0 * 33], s[1 * 33]); o.y = pk2(s[2 * 33], s[3 * 33]); o.z = pk2(s[4 * 33], s[5 * 33]); o.w = pk2(s[6 * 33], s[7 * 33]);
        *(v4u*)(WT + (size_t)(row_off + n0 + n) * K + k0 + 8 * c) = o; }
    LDS_WAIT(); asm volatile("" ::: "memory");
}
template <int NR>
DI void rms_rows_to_bf16(const float* xrow, const float* w, bf16* orow, int lane) {
    const f32x4* wr = (const f32x4*)w + lane;
    f32x4 v[NR][4]; float s[NR];
#pragma unroll
    for (int q = 0; q < NR; ++q) { const f32x4* xr = (const f32x4*)(xrow + (size_t)q * DM) + lane;
#pragma unroll
        for (int j = 0; j < 4; ++j) v[q][j] = xr[64 * j]; }
#pragma unroll
    for (int q = 0; q < NR; ++q) { s[q] = 0.f;
#pragma unroll
        for (int j = 0; j < 4; ++j) s[q] += (v[q][j].x * v[q][j].x + v[q][j].y * v[q][j].y) + (v[q][j].z * v[q][j].z + v[q][j].w * v[q][j].w); }
#pragma unroll
    for (int q = 0; q < NR; ++q) { const float r = 1.0f / sqrtf(wave_sum(s[q]) * (1.f / DM) + EPS);
        v2u* o8 = (v2u*)(orow + (size_t)q * DM) + lane;
#pragma unroll
        for (int j = 0; j < 4; ++j) { const f32x4 ww = wr[64 * j]; v2u o; o.x = pk2(v[q][j].x * r * ww.x, v[q][j].y * r * ww.y); o.y = pk2(v[q][j].z * r * ww.z, v[q][j].w * r * ww.w); o8[64 * j] = o; } }
}
DI float wave_max_u(float v) {
    v = fmaxf(v, __uint_as_float((unsigned)__builtin_amdgcn_update_dpp(0, (int)__float_as_uint(v), 0xB1, 0xF, 0xF, true)));
    v = fmaxf(v, __uint_as_float((unsigned)__builtin_amdgcn_update_dpp(0, (int)__float_as_uint(v), 0x4E, 0xF, 0xF, true)));
    v = fmaxf(v, __uint_as_float((unsigned)__builtin_amdgcn_update_dpp(0, (int)__float_as_uint(v), 0x141, 0xF, 0xF, true)));
    v = fmaxf(v, __uint_as_float((unsigned)__builtin_amdgcn_update_dpp(0, (int)__float_as_uint(v), 0x140, 0xF, 0xF, true)));
    return fmaxf(fmaxf(rlane(v, 0), rlane(v, 16)), fmaxf(rlane(v, 32), rlane(v, 48)));
}
DI unsigned q8x4(float a, float b, float c, float d, float inv) {
    return ((unsigned)(int)__builtin_rintf(a * inv) & 0xffu) | (((unsigned)(int)__builtin_rintf(b * inv) & 0xffu) << 8) | (((unsigned)(int)__builtin_rintf(c * inv) & 0xffu) << 16) | (((unsigned)(int)__builtin_rintf(d * inv) & 0xffu) << 24);
}
template <int NR>
DI void rms_rows_to_i8(const float* xrow, const float* w, unsigned char* orow, float* srow, int lane) {
    const f32x4* wr = (const f32x4*)w + lane;
    f32x4 v[NR][4]; float s[NR];
#pragma unroll
    for (int q = 0; q < NR; ++q) { const f32x4* xr = (const f32x4*)(xrow + (size_t)q * DM) + lane;
#pragma unroll
        for (int j = 0; j < 4; ++j) v[q][j] = xr[64 * j]; }
#pragma unroll
    for (int q = 0; q < NR; ++q) { s[q] = 0.f;
#pragma unroll
        for (int j = 0; j < 4; ++j) s[q] += (v[q][j].x * v[q][j].x + v[q][j].y * v[q][j].y) + (v[q][j].z * v[q][j].z + v[q][j].w * v[q][j].w); }
#pragma unroll
    for (int q = 0; q < NR; ++q) { const float r = 1.0f / sqrtf(wave_sum(s[q]) * (1.f / DM) + EPS); float mx = 0.f;
#pragma unroll
        for (int j = 0; j < 4; ++j) { v[q][j] = v[q][j] * r * wr[64 * j]; mx = fmaxf(mx, fmaxf(fmaxf(fabsf(v[q][j].x), fabsf(v[q][j].y)), fmaxf(fabsf(v[q][j].z), fabsf(v[q][j].w)))); }
        mx = wave_max_u(mx); const float inv = mx > 0.f ? 127.0f / mx : 0.f;
        unsigned* o4 = (unsigned*)(orow + (size_t)q * DM) + lane;
#pragma unroll
        for (int j = 0; j < 4; ++j) o4[64 * j] = q8x4(v[q][j].x, v[q][j].y, v[q][j].z, v[q][j].w, inv);
        if (lane == 0) srow[q] = mx * (1.0f / 127.0f); }
}
DI void transpose_item_i8(const float* W, int NR, int NP, const float* cmx, unsigned char* WT, float* sb, LAS float* scr, int item, int lane) {
    const int nblk = NP / 32, kb = item / nblk, nb = item % nblk, k0 = 64 * kb, n0 = 32 * nb;
    const int nn = n0 + (lane & 31);
    float cm = 0.f;
#pragma unroll
    for (int kc = 0; kc < 16; ++kc) cm = fmaxf(cm, cmx[kc * NP + nn]);
    const float inv = cm > 0.f ? 127.0f / cm : 0.f;
    if (kb == 0 && lane < 32) sb[nn] = cm * (1.0f / 127.0f);
    {
        const int kr = lane >> 3, nc = lane & 7, nq = n0 + 4 * nc;
        const float i0 = __shfl(inv, 4 * nc), i1 = __shfl(inv, 4 * nc + 1), i2 = __shfl(inv, 4 * nc + 2), i3 = __shfl(inv, 4 * nc + 3);
        f32x4 v[8];
#pragma unroll
        for (int i = 0; i < 8; ++i) v[i] = (nq < NR) ? *(const f32x4*)(W + (size_t)(k0 + 8 * i + kr) * NR + nq) : (f32x4){0.f, 0.f, 0.f, 0.f};
#pragma unroll
        for (int i = 0; i < 8; ++i) { LAS float* d = scr + (8 * i + kr) * 33 + 4 * nc; d[0] = v[i].x * i0; d[1] = v[i].y * i1; d[2] = v[i].z * i2; d[3] = v[i].w * i3; }
    }
    LDS_WAIT(); asm volatile("" ::: "memory");
    const int c = lane & 7;
#pragma unroll
    for (int j = 0; j < 4; ++j) { const int n = (lane >> 3) + 8 * j; const LAS float* s = scr + (8 * c) * 33 + n;
        v2u o; o.x = q8x4(s[0 * 33], s[1 * 33], s[2 * 33], s[3 * 33], 1.0f); o.y = q8x4(s[4 * 33], s[5 * 33], s[6 * 33], s[7 * 33], 1.0f);
        *(v2u*)(WT + (size_t)(n0 + n) * DM + k0 + 8 * c) = o; }
    LDS_WAIT(); asm volatile("" ::: "memory");
}
DI void cvt_stream(const float* src, bf16* dst, size_t n8, int gthread, int nthreads) {
    for (size_t i = gthread; i < n8; i += nthreads) {
        const f32x4 a = ((const f32x4*)src)[2 * i], b = ((const f32x4*)src)[2 * i + 1];
        v4u o; o.x = pk2(a.x, a.y); o.y = pk2(a.z, a.w); o.z = pk2(b.x, b.y); o.w = pk2(b.z, b.w);
        ((v4u*)dst)[i] = o;
    }
}

DI void colmax_item(const float* W, int NR, int NP, float* cmx, int it, int lane) {
    const int kc = it / (NP / 64), n = 64 * (it % (NP / 64)) + 4 * (lane & 15), kr = lane >> 4; f32x4 mx = {0.f, 0.f, 0.f, 0.f};
    if (n < NR) {
#pragma unroll
        for (int i = 0; i < 16; ++i) { const f32x4 v = *(const f32x4*)(W + (size_t)(64 * kc + 4 * i + kr) * NR + n);
            mx.x = fmaxf(mx.x, fabsf(v.x)); mx.y = fmaxf(mx.y, fabsf(v.y)); mx.z = fmaxf(mx.z, fabsf(v.z)); mx.w = fmaxf(mx.w, fabsf(v.w)); } }
    mx.x = fmaxf(mx.x, __shfl_xor(mx.x, 16)); mx.y = fmaxf(mx.y, __shfl_xor(mx.y, 16)); mx.z = fmaxf(mx.z, __shfl_xor(mx.z, 16)); mx.w = fmaxf(mx.w, __shfl_xor(mx.w, 16));
    mx.x = fmaxf(mx.x, __shfl_xor(mx.x, 32)); mx.y = fmaxf(mx.y, __shfl_xor(mx.y, 32)); mx.z = fmaxf(mx.z, __shfl_xor(mx.z, 32)); mx.w = fmaxf(mx.w, __shfl_xor(mx.w, 32));
    if (kr == 0) *(f32x4*)(cmx + kc * NP + n) = mx;
}
struct Ptrs {
    const float *x, *mem, *mix_norm_w, *w_in, *conv_w, *conv_b, *cmp_pe, *cmp_w1, *cmp_w2, *q_norm_w, *k_norm_w, *w_out, *xattn_norm_w, *mem_norm_w,
                *xq, *xk, *xv, *xo, *xq_norm_w, *xk_norm_w, *ffn_norm_w, *peer_wq, *peer_keys, *peer_down, *peer_up;
    float* out;
    bf16 *WIN, *WOUT, *XQT, *XKVT, *XOT, *PWQT, *PKEYS, *KCMP, *VCMP, *MN, *XKV, *HN, *YMIX, *PROJ, *XQ, *PQ;
    unsigned char *PDOWN, *PUP;
    float *B1P, *PGATE, *PSC, *SSP1, *SSP2, *SA1, *SB1, *CMX, *SH, *SBQ, *CMXQ; int* PIDX; bf16* CW1T; unsigned char *HN8, *WIN8, *H8, *PWQ8;
};

DI void p0_prologue(const Ptrs& P, LAS unsigned char* lds, int gw, int NGW, int wave, int lane, int part, int pm = 7) {
    LAS float* scr = (LAS float*)(lds + wave * 16384);
    if (part == 1 && !(pm & 1)) return;
    if (part == 1) {
        for (int it = gw; it < (DM / 64) * (INP / 32) + (DM / 64) * (2048 / 32); it += NGW) {
            if (it < (DM / 64) * (INP / 32)) transpose_item_i8(P.w_in, INC, INP, P.CMX, P.WIN8, P.SB1, scr, it, lane);
            else transpose_item_i8(P.peer_wq, 2048, 2048, P.CMXQ, P.PWQ8, P.SBQ, scr, it - (DM / 64) * (INP / 32), lane); }
        return;
    }
    if (pm & 1) for (int it = gw; it < 16 * (INP / 64) + 16 * (2048 / 64); it += NGW) {
        if (it < 16 * (INP / 64)) colmax_item(P.w_in, INC, INP, P.CMX, it, lane); else colmax_item(P.peer_wq, 2048, 2048, P.CMXQ, it - 16 * (INP / 64), lane); }
    constexpr int I_IN = (DM / 64) * (INP / 32), I_SQ = (DM / 64) * (DM / 32), I_PQ = (DM / 64) * (2048 / 32);
    constexpr int NITEMS = 5 * I_SQ;
    if (pm & 1) for (int it = gw; it < NITEMS; it += NGW) {
        int r = it;
        if (r < I_SQ) { transpose_item(P.w_out, DM, DM, DM, P.WOUT, 0, scr, r, lane); continue; } r -= I_SQ;
        if (r < I_SQ) { transpose_item(P.xq, DM, DM, DM, P.XQT, 0, scr, r, lane, P.xattn_norm_w); continue; } r -= I_SQ;
        if (r < I_SQ) { transpose_item(P.xk, DM, DM, DM, P.XKVT, 0, scr, r, lane); continue; } r -= I_SQ;
        if (r < I_SQ) { transpose_item(P.xv, DM, DM, DM, P.XKVT, DM, scr, r, lane); continue; } r -= I_SQ;
        transpose_item(P.xo, DM, DM, DM, P.XOT, 0, scr, r, lane);
    }
    for (int it = gw; it < 128; it += NGW) {
        const int q = it >> 5, r = it & 31;
        transpose_item(P.cmp_w1 + (size_t)q * 1024 * 64, 1024, 64, 64, P.CW1T + (size_t)(q >> 1) * 128 * 1024, (q & 1) * 64, scr, r, lane);
    }
    for (int it = gw; it < 64; it += NGW) {
        const int kv = it >> 5, l = it & 31;
        const float pv = P.cmp_pe[(kv * 32 + l) * 64 + lane];
        const float* w1 = P.cmp_w1 + ((size_t)kv * 2048 + l * 64) * 64 + lane;
        float acc = 0.f;
#pragma unroll 16
        for (int d = 0; d < 64; ++d) acc += rlane(pv, d) * w1[d * 64];
        P.B1P[it * 64 + lane] = acc;
    }
    if (pm & 2) for (int m = 4 * gw; m < NTOK; m += 4 * NGW) rms_rows_to_i8<4>(P.x + (size_t)m * DM, P.mix_norm_w, P.HN8 + (size_t)m * DM, P.SA1 + m, lane);
    if (pm & 2) for (int m = 2 * gw; m < NMEM; m += 2 * NGW) rms_rows_to_bf16<2>(P.mem + (size_t)m * DM, P.mem_norm_w, P.MN + (size_t)m * DM, lane);
    const int gthread = gw * 64 + lane, nthreads = NGW * 64;
    if (pm & 4) for (int row0 = 2 * gw; row0 < 2 * NEXP; row0 += 2 * NGW) {
        f32x4 v2[2][4];
#pragma unroll
        for (int q = 0; q < 2; ++q) { const int row = row0 + q, tb = row >> 14, e = row & (NEXP - 1);
            const f32x4* src = (const f32x4*)((tb ? P.peer_up : P.peer_down) + (size_t)e * DM) + 4 * lane;
#pragma unroll
            for (int j = 0; j < 4; ++j) v2[q][j] = src[j]; }
#pragma unroll
        for (int q = 0; q < 2; ++q) { const int row = row0 + q, tb = row >> 14, e = row & (NEXP - 1);
        f32x4 v[4]; float mx = 0.f;
#pragma unroll
        for (int j = 0; j < 4; ++j) { v[j] = v2[q][j]; mx = fmaxf(mx, fmaxf(fmaxf(fabsf(v[j].x), fabsf(v[j].y)), fmaxf(fabsf(v[j].z), fabsf(v[j].w)))); }
        const bf16 sc16 = f2bf(mx * (tb ? (1.0f / 6.0f) : (1.0f / 7.0f))); const float sc = bf2f(sc16), inv = sc > 0.f ? 1.0f / sc : 0.f;
        unsigned w[2];
#pragma unroll
        for (int d = 0; d < 2; ++d) { unsigned acc = 0u;
            if (tb) {
#define FP4_PAIR(B) { const int c = 8 * d + 2 * (B); const float x0 = fminf(fmaxf(v[c >> 2][c & 3] * inv, -6.0f), 6.0f), x1 = fminf(fmaxf(v[(c + 1) >> 2][(c + 1) & 3] * inv, -6.0f), 6.0f); \
                    acc = __builtin_amdgcn_cvt_scalef32_pk_fp4_f32(acc, x0, x1, 1.0f, (B)); }
                FP4_PAIR(0) FP4_PAIR(1) FP4_PAIR(2) FP4_PAIR(3)
#undef FP4_PAIR
            } else {
#pragma unroll
                for (int i = 0; i < 8; ++i) { const float x = v[2 * d + (i >> 2)][i & 3]; int q2 = (int)__builtin_rintf(x * inv); q2 = q2 < -7 ? -7 : (q2 > 7 ? 7 : q2); acc |= ((unsigned)q2 & 0xFu) << (4 * i); }
            }
            w[d] = acc; }
        unsigned char* rp = P.PDOWN + (size_t)e * PEER_ROW_BYTES;
        *(v2u*)(rp + 16 * lane + 8 * tb) = (v2u){w[0], w[1]};
        *(bf16*)(rp + 1024 + 4 * lane + 2 * tb) = sc16;
        }
    }
    cvt_stream(P.peer_keys, P.PKEYS, (size_t)8 * 2 * 128 * 128 / 8, gthread, nthreads);
}

template <int CTRL> DI float dppf(float v) { return __uint_as_float((unsigned)__builtin_amdgcn_update_dpp(0, (int)__float_as_uint(v), CTRL, 0xF, 0xF, true)); }
DI float sum8(float v) { v += dppf<0xB1>(v); v += dppf<0x4E>(v); v += dppf<0x141>(v); return v; }
DI float sum32(float v) { v = sum8(v); v += dppf<0x140>(v); v += __shfl_xor(v, 16); return v; }
constexpr int CM_SA_OFF = 0, CM_SB_OFF = 36864, CM_P_OFF = 0, CM_H_OFF = 73728, CM_W2_OFF = CM_H_OFF + 128 * 68 * 4, CM_B_OFF = CM_W2_OFF + 64 * 64 * 4;
DI void compress_unit(const Ptrs& P, LAS unsigned char* lds, int kv, int b, int g, int tid, int wave, int lane) {
    LAS float* Pl = (LAS float*)(lds + CM_P_OFF); LAS float* Hl = (LAS float*)(lds + CM_H_OFF); LAS float* W2l = (LAS float*)(lds + CM_W2_OFF); LAS float* Bl = (LAS float*)(lds + CM_B_OFF);
    const int r = lane & 31, h = lane >> 5, wm = wave >> 1, wn = wave & 1;
    __syncthreads();
    for (int e = tid; e < 64 * 64; e += NTHR) W2l[e] = P.cmp_w2[(size_t)kv * 4096 + e];
    if (tid < 64) { float s = 0.f;
#pragma unroll 8
        for (int l = 0; l < 32; ++l) s += P.B1P[(kv * 32 + l) * 64 + tid];
        Bl[tid] = s; }
    {
        const bf16* abase = P.PROJ + (size_t)b * SEQ * INP + (kv ? C_VC : C_KC) + g * 64;
        const bf16* bbase = P.CW1T + (size_t)kv * 128 * 1024;
        const int srow = tid >> 3, sch = tid & 7;
        v4u ra[2], rb[2];
#define CM_GLOAD(L) { _Pragma("unroll") for (int k2 = 0; k2 < 2; ++k2) { const int row = srow + 64 * k2; \
            ra[k2] = *(const v4u*)(abase + (size_t)(16 * row + (L)) * INP + sch * 8); rb[k2] = *(const v4u*)(bbase + (size_t)row * 1024 + (L) * 64 + sch * 8); } }
#define CM_LSTORE(BUF) { _Pragma("unroll") for (int k2 = 0; k2 < 2; ++k2) { const int row = srow + 64 * k2; \
            *(LAS v4u*)(lds + CM_SA_OFF + (BUF) * 18432 + row * 144 + sch * 16) = ra[k2]; *(LAS v4u*)(lds + CM_SB_OFF + (BUF) * 18432 + row * 144 + sch * 16) = rb[k2]; } }
        CM_GLOAD(0) CM_LSTORE(0) CM_GLOAD(1)
        f32x16 acc[2];
#pragma unroll
        for (int i = 0; i < 16; ++i) { acc[0][i] = 0.f; acc[1][i] = 0.f; }
#pragma unroll 1
        for (int l = 0; l < 16; ++l) {
            __syncthreads();
            if (l + 1 < 16) { CM_LSTORE((l + 1) & 1) if (l + 2 < 16) CM_GLOAD(l + 2) }
            LAS const unsigned char* ap = lds + CM_SA_OFF + (l & 1) * 18432 + (32 * wm + r) * 144 + h * 16;
            LAS const unsigned char* bp = lds + CM_SB_OFF + (l & 1) * 18432 + (64 * wn + r) * 144 + h * 16;
#pragma unroll
            for (int kk = 0; kk < 4; ++kk) { const bf16x8 a = *(LAS const bf16x8*)(ap + kk * 32), b0 = *(LAS const bf16x8*)(bp + kk * 32), b1 = *(LAS const bf16x8*)(bp + 32 * 144 + kk * 32);
                acc[0] = MFMA32(a, b0, acc[0]); acc[1] = MFMA32(a, b1, acc[1]); }
        }
#undef CM_GLOAD
#undef CM_LSTORE
        __syncthreads();
#pragma unroll
        for (int t = 0; t < 2; ++t)
#pragma unroll
            for (int i = 0; i < 16; ++i) Pl[(32 * wm + crow(i, h)) * 132 + 64 * wn + 32 * t + r] = acc[t][i];
    }
    __syncthreads();
    for (int e = tid; e < 128 * 64; e += NTHR) { const int n = e >> 6, j = e & 63;
        Hl[n * 68 + j] = (n < 127) ? gelu_erf(Pl[n * 132 + j] + Pl[(n + 1) * 132 + 64 + j] + Bl[j]) : 0.f; }
    __syncthreads();
    {
        const int n = tid >> 2, jq = tid & 3;
        float o[16];
#pragma unroll
        for (int j = 0; j < 16; ++j) o[j] = 0.f;
#pragma unroll 4
        for (int m = 0; m < 64; ++m) { const float hv = Hl[n * 68 + m];
#pragma unroll
            for (int j4 = 0; j4 < 4; ++j4) { const f32x4 w = *(LAS const f32x4*)(W2l + m * 64 + jq * 16 + 4 * j4); o[4 * j4] += hv * w.x; o[4 * j4 + 1] += hv * w.y; o[4 * j4 + 2] += hv * w.z; o[4 * j4 + 3] += hv * w.w; } }
        if (kv == 0) { float ss = 0.f;
#pragma unroll
            for (int j = 0; j < 16; ++j) ss += o[j] * o[j];
            ss += dppf<0xB1>(ss); ss += dppf<0x4E>(ss);
            const float rr = 1.0f / sqrtf(ss * (1.f / 64.f) + EPS);
#pragma unroll
            for (int j = 0; j < 16; ++j) o[j] = o[j] * rr * P.k_norm_w[jq * 16 + j]; }
        v4u w0, w1; w0.x = pk2(o[0], o[1]); w0.y = pk2(o[2], o[3]); w0.z = pk2(o[4], o[5]); w0.w = pk2(o[6], o[7]); w1.x = pk2(o[8], o[9]); w1.y = pk2(o[10], o[11]); w1.z = pk2(o[12], o[13]); w1.w = pk2(o[14], o[15]);
        bf16* outp = (kv ? P.VCMP : P.KCMP) + ((size_t)((b * 2 + g) * 128 + n)) * 64 + jq * 16;
        *(v4u*)outp = w0; *(v4u*)(outp + 8) = w1;
    }
}
template <bool do_norm, int PMODE>
DI void p2_misc(const Ptrs& P, LAS unsigned char* lds, int vcu, int G, int tid, int wave, int lane) {
    const int ncw = G >> 2;
    if ((vcu & 3) == 0) {
        if (PMODE != 1) for (int u = vcu >> 2; u < 64; u += ncw) compress_unit(P, lds, u >> 5, (u >> 1) & 15, u & 1, tid, wave, lane);
        return;
    }
    const int ov = (vcu >> 2) * 3 + (vcu & 3) - 1, gw = ov * NWAVES + wave, NGW = (G - ncw) * NWAVES;
    if (do_norm) {
        pg8::Gemm g{P.MN, P.XKVT, NMEM, 2048, DM}; pg8::StaticOrder S; S.init(NMEM, 2048, G - ncw, ov);
        pg8::EpiBf16<0> E{P.XKV, 2048, nullptr, 0, 0, 1.f};
        pg8::gemm_phase<pg8::EpiBf16<0>, pg8::StaticOrder, true, true>(lds, g, S, E);
    }
    if (do_norm) {
      const int grp = (lane >> 3) & 3, ch = lane & 7;
      const f32x4 w0 = *(const f32x4*)(P.k_norm_w + (grp < 2 ? 64 : 128) + ch * 8), w1 = *(const f32x4*)(P.k_norm_w + (grp < 2 ? 64 : 128) + ch * 8 + 4);
      for (int it = gw; it < NTOK * 4 / 8; it += NGW) {
        const int rowid = it * 8 + (lane >> 3), t = rowid >> 2;
        bf16* p = P.PROJ + (size_t)t * INP + (grp < 2 ? C_KS : C_KW) + (grp & 1) * 64 + ch * 8;
        const v4u u = *(const v4u*)p;
        const float a = bflo(u.x), b = bfhi(u.x), c = bflo(u.y), d = bfhi(u.y), e = bflo(u.z), f = bfhi(u.z), g2 = bflo(u.w), k = bfhi(u.w);
        const float ss = sum8(((a * a + b * b) + (c * c + d * d)) + ((e * e + f * f) + (g2 * g2 + k * k)));
        const float rr = 1.0f / sqrtf(ss * (1.f / 64.f) + EPS);
        v4u o; o.x = pk2(a * rr * w0.x, b * rr * w0.y); o.y = pk2(c * rr * w0.z, d * rr * w0.w); o.z = pk2(e * rr * w1.x, f * rr * w1.y); o.w = pk2(g2 * rr * w1.z, k * rr * w1.w);
        *(v4u*)p = o;
      }
    }
    if (PMODE != 2) {
        const int c8 = lane * 8;
        float cw[3][8], cb[8];
#pragma unroll
        for (int k = 0; k < 3; ++k) { const f32x4 w0 = *(const f32x4*)(P.conv_w + k * 512 + c8), w1 = *(const f32x4*)(P.conv_w + k * 512 + c8 + 4);
            cw[k][0] = w0.x; cw[k][1] = w0.y; cw[k][2] = w0.z; cw[k][3] = w0.w; cw[k][4] = w1.x; cw[k][5] = w1.y; cw[k][6] = w1.z; cw[k][7] = w1.w; }
        { const f32x4 w0 = *(const f32x4*)(P.conv_b + c8), w1 = *(const f32x4*)(P.conv_b + c8 + 4);
            cb[0] = w0.x; cb[1] = w0.y; cb[2] = w0.z; cb[3] = w0.w; cb[4] = w1.x; cb[5] = w1.y; cb[6] = w1.z; cb[7] = w1.w; }
        for (int t = gw; t < NTOK; t += NGW) {
            const int s = t & (SEQ - 1);
            const bf16* row = P.PROJ + (size_t)t * INP;
            float u[3][8];
#pragma unroll
            for (int k = 0; k < 3; ++k) {
                const int back = 2 - k;
                if (s >= back) {
                    const v4u cv = *(const v4u*)(row - (size_t)back * INP + C_C + c8), hv = *(const v4u*)(row - (size_t)back * INP + C_H + c8);
                    u[k][0] = bflo(cv.x) * bflo(hv.x); u[k][1] = bfhi(cv.x) * bfhi(hv.x); u[k][2] = bflo(cv.y) * bflo(hv.y); u[k][3] = bfhi(cv.y) * bfhi(hv.y);
                    u[k][4] = bflo(cv.z) * bflo(hv.z); u[k][5] = bfhi(cv.z) * bfhi(hv.z); u[k][6] = bflo(cv.w) * bflo(hv.w); u[k][7] = bfhi(cv.w) * bfhi(hv.w);
                } else {
#pragma unroll
                    for (int e = 0; e < 8; ++e) u[k][e] = 0.f;
                }
            }
            const v4u bv = *(const v4u*)(row + C_B + c8);
            float bg[8] = {bflo(bv.x), bfhi(bv.x), bflo(bv.y), bfhi(bv.y), bflo(bv.z), bfhi(bv.z), bflo(bv.w), bfhi(bv.w)};
            float y[8];
#pragma unroll
            for (int e = 0; e < 8; ++e) y[e] = bg[e] * (cw[0][e] * u[0][e] + cw[1][e] * u[1][e] + cw[2][e] * u[2][e] + cb[e]);
            v4u o; o.x = pk2(y[0], y[1]); o.y = pk2(y[2], y[3]); o.z = pk2(y[4], y[5]); o.w = pk2(y[6], y[7]);
            *(v4u*)(P.YMIX + (size_t)t * DM + c8) = o;
        }
    }
}
DI void xk_norm(const Ptrs& P, int gw, int NGW, int lane) {
    for (int it = gw; it < NMEM * 4 / 2; it += NGW) {
        const int rowid = it * 2 + (lane >> 5), m = rowid >> 2, hd = rowid & 3, ch = lane & 31;
        bf16* p = P.XKV + (size_t)m * 2048 + hd * 256 + ch * 8;
        const v4u u = *(const v4u*)p;
        const float a = bflo(u.x), b = bfhi(u.x), c = bflo(u.y), d = bfhi(u.y), e = bflo(u.z), f = bfhi(u.z), g2 = bflo(u.w), k = bfhi(u.w);
        const float ss = sum32(((a * a + b * b) + (c * c + d * d)) + ((e * e + f * f) + (g2 * g2 + k * k)));
        const float rr = 1.0f / sqrtf(ss * (1.f / 256.f) + EPS);
        f32x4 w0 = *(const f32x4*)(P.xk_norm_w + ch * 8), w1 = *(const f32x4*)(P.xk_norm_w + ch * 8 + 4);
        w0 *= *(const f32x4*)(P.xq_norm_w + ch * 8); w1 *= *(const f32x4*)(P.xq_norm_w + ch * 8 + 4);
        v4u o; o.x = pk2(a * rr * w0.x, b * rr * w0.y); o.y = pk2(c * rr * w0.z, d * rr * w0.w); o.z = pk2(e * rr * w1.x, f * rr * w1.y); o.w = pk2(g2 * rr * w1.z, k * rr * w1.w);
        *(v4u*)p = o;
    }
}
DI void p9_quant_h(const Ptrs& P, int gw, int NGW, int lane) {
    const f32x4 w0 = *(const f32x4*)(P.ffn_norm_w + 16 * lane), w1 = *(const f32x4*)(P.ffn_norm_w + 16 * lane + 4), w2 = *(const f32x4*)(P.ffn_norm_w + 16 * lane + 8), w3 = *(const f32x4*)(P.ffn_norm_w + 16 * lane + 12);
    for (int t0 = 4 * gw; t0 < NTOK; t0 += 4 * NGW) {
        v4u ha[4], hb[4];
#pragma unroll
        for (int q = 0; q < 4; ++q) { ha[q] = *(const v4u*)(P.HN + (size_t)(t0 + q) * DM + 16 * lane); hb[q] = *(const v4u*)(P.HN + (size_t)(t0 + q) * DM + 16 * lane + 8); }
#pragma unroll
        for (int q = 0; q < 4; ++q) {
            const float h0 = bflo(ha[q].x) * w0.x, h1 = bfhi(ha[q].x) * w0.y, h2 = bflo(ha[q].y) * w0.z, h3 = bfhi(ha[q].y) * w0.w, h4 = bflo(ha[q].z) * w1.x, h5 = bfhi(ha[q].z) * w1.y, h6 = bflo(ha[q].w) * w1.z, h7 = bfhi(ha[q].w) * w1.w;
            const float h8 = bflo(hb[q].x) * w2.x, h9 = bfhi(hb[q].x) * w2.y, h10 = bflo(hb[q].y) * w2.z, h11 = bfhi(hb[q].y) * w2.w, h12 = bflo(hb[q].z) * w3.x, h13 = bfhi(hb[q].z) * w3.y, h14 = bflo(hb[q].w) * w3.z, h15 = bfhi(hb[q].w) * w3.w;
            float mx = fmaxf(fmaxf(fmaxf(fabsf(h0), fabsf(h1)), fmaxf(fabsf(h2), fabsf(h3))), fmaxf(fmaxf(fabsf(h4), fabsf(h5)), fmaxf(fabsf(h6), fabsf(h7))));
            mx = fmaxf(mx, fmaxf(fmaxf(fmaxf(fabsf(h8), fabsf(h9)), fmaxf(fabsf(h10), fabsf(h11))), fmaxf(fmaxf(fabsf(h12), fabsf(h13)), fmaxf(fabsf(h14), fabsf(h15)))));
            mx = wave_max_u(mx);
            const float inv = mx > 0.f ? 127.0f / mx : 0.f;
            const v4u o = {q8x4(h0, h1, h2, h3, inv), q8x4(h4, h5, h6, h7, inv), q8x4(h8, h9, h10, h11, inv), q8x4(h12, h13, h14, h15, inv)};
            *(v4u*)(P.H8 + (size_t)(t0 + q) * DM + 16 * lane) = o;
            if (lane == 0) P.SH[t0 + q] = mx * (1.0f / 127.0f);
        }
    }
}

DI s16x4 tr_read(LAS const char* p) { return __builtin_bit_cast(s16x4, __builtin_amdgcn_ds_read_tr16_b64_v4i16((LAS s16x4*)p)); }
DI bf16x8 pack8a(const f32x16& x) { v4u p; p.x = pk2(x[0], x[1]); p.y = pk2(x[2], x[3]); p.z = pk2(x[4], x[5]); p.w = pk2(x[6], x[7]); return __builtin_bit_cast(bf16x8, p); }
DI bf16x8 pack8b(const f32x16& x) { v4u p; p.x = pk2(x[8], x[9]); p.y = pk2(x[10], x[11]); p.z = pk2(x[12], x[13]); p.w = pk2(x[14], x[15]); return __builtin_bit_cast(bf16x8, p); }
DI float max16(const f32x16& x) {
    float a = fmaxf(fmaxf(x[0], x[1]), fmaxf(x[2], x[3])), b = fmaxf(fmaxf(x[4], x[5]), fmaxf(x[6], x[7]));
    float c = fmaxf(fmaxf(x[8], x[9]), fmaxf(x[10], x[11])), d = fmaxf(fmaxf(x[12], x[13]), fmaxf(x[14], x[15]));
    return fmaxf(fmaxf(a, b), fmaxf(c, d));
}
DI float sum16(const f32x16& x) {
    return (((x[0] + x[1]) + (x[2] + x[3])) + ((x[4] + x[5]) + (x[6] + x[7]))) + (((x[8] + x[9]) + (x[10] + x[11])) + ((x[12] + x[13]) + (x[14] + x[15])));
}
template <int DH>
DI void qk_tile(LAS const char* ksm, const bf16x8* qf, f32x16& s0, f32x16& s1, int lane) {
    constexpr int KP = (DH + 8) * 2;
    LAS const char* kp = ksm + (lane & 31) * KP + (lane >> 5) * 16;
#pragma unroll
    for (int i = 0; i < 16; ++i) { s0[i] = 0.f; s1[i] = 0.f; }
#pragma unroll
    for (int d0 = 0; d0 < DH / 16; ++d0) {
        const bf16x8 a0 = *(LAS const bf16x8*)(kp + d0 * 32);
        const bf16x8 a1 = *(LAS const bf16x8*)(kp + 32 * KP + d0 * 32);
        s0 = MFMA32(a0, qf[d0], s0); s1 = MFMA32(a1, qf[d0], s1);
        if ((d0 & 3) == 3) __builtin_amdgcn_sched_barrier(0);
    }
}
template <int DH, int ND>
DI void pv_tile(LAS const char* vsm, const f32x16& p0, const f32x16& p1, f32x16* o, int dbase, int lane) {
    constexpr int VP = (DH + 32) * 2;
    const int h = lane >> 5, q4 = (lane & 15) >> 2, p = lane & 3, blk = (lane >> 4) & 1;
    LAS const char* vp = vsm + (4 * h + q4) * VP + (dbase + 16 * blk) * 2 + 8 * p;
    const bf16x8 pb0 = pack8a(p0), pb1 = pack8b(p0), pb2 = pack8a(p1), pb3 = pack8b(p1);
#pragma unroll
    for (int db = 0; db < ND; ++db) {
#define PV_STEP(S4, PB) { const s16x4 lo = tr_read(vp + (16 * (S4)) * VP + db * 64), hi = tr_read(vp + (16 * (S4) + 8) * VP + db * 64); \
        const bf16x8 va = __builtin_shufflevector(lo, hi, 0, 1, 2, 3, 4, 5, 6, 7); o[db] = MFMA32(va, PB, o[db]); }
        PV_STEP(0, pb0) PV_STEP(1, pb1) PV_STEP(2, pb2) PV_STEP(3, pb3)
        __builtin_amdgcn_sched_barrier(0);
#undef PV_STEP
    }
}
template <int DH, int ND>
DI void pv_tile_packed(LAS const char* vsm, const bf16x8& pb0, const bf16x8& pb1, const bf16x8& pb2, const bf16x8& pb3, f32x16* o, int dbase, int lane) {
    constexpr int VP = (DH + 32) * 2;
    const int h = lane >> 5, q4 = (lane & 15) >> 2, p = lane & 3, blk = (lane >> 4) & 1;
    LAS const char* vp = vsm + (4 * h + q4) * VP + (dbase + 16 * blk) * 2 + 8 * p;
#pragma unroll
    for (int db = 0; db < ND; ++db) {
#define PV_STEP(S4, PB) { const s16x4 lo = tr_read(vp + (16 * (S4)) * VP + db * 64), hi = tr_read(vp + (16 * (S4) + 8) * VP + db * 64); \
        const bf16x8 va = __builtin_shufflevector(lo, hi, 0, 1, 2, 3, 4, 5, 6, 7); o[db] = MFMA32(va, PB, o[db]); }
        PV_STEP(0, pb0) PV_STEP(1, pb1) PV_STEP(2, pb2) PV_STEP(3, pb3)
        __builtin_amdgcn_sched_barrier(0);
#undef PV_STEP
    }
}
DI void mask_tile(f32x16& s0, f32x16& s1, int klo, int khi, int h) {
    int hh = 4 * h; asm volatile("" : "+v"(hh));
    const int kl = klo - hh, kh = khi - hh;
#pragma unroll
    for (int i = 0; i < 16; ++i) { const int c0 = (i & 3) + 8 * (i >> 2), c1 = 32 + c0;
        s0[i] = (c0 >= kl && c0 <= kh) ? s0[i] : -INFINITY; s1[i] = (c1 >= kl && c1 <= kh) ? s1[i] : -INFINITY; }
}
DI float fmax3(float a, float b, float c) { float r; asm("v_max3_f32 %0, %1, %2, %3" : "=v"(r) : "v"(a), "v"(b), "v"(c)); return r; }
DI float max32(const f32x16& a, const f32x16& b) {
    float t0 = fmax3(a[0], a[1], a[2]), t1 = fmax3(a[3], a[4], a[5]), t2 = fmax3(a[6], a[7], a[8]), t3 = fmax3(a[9], a[10], a[11]), t4 = fmax3(a[12], a[13], a[14]);
    float u0 = fmax3(b[0], b[1], b[2]), u1 = fmax3(b[3], b[4], b[5]), u2 = fmax3(b[6], b[7], b[8]), u3 = fmax3(b[9], b[10], b[11]), u4 = fmax3(b[12], b[13], b[14]);
    t0 = fmax3(t0, t1, t2); t3 = fmax3(t3, t4, a[15]); u0 = fmax3(u0, u1, u2); u3 = fmax3(u3, u4, b[15]);
    return fmax3(fmax3(t0, t3, u0), u3, u3);
}
DI float max16t(const f32x16& a) {
    const float t0 = fmax3(a[0], a[1], a[2]), t1 = fmax3(a[3], a[4], a[5]), t2 = fmax3(a[6], a[7], a[8]), t3 = fmax3(a[9], a[10], a[11]), t4 = fmax3(a[12], a[13], a[14]);
    return fmax3(fmax3(t0, t1, t2), fmax3(t3, t4, a[15]), t0);
}
template <int ND>
DI void softmax_tile(f32x16& s0, f32x16& s1, f32x16* o, float& m, float& l, float dead) {
    float mx = max32(s0, s1); { const auto rr = __builtin_amdgcn_permlane32_swap(__float_as_uint(mx), __float_as_uint(mx), false, false); mx = fmax3(__uint_as_float(rr[0]), __uint_as_float(rr[1]), mx); }
    const float mn = fmaxf(m, mx), alpha = __builtin_amdgcn_exp2f(m - mn), mnd = mn + dead;
    s0 = s0 - mnd; s1 = s1 - mnd;
#pragma unroll
    for (int i = 0; i < 16; ++i) { s0[i] = __builtin_amdgcn_exp2f(s0[i]); s1[i] = __builtin_amdgcn_exp2f(s1[i]); }
    const f32x16 t = s0 + s1;
    float rs = sum16(t); { const auto rr = __builtin_amdgcn_permlane32_swap(__float_as_uint(rs), __float_as_uint(rs), false, false); rs = __uint_as_float(rr[0]) + __uint_as_float(rr[1]); }
    l = l * alpha + rs; m = mn;
#pragma unroll
    for (int db = 0; db < ND; ++db) o[db] *= alpha;
}
template <int DH>
DI void qk_tile_c(LAS const char* ksm, const bf16x8* qf, const f32x16& cinit, f32x16& s0, f32x16& s1, int lane) {
    constexpr int KP = (DH + 8) * 2;
    LAS const char* kp = ksm + (lane & 31) * KP + (lane >> 5) * 16;
    s0 = MFMA32(*(LAS const bf16x8*)(kp), qf[0], cinit); s1 = MFMA32(*(LAS const bf16x8*)(kp + 32 * KP), qf[0], cinit);
#pragma unroll
    for (int d0 = 1; d0 < DH / 16; ++d0) {
        const bf16x8 a0 = *(LAS const bf16x8*)(kp + d0 * 32);
        const bf16x8 a1 = *(LAS const bf16x8*)(kp + 32 * KP + d0 * 32);
        s0 = MFMA32(a0, qf[d0], s0); s1 = MFMA32(a1, qf[d0], s1);
    }
}
template <int ND>
DI void softmax_tile_ref(f32x16& s0, f32x16& s1, f32x16* o, float& negm, float& l) {
    float mx = max32(s0, s1); { const auto rr = __builtin_amdgcn_permlane32_swap(__float_as_uint(mx), __float_as_uint(mx), false, false); mx = fmax3(__uint_as_float(rr[0]), __uint_as_float(rr[1]), mx); }
    if (__any(mx > 8.0f)) {
        const float delta = mx > 8.0f ? mx : 0.f, f = __builtin_amdgcn_exp2f(-delta);
        s0 = s0 - delta; s1 = s1 - delta; negm = negm - delta; l *= f;
#pragma unroll
        for (int db = 0; db < ND; ++db) o[db] *= f;
    }
#pragma unroll
    for (int i = 0; i < 16; ++i) { s0[i] = __builtin_amdgcn_exp2f(s0[i]); s1[i] = __builtin_amdgcn_exp2f(s1[i]); }
    const f32x16 t = s0 + s1;
    float rs = sum16(t); { const auto rr = __builtin_amdgcn_permlane32_swap(__float_as_uint(rs), __float_as_uint(rs), false, false); rs = __uint_as_float(rr[0]) + __uint_as_float(rr[1]); }
    l += rs;
}
template <int DH>
DI void load_q_frags(const bf16* qrow, const float* w, float scale, bf16x8* qf, int lane) {
    const int h = lane >> 5;
    v4u raw[DH / 16]; float ss = 0.f;
#pragma unroll
    for (int d0 = 0; d0 < DH / 16; ++d0) { raw[d0] = *(const v4u*)(qrow + 16 * d0 + 8 * h);
        const float a = bflo(raw[d0].x), b = bfhi(raw[d0].x), c = bflo(raw[d0].y), d = bfhi(raw[d0].y), e = bflo(raw[d0].z), f = bfhi(raw[d0].z), g = bflo(raw[d0].w), k = bfhi(raw[d0].w);
        ss += ((a * a + b * b) + (c * c + d * d)) + ((e * e + f * f) + (g * g + k * k)); }
    ss += __shfl_xor(ss, 32);
    const float r = scale / sqrtf(ss * (1.f / DH) + EPS);
#pragma unroll
    for (int d0 = 0; d0 < DH / 16; ++d0) { const f32x4 w0 = *(const f32x4*)(w + 16 * d0 + 8 * h), w1 = *(const f32x4*)(w + 16 * d0 + 8 * h + 4);
        v4u o; o.x = pk2(bflo(raw[d0].x) * r * w0.x, bfhi(raw[d0].x) * r * w0.y); o.y = pk2(bflo(raw[d0].y) * r * w0.z, bfhi(raw[d0].y) * r * w0.w);
        o.z = pk2(bflo(raw[d0].z) * r * w1.x, bfhi(raw[d0].z) * r * w1.y); o.w = pk2(bflo(raw[d0].w) * r * w1.z, bfhi(raw[d0].w) * r * w1.w);
        qf[d0] = __builtin_bit_cast(bf16x8, o); }
}
template <int DH>
DI void tile_gload(const bf16* base, size_t pitch, v4u* regs, int tid) {
    constexpr int CPR = DH / 8;
#pragma unroll
    for (int k = 0; k < DH / 64; ++k) { const int id = tid + NTHR * k, row = id / CPR, ch = id % CPR; regs[k] = *(const v4u*)(base + (size_t)row * pitch + ch * 8); }
}
template <int DH, int PADE>
DI void tile_lstore(LAS char* sm, const v4u* regs, int tid) {
    constexpr int CPR = DH / 8, PB = (DH + PADE) * 2;
#pragma unroll
    for (int k = 0; k < DH / 64; ++k) { const int id = tid + NTHR * k, row = id / CPR, ch = id % CPR; *(LAS v4u*)(sm + row * PB + ch * 16) = regs[k]; }
}
DI float sigmoidf_(float x) { return 1.0f / (1.0f + __expf(-x)); }

DI void nsa_tile_fused(LAS const char* ksm, LAS const char* vsm, const bf16x8* qf, const f32x16& c0, f32x16* o, float& nref, float& l, int lane) {
    constexpr int KP = 144, VP = 192;
    LAS const char* kp = ksm + (lane & 31) * KP + (lane >> 5) * 16;
    const int h = lane >> 5, q4 = (lane & 15) >> 2, p = lane & 3, blk = (lane >> 4) & 1;
    LAS const char* vp = vsm + (4 * h + q4) * VP + (16 * blk) * 2 + 8 * p;
    f32x16 s0 = MFMA32(*(LAS const bf16x8*)(kp), qf[0], c0);
#pragma unroll
    for (int d0 = 1; d0 < 4; ++d0) s0 = MFMA32(*(LAS const bf16x8*)(kp + d0 * 32), qf[d0], s0);
    f32x16 s1 = MFMA32(*(LAS const bf16x8*)(kp + 32 * KP), qf[0], c0);
#pragma unroll
    for (int d0 = 1; d0 < 4; ++d0) s1 = MFMA32(*(LAS const bf16x8*)(kp + 32 * KP + d0 * 32), qf[d0], s1);
#define PV_STEP(S4, PB, DB) { const s16x4 lo = tr_read(vp + (16 * (S4)) * VP + (DB) * 64), hi = tr_read(vp + (16 * (S4) + 8) * VP + (DB) * 64); \
        const bf16x8 va = __builtin_shufflevector(lo, hi, 0, 1, 2, 3, 4, 5, 6, 7); o[DB] = MFMA32(va, PB, o[DB]); }
#pragma unroll
    for (int i = 0; i < 16; ++i) s0[i] = __builtin_amdgcn_exp2f(s0[i]);
    float rs = sum16(s0);
    { const bf16x8 pb0 = pack8a(s0), pb1 = pack8b(s0);
      PV_STEP(0, pb0, 0) PV_STEP(1, pb1, 0) PV_STEP(0, pb0, 1) PV_STEP(1, pb1, 1) }
#pragma unroll
    for (int i = 0; i < 16; ++i) s1[i] = __builtin_amdgcn_exp2f(s1[i]);
    rs += sum16(s1);
    { const bf16x8 pb2 = pack8a(s1), pb3 = pack8b(s1);
      PV_STEP(2, pb2, 0) PV_STEP(3, pb3, 0) PV_STEP(2, pb2, 1) PV_STEP(3, pb3, 1) }
#undef PV_STEP
    { const auto rr = __builtin_amdgcn_permlane32_swap(__float_as_uint(rs), __float_as_uint(rs), false, false); rs = __uint_as_float(rr[0]) + __uint_as_float(rr[1]); }
    l += rs;
    if (__any(l > 65536.0f)) {
        const unsigned e = l > 65536.0f ? (__float_as_uint(l) >> 23) - 127u : 0u;
        const float f = __uint_as_float((127u - e) << 23);
        nref -= (float)e; l *= f; o[0] *= f; o[1] *= f;
    }
}
constexpr int NSA_K_OFF = 0, NSA_V_OFF = 18432, NSA_IMP_OFF = 43008, NSA_IMP_PITCH = 36, NSA_SEL_OFF = NSA_IMP_OFF + 4 * 64 * NSA_IMP_PITCH * 4, NSA_TOT_OFF = NSA_SEL_OFF + 256;
template <int NQ>
DI void nsa_cmp_branch(LAS const char* ksm, LAS const char* vsm, LAS float* imph, const bf16x8* qf, int tpos, float gate0, LAS char* totp, int lane) {
    constexpr int KP = 144, VP = 192;
    const int h = lane >> 5;
    f32x16 s[NQ];
    qk_tile<64>(ksm, qf, s[0], s[1], lane);
    if (NQ == 4) qk_tile<64>(ksm + 64 * KP, qf, s[NQ - 2], s[NQ - 1], lane);
    const int nmax = tpos >= 31 ? min(126, (tpos - 31) >> 4) : -1;
    float mx = -INFINITY;
    int hh = 4 * h; asm volatile("" : "+v"(hh));
    const int nm = nmax - hh;
#pragma unroll
    for (int q = 0; q < NQ; ++q)
#pragma unroll
        for (int i = 0; i < 16; ++i) { const int c = 32 * q + (i & 3) + 8 * (i >> 2); s[q][i] = (c <= nm) ? s[q][i] : -INFINITY; mx = fmaxf(mx, s[q][i]); }
    { const auto rr = __builtin_amdgcn_permlane32_swap(__float_as_uint(mx), __float_as_uint(mx), false, false); mx = fmaxf(__uint_as_float(rr[0]), __uint_as_float(rr[1])); }
    const float mm = (mx == -INFINITY) ? 0.f : mx;
    float rs = 0.f;
#pragma unroll
    for (int q = 0; q < NQ; ++q) {
#pragma unroll
        for (int i = 0; i < 16; ++i) s[q][i] = __builtin_amdgcn_exp2f(s[q][i] - mm);
        rs += sum16(s[q]); }
    { const auto rr = __builtin_amdgcn_permlane32_swap(__float_as_uint(rs), __float_as_uint(rs), false, false); rs = __uint_as_float(rr[0]) + __uint_as_float(rr[1]); }
    const float inv = rs > 0.f ? 1.0f / rs : 0.f;
    if (NQ == 4) {
        LAS float* ip = imph + h;
#pragma unroll
        for (int G = 0; G < 16; ++G) { const int q = G >> 2, g4 = G & 3;
            const float sum4 = (s[q][4 * g4] + s[q][4 * g4 + 1]) + (s[q][4 * g4 + 2] + s[q][4 * g4 + 3]);
            const float last = s[q][4 * g4 + 3], prev = G ? s[(G - 1) >> 2][4 * ((G - 1) & 3) + 3] : 0.f;
            const auto rr = __builtin_amdgcn_permlane32_swap(__float_as_uint(prev), __float_as_uint(last), false, false);
            const float extra = h ? __uint_as_float(rr[0]) : __uint_as_float(rr[1]);
            ip[2 * G] = (sum4 + extra) * inv; }
    }
    f32x16 oc[2];
#pragma unroll
    for (int i = 0; i < 16; ++i) { oc[0][i] = 0.f; oc[1][i] = 0.f; }
    pv_tile<64, 2>(vsm, s[0], s[1], oc, 0, lane);
    if (NQ == 4) pv_tile<64, 2>(vsm + 64 * VP, s[NQ - 2], s[NQ - 1], oc, 0, lane);
    const float f = gate0 * inv;
#pragma unroll
    for (int c = 0; c < 8; ++c) { const f32x16& x = oc[c >> 2]; const int e = 4 * (c & 3); *(LAS f32x4*)(totp + c * 1024) = (f32x4){x[e] * f, x[e + 1] * f, x[e + 2] * f, x[e + 3] * f}; }
}
template <int MODE>
DI void nsa_unit(const Ptrs& P, LAS unsigned char* lds, int b, int g, int qi, int tid, int wave, int lane) {
    constexpr int KP = 144, VP = 192;
    const int r = lane & 31, h = lane >> 5;
    const int hd = g * 4 + (wave >> 1), tl = 32 * (wave & 1) + r;
    const size_t tok = (size_t)b * SEQ + 64 * qi + tl;
    const int tpos = 64 * qi + tl;
    LAS char* ksm = (LAS char*)lds + NSA_K_OFF; LAS char* vsm = (LAS char*)lds + NSA_V_OFF;
    LAS float* imp = (LAS float*)(lds + NSA_IMP_OFF); LAS unsigned* selm = (LAS unsigned*)(lds + NSA_SEL_OFF);
    v4u ckr[2], cvr[2];
    { const bf16* kc = P.KCMP + (size_t)(b * 2 + g) * 128 * 64; const bf16* vc = P.VCMP + (size_t)(b * 2 + g) * 128 * 64;
#pragma unroll
      for (int k = 0; k < 2; ++k) { const int id = tid + NTHR * k, row = id >> 3, ch = id & 7; ckr[k] = *(const v4u*)(kc + row * 64 + ch * 8); cvr[k] = *(const v4u*)(vc + row * 64 + ch * 8); } }
    const bf16* kvbase = P.PROJ + (size_t)b * SEQ * INP + g * 64;
    v4u kreg[1], vreg[1];
    tile_gload<64>(kvbase + C_KS, INP, kreg, tid); tile_gload<64>(kvbase + C_VS, INP, vreg, tid);
    bf16x8 qf[4];
    load_q_frags<64>(P.PROJ + tok * INP + C_Q + hd * 64, P.q_norm_w, 0.125f * LOG2E, qf, lane);
    float gate[3];
#pragma unroll
    for (int br = 0; br < 3; ++br) gate[br] = sigmoidf_(bf2f(P.PROJ[tok * INP + C_G + hd * 3 + br]));
    LAS char* totp = (LAS char*)lds + NSA_TOT_OFF + (wave * 512 + lane) * 16;

    __syncthreads();
    {
#pragma unroll
        for (int k = 0; k < 2; ++k) { const int id = tid + NTHR * k, row = id >> 3, ch = id & 7;
            *(LAS v4u*)(ksm + row * KP + ch * 16) = ckr[k]; *(LAS v4u*)(vsm + row * VP + ch * 16) = cvr[k]; }
    }
    __syncthreads();
    if (qi >= 16) nsa_cmp_branch<4>(ksm, vsm, imp + ((wave >> 1) * 64 + tl) * NSA_IMP_PITCH, qf, tpos, gate[0], totp, lane);
    else nsa_cmp_branch<2>(ksm, vsm, imp, qf, tpos, gate[0], totp, lane);
    __syncthreads();
    {
        const int tk = tid >> 3, sub = tid & 7;
        unsigned bits;
        if (qi >= 16) {
            float v[32];
#pragma unroll
            for (int c = 0; c < 8; ++c) { LAS const float* ip = imp + tk * NSA_IMP_PITCH + 4 * c;
                const f32x4 a = *(LAS const f32x4*)ip, b2 = *(LAS const f32x4*)(ip + 64 * NSA_IMP_PITCH), c2 = *(LAS const f32x4*)(ip + 128 * NSA_IMP_PITCH), d2 = *(LAS const f32x4*)(ip + 192 * NSA_IMP_PITCH);
                const f32x4 t = (a + b2) + (c2 + d2);
#pragma unroll
                for (int e = 0; e < 4; ++e) { const int j2 = 4 * c + e; v[j2] = (j2 >= 1 && j2 <= qi - 2) ? t[e] : -1.0f; } }
            bits = 0u;
#pragma unroll
            for (int k = 0; k < 4; ++k) { const int j = sub + 8 * k;
                float vj = v[8 * k];
#pragma unroll
                for (int t = 1; t < 8; ++t) vj = (sub == t) ? v[8 * k + t] : vj;
                int rank = 0;
#pragma unroll
                for (int j2 = 0; j2 < 32; ++j2) {
                    if ((j2 >> 3) < k) rank += (v[j2] >= vj) ? 1 : 0;
                    else if ((j2 >> 3) > k) rank += (v[j2] > vj) ? 1 : 0;
                    else rank += (v[j2] > vj || (v[j2] == vj && (j2 & 7) < sub)) ? 1 : 0; }
                if (j >= 1 && j <= qi - 2 && rank < 13) bits |= 1u << j; }
            bits |= __shfl_xor(bits, 1); bits |= __shfl_xor(bits, 2); bits |= __shfl_xor(bits, 4);
            bits |= 1u | (1u << qi) | (1u << (qi - 1));
        } else bits = (2u << qi) - 1u;
        if (sub == 0) selm[tk] = bits;
    }
    const int nsel = qi + 1, nwin = min(9, qi + 1), ntiles = nsel + nwin;
    f32x16 o[2]; float l = 0.f, nref = 0.f;
#pragma unroll
    for (int i = 0; i < 16; ++i) { o[0][i] = 0.f; o[1][i] = 0.f; }
    unsigned mysel = 0u;
    for (int tt = 0; tt < (MODE >= 5 ? 0 : ntiles); ++tt) {
        if (MODE != 2 || tt == 0) {
        __syncthreads();
        tile_lstore<64, 8>(ksm, kreg, tid); tile_lstore<64, 32>(vsm, vreg, tid);
        __syncthreads(); }
        if (tt == 0) mysel = selm[tl];
        if (MODE != 2 && tt + 1 < ntiles) { const int t2 = tt + 1; const bool w2 = t2 >= nsel; const int j2 = w2 ? qi - (t2 - nsel) : t2;
            tile_gload<64>(kvbase + (size_t)j2 * 64 * INP + (w2 ? C_KW : C_KS), INP, kreg, tid);
            tile_gload<64>(kvbase + (size_t)j2 * 64 * INP + (w2 ? C_VW : C_VS), INP, vreg, tid); }
        const bool win = tt >= nsel; const int j = win ? qi - (tt - nsel) : tt;
        if (tt == nsel) {
            const float f = l > 0.f ? gate[1] / l : 0.f;
#pragma unroll
            for (int c = 0; c < 8; ++c) { const f32x16& x = o[c >> 2]; const int e = 4 * (c & 3); LAS f32x4* tp = (LAS f32x4*)(totp + c * 1024); *tp = *tp + (f32x4){x[e] * f, x[e + 1] * f, x[e + 2] * f, x[e + 3] * f}; }
#pragma unroll
            for (int i = 0; i < 16; ++i) { o[0][i] = 0.f; o[1][i] = 0.f; }
            l = 0.f; nref = 0.f;
        }
        if (MODE == 1) continue;
        const bool dead = !win && !((mysel >> j) & 1u);
        f32x16 c0;
        { const float cv = dead ? -INFINITY : nref;
#pragma unroll
          for (int i = 0; i < 16; ++i) c0[i] = cv; }
        if (j == qi || (win && j == qi - 8)) {
            f32x16 s0, s1;
            qk_tile_c<64>(ksm, qf, c0, s0, s1, lane);
            int klo = 0, khi = 63;
            if (j == qi) khi = tl; else klo = tl + 1;
            mask_tile(s0, s1, klo, khi, h);
            softmax_tile_ref<2>(s0, s1, o, nref, l);
            pv_tile<64, 2>(vsm, s0, s1, o, 0, lane);
        } else nsa_tile_fused(ksm, vsm, qf, c0, o, nref, l, lane);
    }
    { const float f = l > 0.f ? gate[2] / l : 0.f;
      bf16* op = P.YMIX + tok * DM + 512 + hd * 64 + 4 * h;
#pragma unroll
      for (int c = 0; c < 8; ++c) { const f32x16& x = o[c >> 2]; const int e = 4 * (c & 3); const f32x4 t = *(LAS const f32x4*)(totp + c * 1024) + (f32x4){x[e] * f, x[e + 1] * f, x[e + 2] * f, x[e + 3] * f};
          v2u w; w.x = pk2(t[0], t[1]); w.y = pk2(t[2], t[3]);
          *(v2u*)(op + 32 * (c >> 2) + 8 * (c & 3)) = w; } }
}
template <int MODE>
DI void p3_nsa(const Ptrs& P, LAS unsigned char* lds, int vcu, int G, int tid, int wave, int lane) {
    for (int v = vcu; v < 256; v += G) {
        const int bg = v >> 3, s = v & 7;
#pragma unroll 1
        for (int k = 0; k < 4; ++k) { const int qi = (k == 0) ? 31 - s : (k == 1) ? 16 + s : (k == 2) ? 15 - s : s;
            nsa_unit<MODE>(P, lds, bg >> 1, bg & 1, qi, tid, wave, lane); }
    }
}

constexpr int XA_Q_OFF = 0, XA_K_OFF = 67584, XA_V_OFF = 101376, XA_XP_OFF = 138240, XA_XR_OFF = XA_XP_OFF + 16384;
DI void xattn_unit(const Ptrs& P, LAS unsigned char* lds, int b, int hd, int qt, int tid, int wave, int lane) {
    constexpr int KP = 528, VP = 576;
    const int r = lane & 31, h = lane >> 5, rb = wave >> 1, kh = wave & 1;
    const size_t tok0 = (size_t)b * SEQ + 128 * qt;
    LAS char* qsm = (LAS char*)lds + XA_Q_OFF; LAS char* ksm = (LAS char*)lds + XA_K_OFF; LAS char* vsm = (LAS char*)lds + XA_V_OFF;
    LAS const char* qrow = qsm + (32 * rb + r) * KP + h * 16;
    LAS char* xw = (LAS char*)lds + XA_XP_OFF + (wave * 64 + lane) * 16;
    LAS const char* xr0 = (LAS const char*)lds + XA_XP_OFF + (rb * 128 + lane) * 16;
    LAS float* xs = (LAS float*)(lds + XA_XR_OFF);
    const bf16* kb = P.XKV + (size_t)b * MEMT * 2048 + hd * 256; const bf16* vb = kb + 1024;
    v4u kreg[4], vreg[4];
    tile_gload<256>(kb, 2048, kreg, tid); tile_gload<256>(vb, 2048, vreg, tid);
    f32x4 sp0, sp1, sp2, sp3;
    { const float* sp = P.SSP1 + (tok0 + 32 * rb + r) * 16; sp0 = *(const f32x4*)sp; sp1 = *(const f32x4*)(sp + 4); sp2 = *(const f32x4*)(sp + 8); sp3 = *(const f32x4*)(sp + 12); }
    {
        const bf16* qb = P.XQ + tok0 * DM + hd * 256;
        v4u qreg[8];
#pragma unroll
        for (int k = 0; k < 8; ++k) { const int id = tid + NTHR * k, row = id >> 5, ch = id & 31; qreg[k] = *(const v4u*)(qb + (size_t)row * DM + ch * 8); }
        __syncthreads();
#pragma unroll
        for (int k = 0; k < 8; ++k) { const int id = tid + NTHR * k, row = id >> 5, ch = id & 31; *(LAS v4u*)(qsm + row * KP + ch * 16) = qreg[k]; }
    }
    f32x16 o[4]; float nref = 0.f, l = 0.f, cq = 0.f;
#pragma unroll
    for (int db = 0; db < 4; ++db)
#pragma unroll
        for (int i = 0; i < 16; ++i) o[db][i] = 0.f;
#pragma unroll 1
    for (int tt = 0; tt < 4; ++tt) {
        if (tt > 0) __syncthreads();
        tile_lstore<256, 8>(ksm, kreg, tid); tile_lstore<256, 32>(vsm, vreg, tid);
        __syncthreads();
        if (tt + 1 < 4) { tile_gload<256>(kb + (size_t)(tt + 1) * 64 * 2048, 2048, kreg, tid); tile_gload<256>(vb + (size_t)(tt + 1) * 64 * 2048, 2048, vreg, tid); }
        if (tt == 0) {
            float ss = 0.f;
#pragma unroll
            for (int d0 = 0; d0 < 16; ++d0) { const v4u u = *(LAS const v4u*)(qrow + d0 * 32);
                const float a = bflo(u.x), b2 = bfhi(u.x), c = bflo(u.y), d = bfhi(u.y), e = bflo(u.z), f = bfhi(u.z), g = bflo(u.w), k = bfhi(u.w);
                ss += ((a * a + b2 * b2) + (c * c + d * d)) + ((e * e + f * f) + (g * g + k * k)); }
            ss += __shfl_xor(ss, 32);
            const f32x4 p0 = sp0, p1 = sp1, p2 = sp2, p3 = sp3;
            const float rt = 1.0f / sqrtf((((p0.x + p0.y) + (p0.z + p0.w)) + ((p1.x + p1.y) + (p1.z + p1.w)) + ((p2.x + p2.y) + (p2.z + p2.w)) + ((p3.x + p3.y) + (p3.z + p3.w))) * (1.f / DM) + EPS);
            cq = 0.0625f * LOG2E * rt / sqrtf(rt * rt * ss * (1.f / 256.f) + EPS);
        }
        f32x16 s;
        {
            LAS const char* kp = ksm + (32 * kh + r) * KP + h * 16;
#pragma unroll
            for (int i = 0; i < 16; ++i) s[i] = 0.f;
#pragma unroll
            for (int d0 = 0; d0 < 16; ++d0) {
                const bf16x8 a0 = *(LAS const bf16x8*)(kp + d0 * 32), bq = *(LAS const bf16x8*)(qrow + d0 * 32);
                s = MFMA32(a0, bq, s);
                if ((d0 & 3) == 3) __builtin_amdgcn_sched_barrier(0);
            }
        }
        s = s * cq + nref;
#pragma unroll
        for (int i = 0; i < 16; ++i) s[i] = __builtin_amdgcn_exp2f(s[i]);
        { float rs = sum16(s); { const auto rr = __builtin_amdgcn_permlane32_swap(__float_as_uint(rs), __float_as_uint(rs), false, false); rs = __uint_as_float(rr[0]) + __uint_as_float(rr[1]); }
          *(LAS bf16x8*)xw = pack8a(s); *(LAS bf16x8*)(xw + 8192) = pack8b(s); xs[wave * 64 + lane] = rs; }
        __syncthreads();
        {
            const bf16x8 pb0 = *(LAS const bf16x8*)xr0, pb1 = *(LAS const bf16x8*)(xr0 + 8192), pb2 = *(LAS const bf16x8*)(xr0 + 1024), pb3 = *(LAS const bf16x8*)(xr0 + 1024 + 8192);
            l += xs[rb * 128 + lane] + xs[rb * 128 + 64 + lane];
            pv_tile_packed<256, 4>(vsm, pb0, pb1, pb2, pb3, o, 128 * kh, lane);
        }
        if (__any(l > 65536.0f)) {
            const unsigned e = l > 65536.0f ? (__float_as_uint(l) >> 23) - 127u : 0u;
            const float f2 = __uint_as_float((127u - e) << 23);
            nref -= (float)e; l *= f2;
#pragma unroll
            for (int db = 0; db < 4; ++db) o[db] *= f2;
        }
    }
    const float f = 1.0f / l;
    bf16* op = P.YMIX + (tok0 + 32 * rb + r) * DM + hd * 256 + 128 * kh + 4 * h;
#pragma unroll
    for (int db = 0; db < 4; ++db)
#pragma unroll
        for (int g4 = 0; g4 < 4; ++g4) { v2u w; w.x = pk2(o[db][4 * g4] * f, o[db][4 * g4 + 1] * f); w.y = pk2(o[db][4 * g4 + 2] * f, o[db][4 * g4 + 3] * f);
            *(v2u*)(op + 32 * db + 8 * g4) = w; }
}
DI void p7_xattn(const Ptrs& P, LAS unsigned char* lds, int bx, int G, int tid, int wave, int lane) {
    pg8::StaticOrder SO; SO.init(NTOK, DM, G, bx); pg8::Unit un;
    for (int ui = 0; SO.next(ui, un); ++ui) {
        const int b = un.pm >> 3, qt0 = (un.pm & 7) * 2;
        xattn_unit(P, lds, b, un.pn, qt0, tid, wave, lane); xattn_unit(P, lds, b, un.pn, qt0 + 1, tid, wave, lane);
    }
}

DI unsigned umax3(unsigned a, unsigned b, unsigned c) { return max(max(a, b), c); }
DI unsigned umax16(const unsigned* k) {
    return umax3(umax3(umax3(k[0], k[1], k[2]), umax3(k[3], k[4], k[5]), umax3(k[6], k[7], k[8])), umax3(umax3(k[9], k[10], k[11]), umax3(k[12], k[13], k[14]), k[15]), 0u);
}
DI unsigned pair_umax(unsigned m) { const auto rr = __builtin_amdgcn_permlane32_swap(m, m, false, false); return max((unsigned)rr[0], (unsigned)rr[1]); }
constexpr int PK_PITCH = 272;
constexpr int PK_SCR_OFF = 2 * 128 * PK_PITCH;
DI void p11_peer_topk(const Ptrs& P, LAS unsigned char* lds, int bx, int G, int tid, int wave, int lane) {
    const int r = lane & 31, h = lane >> 5;
    LAS char* ksm = (LAS char*)lds;
    LAS unsigned* tvl = (LAS unsigned*)(lds + PK_SCR_OFF + wave * 8192);
    LAS float* bsl = (LAS float*)(tvl + 1024); LAS int* bel = (LAS int*)(tvl + 1536);
    pg8::StaticOrder SO; SO.init(NTOK, 2048, G, bx); pg8::Unit un;
    for (int ui = 0; SO.next(ui, un); ++ui) {
        const int hd = un.pn;
        __syncthreads();
        {
            const bf16* kb = P.PKEYS + (size_t)hd * 2 * 128 * 128;
#pragma unroll
            for (int k = 0; k < 8; ++k) { const int id = tid + NTHR * k, row = id >> 4, ch = id & 15; *(LAS v4u*)(ksm + row * PK_PITCH + ch * 16) = *(const v4u*)(kb + row * 128 + ch * 8); }
        }
        __syncthreads();
        {
        const size_t tok = (size_t)un.pm * 256 + 32 * wave + r;
#pragma unroll 1
        for (int c = 0; c < 2; ++c) {
            bf16x8 qf[8];
#pragma unroll
            for (int d0 = 0; d0 < 8; ++d0) qf[d0] = *(const bf16x8*)(P.PQ + tok * 2048 + hd * 256 + c * 128 + 16 * d0 + 8 * h);
            unsigned key[64];
            unsigned h4 = 4u * (unsigned)h; asm volatile("" : "+v"(h4));
#pragma unroll
            for (int nb = 0; nb < 4; ++nb) {
                f32x16 sc;
#pragma unroll
                for (int i = 0; i < 16; ++i) sc[i] = 64.f;
                LAS const char* kp = ksm + (c * 128 + 32 * nb + r) * PK_PITCH + h * 16;
#pragma unroll
                for (int d0 = 0; d0 < 8; ++d0) sc = MFMA32(*(LAS const bf16x8*)(kp + d0 * 32), qf[d0], sc);
#pragma unroll
                for (int i = 0; i < 16; ++i) key[16 * nb + i] = ((__float_as_uint(sc[i]) & ~0x7Fu) | h4) | (unsigned)(32 * nb + (i & 3) + 8 * (i >> 2));
            }
            unsigned w = pair_umax(umax3(umax16(key), umax16(key + 16), umax3(umax16(key + 32), umax16(key + 48), 0u)));
            if (h == 0) tvl[(c * 16) * 32 + r] = w;
#pragma unroll 1
            for (int k = 1; k < 16; ++k) {
                unsigned d[64];
#pragma unroll
                for (int i = 0; i < 64; ++i) d[i] = key[i] - w;
                w += pair_umax(umax3(umax16(d), umax16(d + 16), umax3(umax16(d + 32), umax16(d + 48), 0u)));
                if (h == 0) tvl[(c * 16 + k) * 32 + r] = w;
            }
        }
        LDS_WAIT(); asm volatile("" ::: "memory");
        float t0[16], t1[16];
#pragma unroll
        for (int k = 0; k < 16; ++k) { t0[k] = __uint_as_float(tvl[k * 32 + r] & ~0x7Fu); t1[k] = __uint_as_float(tvl[(16 + k) * 32 + r] & ~0x7Fu); }
        unsigned cand[25];
        {
            int n = 0;
#pragma unroll
            for (int a = 0; a < 16; ++a)
#pragma unroll
                for (int b = 0; b < 16; ++b)
                    if ((a + 1) * (b + 1) <= 16) {
                        const unsigned key = (__float_as_uint(t0[a] + t1[b]) & ~0xFFu) | (unsigned)(a * 16 + b);
                        if ((n & 1) == 0) cand[n >> 1] = key; else cand[n >> 1] = h ? key : cand[n >> 1];
                        ++n;
                    }
        }
        unsigned w = 0u;
#pragma unroll
        for (int q = 0; q < 25; ++q) w = max(w, cand[q]);
        w = pair_umax(w);
#pragma unroll 1
        for (int k = 0; k < 16; ++k) {
            if (k > 0) { unsigned m = 0u;
#pragma unroll
                for (int q = 0; q < 25; ++q) m = max(m, cand[q] - w);
                w += pair_umax(m); }
            const int ia = (int)((w >> 4) & 15u), ib = (int)(w & 15u);
            const int e0 = (int)(tvl[ia * 32 + r] & 0x7Fu), e1 = (int)(tvl[(16 + ib) * 32 + r] & 0x7Fu);
            if (h == 0) { bsl[k * 32 + r] = __uint_as_float(w & ~0xFFu); bel[k * 32 + r] = e0 * 128 + e1; }
        }
        LDS_WAIT(); asm volatile("" ::: "memory");
        if (h == 0) {
            float bs[16]; int be[16];
#pragma unroll
            for (int k = 0; k < 16; ++k) { bs[k] = bsl[k * 32 + r]; be[k] = bel[k * 32 + r]; }
            const float* sp = P.SSP2 + tok * 16; const f32x4 p0 = *(const f32x4*)sp, p1 = *(const f32x4*)(sp + 4), p2 = *(const f32x4*)(sp + 8), p3 = *(const f32x4*)(sp + 12);
            const float rt = 1.0f / sqrtf((((p0.x + p0.y) + (p0.z + p0.w)) + ((p1.x + p1.y) + (p1.z + p1.w)) + ((p2.x + p2.y) + (p2.z + p2.w)) + ((p3.x + p3.y) + (p3.z + p3.w))) * (1.f / DM) + EPS);
            const float mx = bs[0]; float sum = 0.f;
#pragma unroll
            for (int k = 0; k < 16; ++k) { bs[k] = __expf((bs[k] - mx) * rt); sum += bs[k]; }
            const float inv = 1.0f / sum;
            int* ip = P.PIDX + tok * 128 + hd * 16; float* gp = P.PGATE + tok * 128 + hd * 16;
#pragma unroll
            for (int k4 = 0; k4 < 4; ++k4) {
                *(v4u*)(ip + 4 * k4) = (v4u){(unsigned)be[4 * k4], (unsigned)be[4 * k4 + 1], (unsigned)be[4 * k4 + 2], (unsigned)be[4 * k4 + 3]};
                *(f32x4*)(gp + 4 * k4) = (f32x4){bs[4 * k4] * inv, bs[4 * k4 + 1] * inv, bs[4 * k4 + 2] * inv, bs[4 * k4 + 3] * inv};
            }
        }
        LDS_WAIT(); asm volatile("" ::: "memory");
        }
    }
}

template <int CTRL> DI float dpp_mov(float v) { return __uint_as_float((unsigned)__builtin_amdgcn_update_dpp(0, (int)__float_as_uint(v), CTRL, 0xF, 0xF, true)); }
template <int CTRL> DI int dpp_movi(int v) { return __builtin_amdgcn_update_dpp(0, v, CTRL, 0xF, 0xF, true); }
DI int wave_sum_i(int v) {
    v += dpp_movi<0xB1>(v); v += dpp_movi<0x4E>(v); v += dpp_movi<0x141>(v); v += dpp_movi<0x140>(v);
    return (__builtin_amdgcn_readlane(v, 0) + __builtin_amdgcn_readlane(v, 16)) + (__builtin_amdgcn_readlane(v, 32) + __builtin_amdgcn_readlane(v, 48));
}
DI float wave_max_f(float v) {
    v = fmaxf(v, dpp_mov<0xB1>(v)); v = fmaxf(v, dpp_mov<0x4E>(v)); v = fmaxf(v, dpp_mov<0x141>(v)); v = fmaxf(v, dpp_mov<0x140>(v));
    return fmaxf(fmaxf(rlane(v, 0), rlane(v, 16)), fmaxf(rlane(v, 32), rlane(v, 48)));
}
DI float gelu_as(float v) {
    const float av = fabsf(v), t = __builtin_amdgcn_rcpf(av * 0.2316418882f + 1.0f);
    float q = t * 0.5307027145f + (-0.7265760135f); q = q * t + 0.7107068705f; q = q * t + (-0.142248368f); q = q * t + 0.127414796f; q = q * t;
    const float e = __builtin_amdgcn_exp2f((v * v) * (-0.72134752044f)), m = v * (q * e);
    return v < 0.f ? m : v - m;
}
DI int dot16_i8(const v4u& a, const v4u& b) {
    int c = __builtin_amdgcn_sdot4((int)a.x, (int)b.x, 0, false);
    c = __builtin_amdgcn_sdot4((int)a.y, (int)b.y, c, false); c = __builtin_amdgcn_sdot4((int)a.z, (int)b.z, c, false); c = __builtin_amdgcn_sdot4((int)a.w, (int)b.w, c, false);
    return c;
}
DI void axpy4_u8(float* acc, float a, unsigned u) {
    acc[0] += a * (float)(u & 0xffu); acc[1] += a * (float)((u >> 8) & 0xffu); acc[2] += a * (float)((u >> 16) & 0xffu); acc[3] += a * (float)(u >> 24);
}
DI unsigned quant4(float a, float b, float c, float d, float inv) {
    return ((unsigned)(int)__builtin_rintf(a * inv) & 0xffu) | (((unsigned)(int)__builtin_rintf(b * inv) & 0xffu) << 8) | (((unsigned)(int)__builtin_rintf(c * inv) & 0xffu) << 16) | (((unsigned)(int)__builtin_rintf(d * inv) & 0xffu) << 24);
}
typedef float f32x2 __attribute__((ext_vector_type(2)));
constexpr int PEER_SLICE_SHIFT = 7, PEER_NSLICE = NEXP >> PEER_SLICE_SHIFT;
constexpr int P12_WAVE_LDS = 8192 + 512;
DI void axpy16_fp4(f32x2* acc, float a, const v4u& rw) {
    const v2u uq = {rw.z, rw.w};
    const f32x2 aa = {a, a};
    f32x2 t[4];
    t[0] = __builtin_amdgcn_cvt_scalef32_pk_f32_fp4(uq.x, 1.0f, 0); t[1] = __builtin_amdgcn_cvt_scalef32_pk_f32_fp4(uq.x, 1.0f, 1); t[2] = __builtin_amdgcn_cvt_scalef32_pk_f32_fp4(uq.x, 1.0f, 2); t[3] = __builtin_amdgcn_cvt_scalef32_pk_f32_fp4(uq.x, 1.0f, 3);
    asm volatile("" : "+v"(t[0]), "+v"(t[1]), "+v"(t[2]), "+v"(t[3]));
#pragma unroll
    for (int j = 0; j < 4; ++j) acc[j] = __builtin_elementwise_fma(aa, t[j], acc[j]);
    t[0] = __builtin_amdgcn_cvt_scalef32_pk_f32_fp4(uq.y, 1.0f, 0); t[1] = __builtin_amdgcn_cvt_scalef32_pk_f32_fp4(uq.y, 1.0f, 1); t[2] = __builtin_amdgcn_cvt_scalef32_pk_f32_fp4(uq.y, 1.0f, 2); t[3] = __builtin_amdgcn_cvt_scalef32_pk_f32_fp4(uq.y, 1.0f, 3);
    asm volatile("" : "+v"(t[0]), "+v"(t[1]), "+v"(t[2]), "+v"(t[3]));
#pragma unroll
    for (int j = 0; j < 4; ++j) acc[4 + j] = __builtin_elementwise_fma(aa, t[j], acc[4 + j]);
}
DI int dot16_n4(const v4u& hq, const v4u& dq) {
    int c = __builtin_amdgcn_sdot4((int)hq.x, (int)((dq.x << 4) & 0xF0F0F0F0u), 0, false);
    c = __builtin_amdgcn_sdot4((int)hq.y, (int)(dq.x & 0xF0F0F0F0u), c, false);
    c = __builtin_amdgcn_sdot4((int)hq.z, (int)((dq.y << 4) & 0xF0F0F0F0u), c, false);
    c = __builtin_amdgcn_sdot4((int)hq.w, (int)(dq.y & 0xF0F0F0F0u), c, false);
    return c;
}
DI float reduce4_classes_f(float p0, float p1, float p2, float p3, bool b0, bool b1) {
    float x01 = b0 ? p1 : p0; const float y01 = b0 ? p0 : p1; x01 += dpp_mov<0xB1>(y01);
    float x23 = b0 ? p3 : p2; const float y23 = b0 ? p2 : p3; x23 += dpp_mov<0xB1>(y23);
    float w = b1 ? x23 : x01; const float w2 = b1 ? x01 : x23; w += dpp_mov<0x4E>(w2);
    w += dpp_mov<0x124>(w); w += dpp_mov<0x128>(w);
    { const auto r = __builtin_amdgcn_permlane16_swap(__float_as_uint(w), __float_as_uint(w), false, false); w = __uint_as_float(r[0]) + __uint_as_float(r[1]); }
    { const auto r = __builtin_amdgcn_permlane32_swap(__float_as_uint(w), __float_as_uint(w), false, false); w = __uint_as_float(r[0]) + __uint_as_float(r[1]); }
    return w;
}
template <int MODE>
DI void p12_peer_gather(const Ptrs& P, LAS unsigned char* lds, const float* obase, float* odst, int gw, int NGW, int wave, int lane) {
    LAS v4u* sorted = (LAS v4u*)(lds + wave * P12_WAVE_LDS); LAS unsigned* hist = (LAS unsigned*)(lds + wave * P12_WAVE_LDS + 8192);
    const bool b0 = (lane & 1) != 0, b1 = (lane & 2) != 0; const int cls = lane & 3;
    const int l16 = 16 * lane, l4 = 1024 + 4 * lane;
    const __amdgpu_buffer_rsrc_t rtab = __builtin_amdgcn_make_buffer_rsrc((void*)P.PDOWN, 0, NEXP * PEER_ROW_BYTES, 0x00020000);
    for (int tg = gw; tg < NTOK / 4; tg += NGW) {
        v4u hq[4]; f32x2 acc[4][8]; float asl[4]; float shv = 0.f;
#pragma unroll 1
        for (int u = 0; u < 4; ++u) {
            const size_t o = ((size_t)tg * 4 + u) * 128 + lane;
            const int i0 = P.PIDX[o], i1 = P.PIDX[o + 64];
            const float ga = P.PGATE[o], gb = P.PGATE[o + 64];
            hist[lane] = 0u; hist[64 + lane] = 0u;
            LDS_WAIT(); asm volatile("" ::: "memory");
            const unsigned r0 = __hip_atomic_fetch_add(&hist[i0 >> PEER_SLICE_SHIFT], 1u, __ATOMIC_RELAXED, __HIP_MEMORY_SCOPE_WORKGROUP);
            const unsigned r1 = __hip_atomic_fetch_add(&hist[i1 >> PEER_SLICE_SHIFT], 1u, __ATOMIC_RELAXED, __HIP_MEMORY_SCOPE_WORKGROUP);
            LDS_WAIT(); asm volatile("" ::: "memory");
            const unsigned c0 = hist[2 * lane], c1 = hist[2 * lane + 1]; unsigned incl = c0 + c1;
#pragma unroll
            for (int s2 = 1; s2 < 64; s2 <<= 1) { const unsigned t = __shfl_up(incl, s2); if (lane >= s2) incl += t; }
            const unsigned excl = incl - (c0 + c1);
            LDS_WAIT(); asm volatile("" ::: "memory");
            hist[2 * lane] = excl; hist[2 * lane + 1] = excl + c0;
            LDS_WAIT(); asm volatile("" ::: "memory");
            const unsigned p0 = hist[i0 >> PEER_SLICE_SHIFT] + r0, p1 = hist[i1 >> PEER_SLICE_SHIFT] + r1;
            sorted[u * 128 + p0] = (v4u){__float_as_uint(ga), 0u, (unsigned)i0, 0u};
            sorted[u * 128 + p1] = (v4u){__float_as_uint(gb), 0u, (unsigned)i1, 0u};
            LDS_WAIT(); asm volatile("" ::: "memory");
        }
#pragma unroll
        for (int u = 0; u < 4; ++u) { const size_t t = (size_t)tg * 4 + u;
            const v4u hb8 = *(const v4u*)(P.H8 + t * DM + 16 * lane);
            const float* sp = P.SSP2 + t * 16; const f32x4 p0 = *(const f32x4*)sp, p1 = *(const f32x4*)(sp + 4), p2 = *(const f32x4*)(sp + 8), p3 = *(const f32x4*)(sp + 12);
            const float rt = 1.0f / sqrtf((((p0.x + p0.y) + (p0.z + p0.w)) + ((p1.x + p1.y) + (p1.z + p1.w)) + ((p2.x + p2.y) + (p2.z + p2.w)) + ((p3.x + p3.y) + (p3.z + p3.w))) * (1.f / DM) + EPS);
            shv = (cls == u) ? P.SH[t] * (1.0f / 16.0f) * rt : shv;
            hq[u].x = __builtin_amdgcn_perm(hb8.y, hb8.x, 0x06040200u); hq[u].y = __builtin_amdgcn_perm(hb8.y, hb8.x, 0x07050301u);
            hq[u].z = __builtin_amdgcn_perm(hb8.w, hb8.z, 0x06040200u); hq[u].w = __builtin_amdgcn_perm(hb8.w, hb8.z, 0x07050301u);
            asl[u] = 0.f;
#pragma unroll
            for (int j = 0; j < 8; ++j) acc[u][j] = (f32x2){0.f, 0.f}; }
        v4u rwA[4], rwB[4]; unsigned scA[4], scB[4]; float gtA, gtB;
#define P12_FETCH(BI, RW, SC, GT) { GT = *(LAS const float*)((LAS const char*)sorted + (cls * 128 + (BI)) * 16); \
        _Pragma("unroll") for (int k = 0; k < 4; ++k) { const unsigned w0 = (unsigned)__builtin_amdgcn_readfirstlane((int)sorted[k * 128 + (BI)].z) & (MODE == 1 ? 63u : 0xffffffffu); \
        const int ro = (int)(w0 * (unsigned)PEER_ROW_BYTES);               \
        RW[k] = __builtin_bit_cast(v4u, __builtin_amdgcn_raw_buffer_load_b128(rtab, l16, ro, 0)); SC[k] = (unsigned)__builtin_amdgcn_raw_buffer_load_b32(rtab, l4, ro, 0); } }
#define P12_COMPUTE(RW, SC, GT) if (MODE == 2) { _Pragma("unroll") for (int k = 0; k < 4; ++k) { asl[k] += __uint_as_float((RW[k].x ^ RW[k].y) ^ (RW[k].z ^ RW[k].w) ^ SC[k]); } } else { \
        const float w_ = reduce4_classes_f((float)dot16_n4(hq[0], RW[0]) * bflo(SC[0]), (float)dot16_n4(hq[1], RW[1]) * bflo(SC[1]), \
                                           (float)dot16_n4(hq[2], RW[2]) * bflo(SC[2]), (float)dot16_n4(hq[3], RW[3]) * bflo(SC[3]), b0, b1); \
        const float a_ = gelu_as(w_ * shv) * GT; \
        axpy16_fp4(acc[0], dpp_mov<0x00>(a_) * bfhi(SC[0]), RW[0]); axpy16_fp4(acc[1], dpp_mov<0x55>(a_) * bfhi(SC[1]), RW[1]); \
        axpy16_fp4(acc[2], dpp_mov<0xAA>(a_) * bfhi(SC[2]), RW[2]); axpy16_fp4(acc[3], dpp_mov<0xFF>(a_) * bfhi(SC[3]), RW[3]); }
        P12_FETCH(0, rwA, scA, gtA)
#pragma unroll 1
        for (int bi = 0; bi < 128; bi += 2) {
            P12_FETCH(bi + 1, rwB, scB, gtB)
            P12_COMPUTE(rwA, scA, gtA)
            if (bi + 2 < 128) P12_FETCH(bi + 2, rwA, scA, gtA)
            P12_COMPUTE(rwB, scB, gtB)
        }
#undef P12_FETCH
#undef P12_COMPUTE
#pragma unroll
        for (int u = 0; u < 4; ++u) { const size_t t = (size_t)tg * 4 + u;
            float* op = odst + t * DM + 16 * lane;
            const v4u xa = *(const v4u*)(P.HN + t * DM + 16 * lane), xb = *(const v4u*)(P.HN + t * DM + 16 * lane + 8);
            const float pz = (MODE == 2) ? asl[u] * 1e-30f : 0.f;
            *(f32x4*)(op) = (f32x4){bflo(xa.x) + acc[u][0].x + pz, bfhi(xa.x) + acc[u][0].y, bflo(xa.y) + acc[u][1].x, bfhi(xa.y) + acc[u][1].y};
            *(f32x4*)(op + 4) = (f32x4){bflo(xa.z) + acc[u][2].x, bfhi(xa.z) + acc[u][2].y, bflo(xa.w) + acc[u][3].x, bfhi(xa.w) + acc[u][3].y};
            *(f32x4*)(op + 8) = (f32x4){bflo(xb.x) + acc[u][4].x, bfhi(xb.x) + acc[u][4].y, bflo(xb.y) + acc[u][5].x, bfhi(xb.y) + acc[u][5].y};
            *(f32x4*)(op + 12) = (f32x4){bflo(xb.z) + acc[u][6].x, bfhi(xb.z) + acc[u][6].y, bflo(xb.w) + acc[u][7].x, bfhi(xb.w) + acc[u][7].y}; }
    }
}

struct Args { const float* in[25]; float* out; unsigned char* ws; int ph_lo, ph_hi; };
__global__ void __launch_bounds__(NTHR, 2) layer_fwd(Args args) {
    extern __shared__ __attribute__((aligned(16))) unsigned char lds_raw[];
    LAS unsigned char* lds = (LAS unsigned char*)lds_raw;
    const int tid = threadIdx.x, lane = tid & 63, wave = __builtin_amdgcn_readfirstlane(tid >> 6);
    const int G = gridDim.x; const int bx = blockIdx.x;
    const int vcu = (G % 8 == 0) ? (bx % 8) * (G / 8) + bx / 8 : bx;
    const int gw = vcu * NWAVES + wave, NGW = G * NWAVES;
    unsigned char* ws = args.ws;
    Ptrs P;
    P.x = args.in[0]; P.mem = args.in[1]; P.mix_norm_w = args.in[2]; P.w_in = args.in[3]; P.conv_w = args.in[4]; P.conv_b = args.in[5]; P.cmp_pe = args.in[6];
    P.cmp_w1 = args.in[7]; P.cmp_w2 = args.in[8]; P.q_norm_w = args.in[9]; P.k_norm_w = args.in[10]; P.w_out = args.in[11]; P.xattn_norm_w = args.in[12];
    P.mem_norm_w = args.in[13]; P.xq = args.in[14]; P.xk = args.in[15]; P.xv = args.in[16]; P.xo = args.in[17]; P.xq_norm_w = args.in[18]; P.xk_norm_w = args.in[19];
    P.ffn_norm_w = args.in[20]; P.peer_wq = args.in[21]; P.peer_keys = args.in[22]; P.peer_down = args.in[23]; P.peer_up = args.in[24];
    P.out = args.out;
    P.WIN = (bf16*)(ws + WS_WIN); P.WOUT = (bf16*)(ws + WS_WOUT); P.XQT = (bf16*)(ws + WS_XQT); P.XKVT = (bf16*)(ws + WS_XKVT); P.XOT = (bf16*)(ws + WS_XOT);
    P.PWQT = (bf16*)(ws + WS_PWQT); P.PKEYS = (bf16*)(ws + WS_PKEYS); P.KCMP = (bf16*)(ws + WS_KCMP); P.VCMP = (bf16*)(ws + WS_VCMP); P.MN = (bf16*)(ws + WS_MN);
    P.XKV = (bf16*)(ws + WS_XKV); P.PDOWN = ws + WS_PDOWN; P.PUP = ws + WS_PUP; P.PSC = (float*)(ws + WS_PSC); P.CW1T = (bf16*)(ws + WS_CW1T); P.SSP1 = (float*)(ws + WS_SSP1); P.SSP2 = (float*)(ws + WS_SSP2); P.SA1 = (float*)(ws + WS_SA1); P.SB1 = (float*)(ws + WS_SB1); P.CMX = (float*)(ws + WS_CMX); P.HN8 = ws + WS_HN; P.WIN8 = ws + WS_WIN; P.H8 = ws + WS_PUP; P.PWQ8 = ws + WS_PWQT; P.SH = (float*)(ws + WS_SH); P.SBQ = (float*)(ws + WS_SBQ); P.CMXQ = (float*)(ws + WS_CMXQ); P.HN = (bf16*)(ws + WS_HN); P.YMIX = (bf16*)(ws + WS_YMIX);
    P.PROJ = (bf16*)(ws + WS_PROJ); P.XQ = (bf16*)(ws + WS_XQ); P.PQ = (bf16*)(ws + WS_PQ); P.B1P = (float*)(ws + WS_B1P); P.PGATE = (float*)(ws + WS_PGATE); P.PIDX = (int*)(ws + WS_PIDX);

    volatile LAS unsigned* MISC = (volatile LAS unsigned*)(lds + MISC_OFF);
    if (tid < 64) MISC[tid] = 0u;
    __syncthreads();
    const int lo = args.ph_lo, hi = args.ph_hi;
    const bool multi = (hi - lo) > 1;
    XcdBarrier bar; bar.bar = (unsigned*)(ws + WS_CTL) + CW_BAR; bar.x = 0; bar.st = MISC + 8;
    if (multi) bar = xcd_barrier_post((unsigned*)(ws + WS_CTL) + CW_BAR, MISC + 8);
#ifndef ONLY_PHASE
#define ONLY_PHASE -1
#endif
#define IN(k) ((ONLY_PHASE < 0 || (k) == ONLY_PHASE) && lo <= (k) && (k) < hi)
#define SEAM(k) do { if (IN(k) && IN((k) + 1)) xcd_barrier(bar); } while (0)

#ifndef REPMASK
#define REPMASK 0
#endif
#ifndef P12_PROBE_MODE
#define P12_PROBE_MODE 0
#endif
#ifndef P2_PROBE_MODE
#define P2_PROBE_MODE 0
#endif
#ifndef P3_PROBE_MODE
#define P3_PROBE_MODE 0
#endif
#ifndef P0_PROBE_MASK
#define P0_PROBE_MASK 7
#endif
#define NREP(k) (((REPMASK) >> (k)) & 1 ? 2 : 1)
    float* const dummy = (float*)(ws + WS_PROJ);
    if (IN(0)) { for (int rep = 0; rep < NREP(0); ++rep) { const int pm = (rep + 1 < NREP(0)) ? P0_PROBE_MASK : 7; p0_prologue(P, lds, gw, NGW, wave, lane, 0, pm); if (multi && pm == 7) xcd_barrier(bar); p0_prologue(P, lds, gw, NGW, wave, lane, 1, pm); } } SEAM(0);
    if (IN(1)) { for (int rep = 0; rep < NREP(1); ++rep) {
        { pg8::Gemm g{(const bf16*)P.HN8, (const bf16*)P.WIN8, NTOK, INP, DM / 2}; pg8::StaticOrder S; S.init(NTOK, INP, G, bx);
          pg8::EpiI8Bf16 E{P.PROJ, INP, P.SA1, P.SB1};
          pg8::gemm_phase<pg8::EpiI8Bf16, pg8::StaticOrder, true, true, true>(lds, g, S, E); }
 }
    } SEAM(1);
    if (IN(2)) { p2_misc<true, 0>(P, lds, vcu, G, tid, wave, lane); if (NREP(2) > 1) p2_misc<false, P2_PROBE_MODE>(P, lds, vcu, G, tid, wave, lane); } SEAM(2);
    if (IN(3)) { xk_norm(P, gw, NGW, lane); for (int rep = 0; rep < NREP(3); ++rep) { if (rep + 1 < NREP(3)) p3_nsa<P3_PROBE_MODE>(P, lds, vcu, G, tid, wave, lane); else p3_nsa<0>(P, lds, vcu, G, tid, wave, lane); } } SEAM(3);
    if (IN(4)) { for (int rep = 0; rep < NREP(4); ++rep) { pg8::Gemm g{P.YMIX, P.WOUT, NTOK, DM, DM}; pg8::StaticOrder S; S.init(NTOK, DM, G, bx);
        pg8::EpiResBf16N<false> E{P.x, P.HN, P.SSP1, DM};
        pg8::gemm_phase<pg8::EpiResBf16N<false>, pg8::StaticOrder, true, true>(lds, g, S, E); } } SEAM(4);
    if (IN(6)) { for (int rep = 0; rep < NREP(6); ++rep) { pg8::Gemm g{P.HN, P.XQT, NTOK, DM, DM}; pg8::StaticOrder S; S.init(NTOK, DM, G, bx);
        pg8::EpiBf16<0> E{P.XQ, DM, nullptr, 0, 0, 1.f};
        pg8::gemm_phase<pg8::EpiBf16<0>, pg8::StaticOrder, true, true>(lds, g, S, E); }
        asm volatile("s_waitcnt vmcnt(0)" ::: "memory"); __syncthreads();
        for (int rep = 0; rep < NREP(7); ++rep) p7_xattn(P, lds, bx, G, tid, wave, lane); } SEAM(7);
    if (IN(8)) { for (int rep = 0; rep < NREP(8); ++rep) { pg8::Gemm g{P.YMIX, P.XOT, NTOK, DM, DM}; pg8::StaticOrder S; S.init(NTOK, DM, G, bx);
        pg8::EpiResBf16N<true> E{P.HN, (rep + 1 < NREP(8)) ? (bf16*)dummy : P.HN, P.SSP2, DM};
        pg8::gemm_phase<pg8::EpiResBf16N<true>, pg8::StaticOrder, true, true>(lds, g, S, E); } } SEAM(8);
    if (IN(9)) { for (int rep = 0; rep < NREP(9); ++rep) p9_quant_h(P, gw, NGW, lane); } SEAM(9);
    if (IN(10)) { for (int rep = 0; rep < NREP(10); ++rep) { pg8::Gemm g{(const bf16*)P.H8, (const bf16*)P.PWQ8, NTOK, 2048, DM / 2}; pg8::StaticOrder S; S.init(NTOK, 2048, G, bx);
        pg8::EpiI8Bf16 E{P.PQ, 2048, P.SH, P.SBQ};
        pg8::gemm_phase<pg8::EpiI8Bf16, pg8::StaticOrder, true, true, true>(lds, g, S, E); }
        asm volatile("s_waitcnt vmcnt(0)" ::: "memory"); __syncthreads();
        for (int rep = 0; rep < NREP(11); ++rep) p11_peer_topk(P, lds, bx, G, tid, wave, lane); } SEAM(11);
    if (IN(12)) { for (int rep = 0; rep < NREP(12); ++rep) if (rep + 1 < NREP(12)) p12_peer_gather<P12_PROBE_MODE>(P, lds, P.out, dummy, gw, NGW, wave, lane); else p12_peer_gather<0>(P, lds, P.out, P.out, gw, NGW, wave, lane); }
#undef IN
#undef SEAM
}

#ifndef MK_PER_PHASE
#define MK_PER_PHASE 0
#endif
extern "C" void kernel_launch(void* const* d_in, const int* in_sizes, int n_in, void* d_out, int out_size, void* d_ws, size_t ws_size, hipStream_t stream) {
    static int grid = 0;
    if (grid == 0) {
        if (n_in != 25 || in_sizes[0] != NTOK * DM || out_size != NTOK * DM || ws_size < WS_END) {
            fprintf(stderr, "kernel_launch: unexpected shapes (n_in %d, in0 %d, out %d, ws %zu); nothing launched\n", n_in, n_in > 0 ? in_sizes[0] : -1, out_size, ws_size); grid = -1; return; }
        int dev = 0, cus = 0, per_cu = 0;
        if (hipGetDevice(&dev) != hipSuccess || hipDeviceGetAttribute(&cus, hipDeviceAttributeMultiprocessorCount, dev) != hipSuccess) { grid = -1; return; }
        if (hipFuncSetAttribute((const void*)layer_fwd, hipFuncAttributeMaxDynamicSharedMemorySize, LDS_BYTES) != hipSuccess) { fprintf(stderr, "kernel_launch: hipFuncSetAttribute failed\n"); grid = -1; return; }
        if (hipOccupancyMaxActiveBlocksPerMultiprocessor(&per_cu, (const void*)layer_fwd, NTHR, LDS_BYTES) != hipSuccess || per_cu < 1)
            fprintf(stderr, "kernel_launch: note: occupancy query reports %d workgroups per CU\n", per_cu);
        (void)hipGetLastError();
        grid = cus;
        if (grid != 256) fprintf(stderr, "kernel_launch: note: %d CUs\n", grid);
    }
    if (grid < 0) return;
    if (hipMemsetAsync((char*)d_ws + WS_CTL, 0, CTL_ZERO_BYTES, stream) != hipSuccess) return;
    Args a{};
    for (int i = 0; i < 25; ++i) a.in[i] = (const float*)d_in[i];
    a.out = (float*)d_out; a.ws = (unsigned char*)d_ws;
#if MK_PER_PHASE
    for (int p = 0; p < NPHASE; ++p) { a.ph_lo = p; a.ph_hi = p + 1; hipLaunchKernelGGL(layer_fwd, dim3(grid), dim3(NTHR), LDS_BYTES, stream, a); }
#else
    a.ph_lo = 0; a.ph_hi = NPHASE; hipLaunchKernelGGL(layer_fwd, dim3(grid), dim3(NTHR), LDS_BYTES, stream, a);
#endif
}
```

```cpp
#include <hip/hip_runtime.h>
#include <cstdio>
#include <cstdint>
#include <cmath>
namespace pg8 {
#define PG8_LAS __attribute__((address_space(3)))
typedef unsigned short bf16_t;
typedef short bf16x8 __attribute__((ext_vector_type(8)));
typedef float f32x4 __attribute__((ext_vector_type(4)));
typedef unsigned u32x4 __attribute__((ext_vector_type(4)));
constexpr int BM = 256, BK = 64, HALF = 128, HTB = HALF * BK * 2  , STAGE_BYTES = 8 * HTB, NXCD = 8, WGM = 8;

__host__ __device__ __forceinline__ int lds_byte(int r, int c) { const int st = (r >> 4) * 2 + (c >> 5), rr = r & 15, cc = c & 31, ob = rr * 64 + cc * 2; return st * 1024 + (ob ^ (((ob >> 9) & 1) << 5)); }
__host__ __device__ __forceinline__ void stage_rc(int b, int& R, int& C) { const int st = b / 1024, sb = b % 1024, swz = sb ^ (((sb >> 9) & 1) << 5); R = (st >> 1) * 16 + swz / 64; C = (st & 1) * 32 + (swz % 64) / 2; }
__host__ __device__ __forceinline__ int perm32(int rho) { const int n = rho >> 4, i = rho & 15; return 8 * (i >> 2) + 4 * n + (i & 3); }

struct Unit { int pm, pn; };
struct Gemm { const bf16_t* A; const bf16_t* Bt; int M, N, K; };

struct StaticOrder {
    int nM, nN, nwg, G, c;
    __host__ __device__ void init(int M, int N, int G_, int c_) { nM = M / BM; nN = N / BM; nwg = nM * nN; G = G_; c = c_; }
    __host__ __device__ bool next(int i, Unit& u) const {
        const long L = (long)i * G + c; if (L >= nwg) return false;
        int wgid = (int)L; { const int q = nwg / NXCD, r = nwg % NXCD, xcd = wgid % NXCD, off = wgid / NXCD; wgid = (xcd < r ? xcd * (q + 1) : r * (q + 1) + (xcd - r) * q) + off; }
        const int nig = WGM * nN, gid = wgid / nig, fm = gid * WGM, gsz = (nM - fm) < WGM ? (nM - fm) : WGM;
        u.pm = fm + ((wgid % nig) % gsz); u.pn = (wgid % nig) / gsz; return true;
    }
    __device__ __forceinline__ void a_ready(const Unit&) const {}
    __device__ __forceinline__ void done(const Unit&) const {}
};

struct ProjOrder {
    int nM, G, v;
    __host__ __device__ void init(int M, int G_, int v_) { nM = M / BM; G = G_; v = v_; }
    __host__ __device__ bool next(int i, Unit& u) const {
        const int round = i / 6, k = i - 6 * round, mt = (v >> 1) + round * (G >> 1);
        if (mt >= nM) return false;
        u.pm = mt; u.pn = (v & 1) ? 6 + k : (k % 3) * 2 + k / 3; return true;
    }
    __device__ __forceinline__ void a_ready(const Unit&) const {}
    __device__ __forceinline__ void done(const Unit&) const {}
};

__device__ __forceinline__ unsigned cvt_pk_bf16(float lo, float hi) { unsigned r; asm volatile("v_cvt_pk_bf16_f32 %0, %1, %2" : "=v"(r) : "v"(lo), "v"(hi)); return r; }
typedef float f32x2 __attribute__((ext_vector_type(2)));
__device__ __forceinline__ f32x2 gelu_pk(f32x2 v) {
    const f32x2 av = __builtin_elementwise_abs(v), d = av * 0.2316418882f + 1.0f;
    f32x2 t; t.x = __builtin_amdgcn_rcpf(d.x); t.y = __builtin_amdgcn_rcpf(d.y);
    f32x2 q = t * 0.5307027145f + (-0.7265760135f); q = q * t + 0.7107068705f; q = q * t + (-0.142248368f); q = q * t + 0.127414796f; q = q * t;
    const f32x2 s = (v * v) * (-0.72134752044f);
    f32x2 e; e.x = __builtin_amdgcn_exp2f(s.x); e.y = __builtin_amdgcn_exp2f(s.y);
    const f32x2 m = v * (q * e), r = v - m;
    f32x2 o; o.x = v.x < 0.f ? m.x : r.x; o.y = v.y < 0.f ? m.y : r.y; return o;
}

template <int ACT  > struct EpiBf16 {
    static constexpr bool PERM = true, AFTER_DRAIN = false; static_assert(ACT == 0 || ACT == 1, "EpiBf16: ACT is 0 (none) or 1 (gelu_pk)");
    bf16_t* O; int ldc; const float* bias; int split_cols; size_t split_stride; float scale0;
    __device__ __forceinline__ void operator()(const f32x4 (&acc)[2][2][4][2], const Unit& u, int wr, int wc, int fr, int fq) const {
        const int row0 = u.pm * BM + wr * 64 + fr; int colt = u.pn * BM; bf16_t* base = O;
        float sc = 1.f; if (split_cols) { const int t = colt / split_cols; base += (size_t)t * split_stride; colt -= t * split_cols; if (t == 0) sc = scale0; }
        const int col0 = colt + wc * 32 + 8 * fq, bcol0 = u.pn * BM + wc * 32 + 8 * fq;
        f32x4 bv[2][2];
#pragma unroll
        for (int bj = 0; bj < 2; ++bj)
#pragma unroll
            for (int n = 0; n < 2; ++n) bv[bj][n] = bias ? *(const f32x4*)(bias + bcol0 + bj * HALF + 4 * n) : (f32x4){0.f, 0.f, 0.f, 0.f};
#pragma unroll
        for (int ai = 0; ai < 2; ++ai)
#pragma unroll
            for (int m = 0; m < 4; ++m) { bf16_t* rowp = base + (size_t)(row0 + ai * HALF + m * 16) * ldc + col0;
#pragma unroll
                for (int bj = 0; bj < 2; ++bj) { f32x4 v0 = acc[ai][bj][m][0] + bv[bj][0], v1 = acc[ai][bj][m][1] + bv[bj][1];
                    if (ACT == 1) { f32x2 a = gelu_pk((f32x2){v0[0], v0[1]}), b = gelu_pk((f32x2){v0[2], v0[3]}), c = gelu_pk((f32x2){v1[0], v1[1]}), d = gelu_pk((f32x2){v1[2], v1[3]});
                        v0 = (f32x4){a.x, a.y, b.x, b.y}; v1 = (f32x4){c.x, c.y, d.x, d.y}; }
                    v0 = v0 * sc; v1 = v1 * sc; u32x4 w; w.x = cvt_pk_bf16(v0[0], v0[1]); w.y = cvt_pk_bf16(v0[2], v0[3]); w.z = cvt_pk_bf16(v1[0], v1[1]); w.w = cvt_pk_bf16(v1[2], v1[3]);
                    *(u32x4*)(rowp + bj * HALF) = w; } }
    }
};

struct EpiResF32 {
    static constexpr bool PERM = false, AFTER_DRAIN = false;
    const float* base; float* out; int ldc;
    __device__ __forceinline__ void operator()(const f32x4 (&acc)[2][2][4][2], const Unit& u, int wr, int wc, int fr, int fq) const {
        const int row0 = u.pm * BM + wr * 64 + fr, col0 = u.pn * BM + wc * 32 + 4 * fq;
#pragma unroll
        for (int ai = 0; ai < 2; ++ai)
#pragma unroll
            for (int m = 0; m < 4; ++m) { const size_t off = (size_t)(row0 + ai * HALF + m * 16) * ldc + col0;
#pragma unroll
                for (int bj = 0; bj < 2; ++bj)
#pragma unroll
                    for (int n = 0; n < 2; ++n) { const f32x4 b = *(const f32x4*)(base + off + bj * HALF + n * 16); *(f32x4*)(out + off + bj * HALF + n * 16) = b + acc[ai][bj][m][n]; } }
    }
};
template <bool BASE_BF16> struct EpiResBf16N {
    static constexpr bool PERM = false, AFTER_DRAIN = false;
    const void* base; bf16_t* xn; float* ssp; int ldc;
    __device__ __forceinline__ void operator()(const f32x4 (&acc)[2][2][4][2], const Unit& u, int wr, int wc, int fr, int fq) const {
        typedef unsigned u32x2 __attribute__((ext_vector_type(2)));
        const int row0 = u.pm * BM + wr * 64 + fr, col0 = u.pn * BM + wc * 32 + 4 * fq;
#pragma unroll
        for (int ai = 0; ai < 2; ++ai)
#pragma unroll
            for (int m = 0; m < 4; ++m) { const int row = row0 + ai * HALF + m * 16; const size_t off = (size_t)row * ldc + col0; float ss = 0.f;
#pragma unroll
                for (int bj = 0; bj < 2; ++bj)
#pragma unroll
                    for (int n = 0; n < 2; ++n) { f32x4 b;
                        if (BASE_BF16) { const u32x2 r = *(const u32x2*)((const bf16_t*)base + off + bj * HALF + n * 16);
                            b = (f32x4){__uint_as_float(r.x << 16), __uint_as_float(r.x & 0xffff0000u), __uint_as_float(r.y << 16), __uint_as_float(r.y & 0xffff0000u)}; }
                        else b = *(const f32x4*)((const float*)base + off + bj * HALF + n * 16);
                        const f32x4 v = b + acc[ai][bj][m][n];
                        ss += (v[0] * v[0] + v[1] * v[1]) + (v[2] * v[2] + v[3] * v[3]);
                        u32x2 w; w.x = cvt_pk_bf16(v[0], v[1]); w.y = cvt_pk_bf16(v[2], v[3]); *(u32x2*)(xn + off + bj * HALF + n * 16) = w; }
                ss += __shfl_xor(ss, 16); ss += __shfl_xor(ss, 32);
                if (fq == 0) ssp[(size_t)row * 16 + u.pn * 4 + wc] = ss; }
    }
};
struct EpiI8Bf16 {
    static constexpr bool PERM = true, AFTER_DRAIN = false;
    bf16_t* O; int ldc; const float* sa; const float* sb;
    __device__ __forceinline__ void operator()(const f32x4 (&acc)[2][2][4][2], const Unit& u, int wr, int wc, int fr, int fq) const {
        typedef int i32x4 __attribute__((ext_vector_type(4)));
        const int row0 = u.pm * BM + wr * 64 + fr, col0 = u.pn * BM + wc * 32 + 8 * fq;
        f32x4 sbv[2][2];
#pragma unroll
        for (int bj = 0; bj < 2; ++bj)
#pragma unroll
            for (int n = 0; n < 2; ++n) sbv[bj][n] = *(const f32x4*)(sb + col0 + bj * HALF + 4 * n);
#pragma unroll
        for (int ai = 0; ai < 2; ++ai)
#pragma unroll
            for (int m = 0; m < 4; ++m) { const int row = row0 + ai * HALF + m * 16; const float sr = sa[row]; bf16_t* rowp = O + (size_t)row * ldc + col0;
#pragma unroll
                for (int bj = 0; bj < 2; ++bj) {
                    const f32x4 v0 = __builtin_convertvector(__builtin_bit_cast(i32x4, acc[ai][bj][m][0]), f32x4) * sr * sbv[bj][0];
                    const f32x4 v1 = __builtin_convertvector(__builtin_bit_cast(i32x4, acc[ai][bj][m][1]), f32x4) * sr * sbv[bj][1];
                    u32x4 w; w.x = cvt_pk_bf16(v0[0], v0[1]); w.y = cvt_pk_bf16(v0[2], v0[3]); w.z = cvt_pk_bf16(v1[0], v1[1]); w.w = cvt_pk_bf16(v1[2], v1[3]);
                    *(u32x4*)(rowp + bj * HALF) = w; } }
    }
};

template <class Epi, class Sched, bool ALIGN_EPI = false, bool SP2 = false, bool I8 = false>
__device__ __forceinline__ void gemm_phase(PG8_LAS unsigned char* lds, const Gemm g, const Sched& S, const Epi& E) {
    const int tid = threadIdx.x, wid = __builtin_amdgcn_readfirstlane(tid >> 6), lane = tid & 63, wr = wid >> 2, wc = wid & 3, fr = lane & 15, fq = lane >> 4;
    const int K = g.K, nt = K / BK;
    unsigned voffA[2], voffB[2];
#pragma unroll
    for (int i = 0; i < 2; ++i) { int R, C; stage_rc(tid * 16 + i * 8192, R, C); const int Rb = Epi::PERM ? ((R & ~31) + perm32(R & 31)) : R;
        voffA[i] = (unsigned)(R * K + C) * 2u; voffB[i] = (unsigned)(Rb * K + C) * 2u; }
    const size_t kstep = (size_t)(BK * 2);
    const size_t hstep = (size_t)HALF * K * 2;
    const size_t tstep = 2 * hstep;
    const unsigned ldsw = (unsigned)wid * 1024u;
    const int aoff = lds_byte(wr * 64 + fr, fq * 8), boff = lds_byte(wc * 32 + fr, fq * 8);
    typedef int i32x4 __attribute__((ext_vector_type(4)));
    auto mma16 = [](const bf16x8& b, const bf16x8& a, const f32x4& c) __attribute__((always_inline)) -> f32x4 {
        if constexpr (I8) return __builtin_bit_cast(f32x4, __builtin_amdgcn_mfma_i32_16x16x64_i8(__builtin_bit_cast(i32x4, b), __builtin_bit_cast(i32x4, a), __builtin_bit_cast(i32x4, c), 0, 0, 0));
        else return __builtin_amdgcn_mfma_f32_16x16x32_bf16(b, a, c, 0, 0, 0);
    };
#define PG8_SA(b, h) (((b) * 2 + (h)) * HTB)
#define PG8_SB(b, h) ((4 + (b) * 2 + (h)) * HTB)
#define PG8_STAGE(bufoff, gbase, voff) do { _Pragma("unroll") for (int _i = 0; _i < 2; ++_i) \
        __builtin_amdgcn_global_load_lds((const unsigned*)((const char*)(gbase) + (voff)[_i]), (PG8_LAS unsigned*)(lds + (bufoff) + ldsw + _i * 8192), 16, 0, 0); } while (0)
#define PG8_LDA(dst, b, h) do { _Pragma("unroll") for (int m = 0; m < 4; ++m) _Pragma("unroll") for (int k = 0; k < 2; ++k) dst[m][k] = *(const PG8_LAS bf16x8*)(lds + PG8_SA(b, h) + aoff + m * 2048 + k * 1024); } while (0)
#define PG8_LDB(dst, b, h) do { _Pragma("unroll") for (int n = 0; n < 2; ++n) _Pragma("unroll") for (int k = 0; k < 2; ++k) dst[n][k] = *(const PG8_LAS bf16x8*)(lds + PG8_SB(b, h) + boff + n * 2048 + k * 1024); } while (0)
#define PG8_MMA(ai, bj, At, Bt) do { __builtin_amdgcn_s_setprio(1); _Pragma("unroll") for (int m = 0; m < 4; ++m) _Pragma("unroll") for (int n = 0; n < 2; ++n) _Pragma("unroll") for (int k = 0; k < 2; ++k) \
        acc[ai][bj][m][n] = mma16(Bt[n][k], At[m][k], acc[ai][bj][m][n]); __builtin_amdgcn_s_setprio(0); } while (0)
#define PG8_WAIT_V(n) asm volatile("s_waitcnt vmcnt(" #n ")" ::: "memory")
#define PG8_WAIT_L(n) asm volatile("s_waitcnt lgkmcnt(" #n ")" ::: "memory")
#define PG8_BAR __builtin_amdgcn_s_barrier()
#define PG8_SCHED __builtin_amdgcn_sched_barrier(0)
    Unit cur, nxt; int ui = 0;
    if (!S.next(0, cur)) return;
    f32x4 acc[2][2][4][2];
#pragma unroll
    for (int a = 0; a < 2; ++a)
#pragma unroll
        for (int b = 0; b < 2; ++b)
#pragma unroll
            for (int m = 0; m < 4; ++m)
#pragma unroll
                for (int n = 0; n < 2; ++n) acc[a][b][m][n] = (f32x4){0.f, 0.f, 0.f, 0.f};
    bf16x8 At[4][2], B0[2][2], B1[2][2];
    const char* cA = (const char*)g.A + (size_t)cur.pm * tstep; const char* cB = (const char*)g.Bt + (size_t)cur.pn * tstep;
    S.a_ready(cur);
    if constexpr (SP2) {
        PG8_STAGE(PG8_SB(0, 0), cB, voffB); PG8_STAGE(PG8_SB(0, 1), cB + hstep, voffB); PG8_STAGE(PG8_SA(0, 0), cA, voffA); PG8_STAGE(PG8_SA(0, 1), cA + hstep, voffA);
        if (wr == 1) PG8_BAR;
        PG8_WAIT_V(2); PG8_BAR;
        PG8_STAGE(PG8_SB(1, 0), cB + kstep, voffB); PG8_STAGE(PG8_SA(1, 0), cA + kstep, voffA); PG8_STAGE(PG8_SB(1, 1), cB + hstep + kstep, voffB);
        PG8_WAIT_V(6); PG8_BAR;
    } else {
        PG8_STAGE(PG8_SB(0, 0), cB, voffB); PG8_STAGE(PG8_SA(0, 0), cA, voffA); PG8_STAGE(PG8_SB(0, 1), cB + hstep, voffB); PG8_STAGE(PG8_SA(0, 1), cA + hstep, voffA);
        if (wr == 1) PG8_BAR;
        PG8_WAIT_V(4); PG8_BAR;
        PG8_STAGE(PG8_SB(1, 0), cB + kstep, voffB); PG8_STAGE(PG8_SA(1, 0), cA + kstep, voffA); PG8_STAGE(PG8_SB(1, 1), cB + hstep + kstep, voffB);
        PG8_WAIT_V(6); PG8_BAR;
    }
    for (;;) {
        const bool has_next = S.next(ui + 1, nxt);
        const char* nA = has_next ? (const char*)g.A + (size_t)nxt.pm * tstep : cA; const char* nB = has_next ? (const char*)g.Bt + (size_t)nxt.pn * tstep : cB;
        for (int t = 0; t < nt; t += 2) {
            const bool last = (t == nt - 2);
            const char* a1 = cA + (size_t)(t + 1) * kstep;
            const char* a2 = last ? nA : cA + (size_t)(t + 2) * kstep; const char* b2 = last ? nB : cB + (size_t)(t + 2) * kstep;
            const char* a3 = a2 + kstep; const char* b3 = b2 + kstep;
            if (last && has_next) S.a_ready(nxt);
            if constexpr (SP2) {
            PG8_LDB(B0, 0, 0); PG8_LDB(B1, 0, 1); PG8_SCHED; PG8_LDA(At, 0, 0); PG8_STAGE(PG8_SA(1, 1), a1 + hstep, voffA);
            PG8_WAIT_V(8); PG8_WAIT_L(0); PG8_BAR; PG8_MMA(0, 0, At, B0); PG8_MMA(0, 1, At, B1); PG8_BAR; PG8_SCHED;
            PG8_LDA(At, 0, 1); PG8_STAGE(PG8_SB(0, 0), b2, voffB); PG8_STAGE(PG8_SB(0, 1), b2 + hstep, voffB); PG8_STAGE(PG8_SA(0, 0), a2, voffA);
            PG8_WAIT_V(8); PG8_WAIT_L(0); PG8_BAR; PG8_MMA(1, 0, At, B0); PG8_MMA(1, 1, At, B1); PG8_BAR; PG8_SCHED;
            PG8_LDB(B0, 1, 0); PG8_LDB(B1, 1, 1); PG8_SCHED; PG8_LDA(At, 1, 0); PG8_STAGE(PG8_SA(0, 1), a2 + hstep, voffA);
            PG8_WAIT_V(8); PG8_WAIT_L(0); PG8_BAR; PG8_MMA(0, 0, At, B0); PG8_MMA(0, 1, At, B1); PG8_BAR; PG8_SCHED;
            PG8_LDA(At, 1, 1); PG8_STAGE(PG8_SB(1, 0), b3, voffB); PG8_STAGE(PG8_SB(1, 1), b3 + hstep, voffB); PG8_STAGE(PG8_SA(1, 0), a3, voffA);
            PG8_WAIT_V(8); PG8_WAIT_L(0); PG8_BAR; PG8_MMA(1, 0, At, B0); PG8_MMA(1, 1, At, B1); PG8_BAR; PG8_SCHED;
            } else {
            PG8_LDB(B0, 0, 0); PG8_SCHED; PG8_LDA(At, 0, 0); PG8_STAGE(PG8_SA(1, 1), a1 + hstep, voffA);
            PG8_WAIT_L(8); PG8_BAR; PG8_WAIT_L(0); PG8_MMA(0, 0, At, B0); PG8_BAR; PG8_SCHED;
            PG8_LDB(B1, 0, 1); PG8_STAGE(PG8_SB(0, 0), b2, voffB);
            PG8_BAR; PG8_WAIT_L(0); PG8_MMA(0, 1, At, B1); PG8_BAR;
            PG8_LDA(At, 0, 1); PG8_STAGE(PG8_SA(0, 0), a2, voffA);
            PG8_BAR; PG8_WAIT_L(0); PG8_MMA(1, 0, At, B0); PG8_BAR; PG8_SCHED;
            PG8_STAGE(PG8_SB(0, 1), b2 + hstep, voffB);
            PG8_WAIT_V(6); PG8_BAR; PG8_MMA(1, 1, At, B1); PG8_BAR;
            PG8_LDB(B0, 1, 0); PG8_SCHED; PG8_LDA(At, 1, 0); PG8_STAGE(PG8_SA(0, 1), a2 + hstep, voffA);
            PG8_WAIT_L(8); PG8_BAR; PG8_WAIT_L(0); PG8_MMA(0, 0, At, B0); PG8_BAR; PG8_SCHED;
            PG8_LDB(B1, 1, 1); PG8_STAGE(PG8_SB(1, 0), b3, voffB);
            PG8_BAR; PG8_WAIT_L(0); PG8_MMA(0, 1, At, B1); PG8_BAR;
            PG8_LDA(At, 1, 1); PG8_STAGE(PG8_SA(1, 0), a3, voffA);
            PG8_BAR; PG8_WAIT_L(0); PG8_MMA(1, 0, At, B0); PG8_BAR; PG8_SCHED;
            PG8_STAGE(PG8_SB(1, 1), b3 + hstep, voffB);
            PG8_WAIT_V(6); PG8_BAR; PG8_MMA(1, 1, At, B1); PG8_BAR;
            }
        }
        if constexpr (ALIGN_EPI) { if (wr == 0) PG8_BAR; }
        if constexpr (!Epi::AFTER_DRAIN) { E(acc, cur, wr, wc, fr, fq); S.done(cur); }
        if (!has_next) break;
#pragma unroll
        for (int a = 0; a < 2; ++a)
#pragma unroll
            for (int b = 0; b < 2; ++b)
#pragma unroll
                for (int m = 0; m < 4; ++m)
#pragma unroll
                    for (int n = 0; n < 2; ++n) acc[a][b][m][n] = (f32x4){0.f, 0.f, 0.f, 0.f};
        cur = nxt; cA = nA; cB = nB; ++ui;
        if constexpr (ALIGN_EPI) { if (wr == 1) PG8_BAR; }
    }
    PG8_WAIT_V(0);
    if constexpr (!ALIGN_EPI) { if (wr == 0) PG8_BAR; }
    PG8_BAR;
    if constexpr (Epi::AFTER_DRAIN) { E.fused(acc, cur, wr, wc, fr, fq, lds, wid, lane); S.done(cur); }
#undef PG8_SA
#undef PG8_SB
#undef PG8_STAGE
#undef PG8_LDA
#undef PG8_LDB
#undef PG8_MMA
#undef PG8_WAIT_V
#undef PG8_WAIT_L
#undef PG8_BAR
#undef PG8_SCHED
}
}

constexpr int NB = 16, SEQ = 2048, DM = 1024, NTOK = NB * SEQ;
constexpr int INC = 2840, INP = 3072;
constexpr int C_B = 0, C_C = 512, C_H = 1024, C_Q = 1536, C_KC = 2048, C_VC = 2176, C_KS = 2304, C_VS = 2432, C_KW = 2560, C_VW = 2688, C_G = 2816;
constexpr int MEMT = 256, NMEM = NB * MEMT;
constexpr int NEXP = 16384;
constexpr int PEER_ROW_BYTES = 1280;
constexpr float EPS = 1e-6f;
constexpr float LOG2E = 1.4426950408889634f;
constexpr int NWAVES = 8, NTHR = 512;
constexpr int NPHASE = 13;

constexpr size_t MiB = 1u << 20;
constexpr size_t WS_CTL = 0, CTL_ZERO_BYTES = 1 * MiB;
constexpr size_t WS_WIN = 2 * MiB, WS_WOUT = 8 * MiB, WS_XQT = 10 * MiB, WS_XKVT = 12 * MiB, WS_XOT = 16 * MiB, WS_PWQT = 18 * MiB;
constexpr size_t WS_PKEYS = 22 * MiB, WS_B1P = 23 * MiB, WS_KCMP = 24 * MiB, WS_VCMP = 24 * MiB + 512 * 1024;
constexpr size_t WS_MN = 26 * MiB, WS_XKV = 34 * MiB;
constexpr size_t WS_CW1T = 22 * MiB + 512 * 1024;
constexpr size_t WS_SA1 = 23 * MiB + 256 * 1024, WS_SB1 = 23 * MiB + 384 * 1024, WS_CMX = 23 * MiB + 448 * 1024;
constexpr size_t WS_PSC = 23 * MiB + 256 * 1024;
constexpr size_t WS_SH = 54 * MiB, WS_SBQ = 54 * MiB + 128 * 1024, WS_CMXQ = 54 * MiB + 256 * 1024;
constexpr size_t WS_SSP1 = 50 * MiB, WS_SSP2 = 52 * MiB;
constexpr size_t WS_PDOWN = 64 * MiB, WS_PUP = 96 * MiB, WS_HN = 128 * MiB, WS_YMIX = 192 * MiB;
constexpr size_t WS_PROJ = 256 * MiB, WS_XQ = 256 * MiB, WS_PQ = 320 * MiB, WS_PIDX = 448 * MiB, WS_PGATE = 464 * MiB, WS_END = 480 * MiB;
constexpr int CW_BAR = 4096;

constexpr int RING_BYTES = 131072;
constexpr int MISC_OFF = 163584;
constexpr int LDS_BYTES = 163840;

#define GAS __attribute__((address_space(1)))
#define LAS __attribute__((address_space(3)))
#define DI __device__ __forceinline__
typedef unsigned short bf16;
typedef unsigned v4u __attribute__((ext_vector_type(4)));
typedef unsigned v2u __attribute__((ext_vector_type(2)));
typedef float f32x4 __attribute__((ext_vector_type(4)));
typedef float f32x16 __attribute__((ext_vector_type(16)));
typedef short bf16x8 __attribute__((ext_vector_type(8)));
typedef short s16x4 __attribute__((ext_vector_type(4)));
typedef float f32x2_t __attribute__((ext_vector_type(2)));
typedef __bf16 bf16x2_t __attribute__((ext_vector_type(2)));
#define RLX_AGENT __ATOMIC_RELAXED, __HIP_MEMORY_SCOPE_AGENT
#define LDS_WAIT() asm volatile("s_waitcnt lgkmcnt(0)" ::: "memory")
#define MFMA32(a, b, c) __builtin_amdgcn_mfma_f32_32x32x16_bf16((a), (b), (c), 0, 0, 0)

DI unsigned pk2(float lo, float hi) { f32x2_t v = {lo, hi}; bf16x2_t b = __builtin_convertvector(v, bf16x2_t); return __builtin_bit_cast(unsigned, b); }
DI bf16 f2bf(float f) { return (bf16)(pk2(f, 0.f) & 0xffffu); }
DI float bf2f(bf16 b) { return __uint_as_float((unsigned)b << 16); }
DI float bflo(unsigned u) { return __uint_as_float(u << 16); }
DI float bfhi(unsigned u) { return __uint_as_float(u & 0xffff0000u); }
DI float rlane(float v, int l);
DI float wave_sum(float v) {
    v += __uint_as_float((unsigned)__builtin_amdgcn_update_dpp(0, (int)__float_as_uint(v), 0xB1, 0xF, 0xF, true));
    v += __uint_as_float((unsigned)__builtin_amdgcn_update_dpp(0, (int)__float_as_uint(v), 0x4E, 0xF, 0xF, true));
    v += __uint_as_float((unsigned)__builtin_amdgcn_update_dpp(0, (int)__float_as_uint(v), 0x141, 0xF, 0xF, true));
    v += __uint_as_float((unsigned)__builtin_amdgcn_update_dpp(0, (int)__float_as_uint(v), 0x140, 0xF, 0xF, true));
    return (rlane(v, 0) + rlane(v, 16)) + (rlane(v, 32) + rlane(v, 48));
}
DI float rlane(float v, int l)   { return __uint_as_float((unsigned)__builtin_amdgcn_readlane((int)__float_as_uint(v), l)); }
DI int crow(int i, int h) { return (i & 3) + 8 * (i >> 2) + 4 * h; }
DI float gelu_erf(float v) { return 0.5f * v * (1.0f + erff(v * 0.70710678118654752f)); }

#define XB_TMO      128
#define XB_XCNT(j)  (256  + 64 * (j))
#define XB_XSUB(j)  (1280 + 64 * (j))
#define XB_XGEN(j)  (2304 + 64 * (j))
#define XB_TOP      3328
#define XB_TOPGEN   3392
#define XCD_BAR_WORDS 3456
#define XB_SPIN_CAP (1u << 22)

DI unsigned xb_ld(unsigned* p)              { return __hip_atomic_load(p, __ATOMIC_RELAXED, __HIP_MEMORY_SCOPE_AGENT); }
DI unsigned xb_add(unsigned* p, unsigned v) { return __hip_atomic_fetch_add(p, v, __ATOMIC_RELAXED, __HIP_MEMORY_SCOPE_AGENT); }
DI unsigned xb_xcc_id() { return (unsigned)__builtin_amdgcn_s_getreg((3 << 11) | 20) & 0xFu; }
#define XB_SPIN(cond, bar) do { unsigned _sp = 0; while (cond) { __builtin_amdgcn_s_sleep(1); \
    if ((++_sp & 255u) == 0u) { if (xb_ld(&(bar)[XB_TMO])) break; if (_sp > XB_SPIN_CAP) { atomicAdd(&(bar)[XB_TMO], 1u); break; } } } } while (0)

struct XcdBarrier { unsigned* bar; unsigned x; volatile LAS unsigned* st; };

DI XcdBarrier xcd_barrier_post(unsigned* bar, volatile LAS unsigned* st) {
    XcdBarrier b; b.bar = bar; b.x = xb_xcc_id(); b.st = st;
    if (threadIdx.x == 0) (void)xb_add(&bar[XB_XCNT(b.x)], 1u);
    return b;
}
DI void xcd_barrier_complete(unsigned* bar, unsigned x, unsigned& nloc, unsigned& nx) {
    const unsigned G = gridDim.x * gridDim.y * gridDim.z;
    unsigned sum, cnt, mine, sp = 0u;
    for (;;) {
        sum = 0u; cnt = 0u; mine = 0u;
#pragma unroll
        for (unsigned j = 0; j < 16; ++j) { const unsigned c = xb_ld(&bar[XB_XCNT(j)]); sum += c; cnt += (c > 0u) ? 1u : 0u; mine = (j == x) ? c : mine; }
        if (sum == G) break;
        __builtin_amdgcn_s_sleep(1);
        if ((++sp & 255u) == 0u) { if (xb_ld(&bar[XB_TMO])) break; if (sp > XB_SPIN_CAP) { atomicAdd(&bar[XB_TMO], 1u); break; } }
    }
    nloc = mine > 0u ? mine : 1u; nx = cnt > 0u ? cnt : 1u;
}
DI void xcd_barrier(const XcdBarrier& b) {
    asm volatile("s_waitcnt vmcnt(0)" ::: "memory");
    __syncthreads();
    if (threadIdx.x == 0) {
        unsigned* bar = b.bar;
        __builtin_amdgcn_s_waitcnt(0);
        unsigned nloc = b.st[0], nx = b.st[1];
        if (nloc == 0u) { xcd_barrier_complete(bar, b.x, nloc, nx); b.st[0] = nloc; b.st[1] = nx; }
        const unsigned old = xb_add(&bar[XB_XSUB(b.x)], 1u);
        const unsigned gen = old / nloc;
        if (old + 1u == (gen + 1u) * nloc) {
            __builtin_amdgcn_fence(__ATOMIC_RELEASE, "agent");
            asm volatile("s_waitcnt vmcnt(0)" ::: "memory");
            const unsigned og = xb_add(&bar[XB_TOP], 1u);
            const unsigned tg = og / nx;
            if (og + 1u == (tg + 1u) * nx) xb_add(&bar[XB_TOPGEN], 1u);
            else XB_SPIN(xb_ld(&bar[XB_TOPGEN]) == tg, bar);
            __builtin_amdgcn_fence(__ATOMIC_ACQUIRE, "agent");
            xb_add(&bar[XB_XGEN(b.x)], 1u);
            asm volatile("s_waitcnt vmcnt(0)" ::: "memory");
        } else {
            XB_SPIN(xb_ld(&bar[XB_XGEN(b.x)]) == gen, bar);
            __builtin_amdgcn_fence(__ATOMIC_ACQUIRE, "agent");
            asm volatile("s_waitcnt vmcnt(0)" ::: "memory");
        }
    }
    __syncthreads();
}

DI void transpose_item(const float* W, int K, int N, int Npad, bf16* WT, int row_off, LAS float* scr, int item, int lane, const float* ks = nullptr) {
    const int nblk = Npad / 32, kb = item / nblk, nb = item % nblk, k0 = 64 * kb, n0 = 32 * nb;
    {
        const int kr = lane >> 3, nq = n0 + 4 * (lane & 7);
        f32x4 v[8];
#pragma unroll
        for (int i = 0; i < 8; ++i) v[i] = (nq < N) ? *(const f32x4*)(W + (size_t)(k0 + 8 * i + kr) * N + nq) : (f32x4){0.f, 0.f, 0.f, 0.f};
#pragma unroll
        for (int i = 0; i < 8; ++i) { const float sc = ks ? ks[k0 + 8 * i + kr] : 1.0f; LAS float* d = scr + (8 * i + kr) * 33 + 4 * (lane & 7);
            d[0] = v[i].x * sc; d[1] = v[i].y * sc; d[2] = v[i].z * sc; d[3] = v[i].w * sc; }
    }
    LDS_WAIT(); asm volatile("" ::: "memory");
    const int c = lane & 7;
#pragma unroll
    for (int j = 0; j < 4; ++j) { const int n = (lane >> 3) + 8 * j; const LAS float* s = scr + (8 * c) * 33 + n;
        v4u o; o.x = pk2(s[0 * 33], s[1 * 33]); o.y = pk2(s[2 * 33], s[3 * 33]); o.z = pk2(s[4 * 33], s[5 * 33]); o.w = pk2(s[6 * 33], s[7 * 33]);
        *(v4u*)(WT + (size_t)(row_off + n0 + n) * K + k0 + 8 * c) = o; }
    LDS_WAIT(); asm volatile("" ::: "memory");
}
template <int NR>
DI void rms_rows_to_bf16(const float* xrow, const float* w, bf16* orow, int lane) {
    const f32x4* wr = (const f32x4*)w + lane;
    f32x4 v[NR][4]; float s[NR];
#pragma unroll
    for (int q = 0; q < NR; ++q) { const f32x4* xr = (const f32x4*)(xrow + (size_t)q * DM) + lane;
#pragma unroll
        for (int j = 0; j < 4; ++j) v[q][j] = xr[64 * j]; }
#pragma unroll
    for (int q = 0; q < NR; ++q) { s[q] = 0.f;
#pragma unroll
        for (int j = 0; j < 4; ++j) s[q] += (v[q][j].x * v[q][j].x + v[q][j].y * v[q][j].y) + (v[q][j].z * v[q][j].z + v[q][j].w * v[q][j].w); }
#pragma unroll
    for (int q = 0; q < NR; ++q) { const float r = 1.0f / sqrtf(wave_sum(s[q]) * (1.f / DM) + EPS);
        v2u* o8 = (v2u*)(orow + (size_t)q * DM) + lane;
#pragma unroll
        for (int j = 0; j < 4; ++j) { const f32x4 ww = wr[64 * j]; v2u o; o.x = pk2(v[q][j].x * r * ww.x, v[q][j].y * r * ww.y); o.y = pk2(v[q][j].z * r * ww.z, v[q][j].w * r * ww.w); o8[64 * j] = o; } }
}
DI float wave_max_u(float v) {
    v = fmaxf(v, __uint_as_float((unsigned)__builtin_amdgcn_update_dpp(0, (int)__float_as_uint(v), 0xB1, 0xF, 0xF, true)));
    v = fmaxf(v, __uint_as_float((unsigned)__builtin_amdgcn_update_dpp(0, (int)__float_as_uint(v), 0x4E, 0xF, 0xF, true)));
    v = fmaxf(v, __uint_as_float((unsigned)__builtin_amdgcn_update_dpp(0, (int)__float_as_uint(v), 0x141, 0xF, 0xF, true)));
    v = fmaxf(v, __uint_as_float((unsigned)__builtin_amdgcn_update_dpp(0, (int)__float_as_uint(v), 0x140, 0xF, 0xF, true)));
    return fmaxf(fmaxf(rlane(v, 0), rlane(v, 16)), fmaxf(rlane(v, 32), rlane(v, 48)));
}
DI unsigned q8x4(float a, float b, float c, float d, float inv) {
    return ((unsigned)(int)__builtin_rintf(a * inv) & 0xffu) | (((unsigned)(int)__builtin_rintf(b * inv) & 0xffu) << 8) | (((unsigned)(int)__builtin_rintf(c * inv) & 0xffu) << 16) | (((unsigned)(int)__builtin_rintf(d * inv) & 0xffu) << 24);
}
template <int NR>
DI void rms_rows_to_i8(const float* xrow, const float* w, unsigned char* orow, float* srow, int lane) {
    const f32x4* wr = (const f32x4*)w + lane;
    f32x4 v[NR][4]; float s[NR];
#pragma unroll
    for (int q = 0; q < NR; ++q) { const f32x4* xr = (const f32x4*)(xrow + (size_t)q * DM) + lane;
#pragma unroll
        for (int j = 0; j < 4; ++j) v[q][j] = xr[64 * j]; }
#pragma unroll
    for (int q = 0; q < NR; ++q) { s[q] = 0.f;
#pragma unroll
        for (int j = 0; j < 4; ++j) s[q] += (v[q][j].x * v[q][j].x + v[q][j].y * v[q][j].y) + (v[q][j].z * v[q][j].z + v[q][j].w * v[q][j].w); }
#pragma unroll
    for (int q = 0; q < NR; ++q) { const float r = 1.0f / sqrtf(wave_sum(s[q]) * (1.f / DM) + EPS); float mx = 0.f;
#pragma unroll
        for (int j = 0; j < 4; ++j) { v[q][j] = v[q][j] * r * wr[64 * j]; mx = fmaxf(mx, fmaxf(fmaxf(fabsf(v[q][j].x), fabsf(v[q][j].y)), fmaxf(fabsf(v[q][j].z), fabsf(v[q][j].w)))); }
        mx = wave_max_u(mx); const float inv = mx > 0.f ? 127.0f / mx : 0.f;
        unsigned* o4 = (unsigned*)(orow + (size_t)q * DM) + lane;
#pragma unroll
        for (int j = 0; j < 4; ++j) o4[64 * j] = q8x4(v[q][j].x, v[q][j].y, v[q][j].z, v[q][j].w, inv);
        if (lane == 0) srow[q] = mx * (1.0f / 127.0f); }
}
DI void transpose_item_i8(const float* W, int NR, int NP, const float* cmx, unsigned char* WT, float* sb, LAS float* scr, int item, int lane) {
    const int nblk = NP / 32, kb = item / nblk, nb = item % nblk, k0 = 64 * kb, n0 = 32 * nb;
    const int nn = n0 + (lane & 31);
    float cm = 0.f;
#pragma unroll
    for (int kc = 0; kc < 16; ++kc) cm = fmaxf(cm, cmx[kc * NP + nn]);
    const float inv = cm > 0.f ? 127.0f / cm : 0.f;
    if (kb == 0 && lane < 32) sb[nn] = cm * (1.0f / 127.0f);
    {
        const int kr = lane >> 3, nc = lane & 7, nq = n0 + 4 * nc;
        const float i0 = __shfl(inv, 4 * nc), i1 = __shfl(inv, 4 * nc + 1), i2 = __shfl(inv, 4 * nc + 2), i3 = __shfl(inv, 4 * nc + 3);
        f32x4 v[8];
#pragma unroll
        for (int i = 0; i < 8; ++i) v[i] = (nq < NR) ? *(const f32x4*)(W + (size_t)(k0 + 8 * i + kr) * NR + nq) : (f32x4){0.f, 0.f, 0.f, 0.f};
#pragma unroll
        for (int i = 0; i < 8; ++i) { LAS float* d = scr + (8 * i + kr) * 33 + 4 * nc; d[0] = v[i].x * i0; d[1] = v[i].y * i1; d[2] = v[i].z * i2; d[3] = v[i].w * i3; }
    }
    LDS_WAIT(); asm volatile("" ::: "memory");
    const int c = lane & 7;
#pragma unroll
    for (int j = 0; j < 4; ++j) { const int n = (lane >> 3) + 8 * j; const LAS float* s = scr + (8 * c) * 33 + n;
        v2u o; o.x = q8x4(s[0 * 33], s[1 * 33], s[2 * 33], s[3 * 33], 1.0f); o.y = q8x4(s[4 * 33], s[5 * 33], s[6 * 33], s[7 * 33], 1.0f);
        *(v2u*)(WT + (size_t)(n0 + n) * DM + k0 + 8 * c) = o; }
    LDS_WAIT(); asm volatile("" ::: "memory");
}
DI void cvt_stream(const float* src, bf16* dst, size_t n8, int gthread, int nthreads) {
    for (size_t i = gthread; i < n8; i += nthreads) {
        const f32x4 a = ((const f32x4*)src)[2 * i], b = ((const f32x4*)src)[2 * i + 1];
        v4u o; o.x = pk2(a.x, a.y); o.y = pk2(a.z, a.w); o.z = pk2(b.x, b.y); o.w = pk2(b.z, b.w);
        ((v4u*)dst)[i] = o;
    }
}

DI void colmax_item(const float* W, int NR, int NP, float* cmx, int it, int lane) {
    const int kc = it / (NP / 64), n = 64 * (it % (NP / 64)) + 4 * (lane & 15), kr = lane >> 4; f32x4 mx = {0.f, 0.f, 0.f, 0.f};
    if (n < NR) {
#pragma unroll
        for (int i = 0; i < 16; ++i) { const f32x4 v = *(const f32x4*)(W + (size_t)(64 * kc + 4 * i + kr) * NR + n);
            mx.x = fmaxf(mx.x, fabsf(v.x)); mx.y = fmaxf(mx.y, fabsf(v.y)); mx.z = fmaxf(mx.z, fabsf(v.z)); mx.w = fmaxf(mx.w, fabsf(v.w)); } }
    mx.x = fmaxf(mx.x, __shfl_xor(mx.x, 16)); mx.y = fmaxf(mx.y, __shfl_xor(mx.y, 16)); mx.z = fmaxf(mx.z, __shfl_xor(mx.z, 16)); mx.w = fmaxf(mx.w, __shfl_xor(mx.w, 16));
    mx.x = fmaxf(mx.x, __shfl_xor(mx.x, 32)); mx.y = fmaxf(mx.y, __shfl_xor(mx.y, 32)); mx.z = fmaxf(mx.z, __shfl_xor(mx.z, 32)); mx.w = fmaxf(mx.w, __shfl_xor(mx.w, 32));
    if (kr == 0) *(f32x4*)(cmx + kc * NP + n) = mx;
}
struct Ptrs {
    const float *x, *mem, *mix_norm_w, *w_in, *conv_w, *conv_b, *cmp_pe, *cmp_w1, *cmp_w2, *q_norm_w, *k_norm_w, *w_out, *xattn_norm_w, *mem_norm_w,
                *xq, *xk, *xv, *xo, *xq_norm_w, *xk_norm_w, *ffn_norm_w, *peer_wq, *peer_keys, *peer_down, *peer_up;
    float* out;
    bf16 *WIN, *WOUT, *XQT, *XKVT, *XOT, *PWQT, *PKEYS, *KCMP, *VCMP, *MN, *XKV, *HN, *YMIX, *PROJ, *XQ, *PQ;
    unsigned char *PDOWN, *PUP;
    float *B1P, *PGATE, *PSC, *SSP1, *SSP2, *SA1, *SB1, *CMX, *SH, *SBQ, *CMXQ; int* PIDX; bf16* CW1T; unsigned char *HN8, *WIN8, *H8, *PWQ8;
};

DI void p0_prologue(const Ptrs& P, LAS unsigned char* lds, int gw, int NGW, int wave, int lane, int part, int pm = 7) {
    LAS float* scr = (LAS float*)(lds + wave * 16384);
    if (part == 1 && !(pm & 1)) return;
    if (part == 1) {
        for (int it = gw; it < (DM / 64) * (INP / 32) + (DM / 64) * (2048 / 32); it += NGW) {
            if (it < (DM / 64) * (INP / 32)) transpose_item_i8(P.w_in, INC, INP, P.CMX, P.WIN8, P.SB1, scr, it, lane);
            else transpose_item_i8(P.peer_wq, 2048, 2048, P.CMXQ, P.PWQ8, P.SBQ, scr, it - (DM / 64) * (INP / 32), lane); }
        return;
    }
    if (pm & 1) for (int it = gw; it < 16 * (INP / 64) + 16 * (2048 / 64); it += NGW) {
        if (it < 16 * (INP / 64)) colmax_item(P.w_in, INC, INP, P.CMX, it, lane); else colmax_item(P.peer_wq, 2048, 2048, P.CMXQ, it - 16 * (INP / 64), lane); }
    constexpr int I_IN = (DM / 64) * (INP / 32), I_SQ = (DM / 64) * (DM / 32), I_PQ = (DM / 64) * (2048 / 32);
    constexpr int NITEMS = 5 * I_SQ;
    if (pm & 1) for (int it = gw; it < NITEMS; it += NGW) {
        int r = it;
        if (r < I_SQ) { transpose_item(P.w_out, DM, DM, DM, P.WOUT, 0, scr, r, lane); continue; } r -= I_SQ;
        if (r < I_SQ) { transpose_item(P.xq, DM, DM, DM, P.XQT, 0, scr, r, lane, P.xattn_norm_w); continue; } r -= I_SQ;
        if (r < I_SQ) { transpose_item(P.xk, DM, DM, DM, P.XKVT, 0, scr, r, lane); continue; } r -= I_SQ;
        if (r < I_SQ) { transpose_item(P.xv, DM, DM, DM, P.XKVT, DM, scr, r, lane); continue; } r -= I_SQ;
        transpose_item(P.xo, DM, DM, DM, P.XOT, 0, scr, r, lane);
    }
    for (int it = gw; it < 128; it += NGW) {
        const int q = it >> 5, r = it & 31;
        transpose_item(P.cmp_w1 + (size_t)q * 1024 * 64, 1024, 64, 64, P.CW1T + (size_t)(q >> 1) * 128 * 1024, (q & 1) * 64, scr, r, lane);
    }
    for (int it = gw; it < 64; it += NGW) {
        const int kv = it >> 5, l = it & 31;
        const float pv = P.cmp_pe[(kv * 32 + l) * 64 + lane];
        const float* w1 = P.cmp_w1 + ((size_t)kv * 2048 + l * 64) * 64 + lane;
        float acc = 0.f;
#pragma unroll 16
        for (int d = 0; d < 64; ++d) acc += rlane(pv, d) * w1[d * 64];
        P.B1P[it * 64 + lane] = acc;
    }
    if (pm & 2) for (int m = 4 * gw; m < NTOK; m += 4 * NGW) rms_rows_to_i8<4>(P.x + (size_t)m * DM, P.mix_norm_w, P.HN8 + (size_t)m * DM, P.SA1 + m, lane);
    if (pm & 2) for (int m = 2 * gw; m < NMEM; m += 2 * NGW) rms_rows_to_bf16<2>(P.mem + (size_t)m * DM, P.mem_norm_w, P.MN + (size_t)m * DM, lane);
    const int gthread = gw * 64 + lane, nthreads = NGW * 64;
    if (pm & 4) for (int row0 = 2 * gw; row0 < 2 * NEXP; row0 += 2 * NGW) {
        f32x4 v2[2][4];
#pragma unroll
        for (int q = 0; q < 2; ++q) { const int row = row0 + q, tb = row >> 14, e = row & (NEXP - 1);
            const f32x4* src = (const f32x4*)((tb ? P.peer_up : P.peer_down) + (size_t)e * DM) + 4 * lane;
#pragma unroll
            for (int j = 0; j < 4; ++j) v2[q][j] = src[j]; }
#pragma unroll
        for (int q = 0; q < 2; ++q) { const int row = row0 + q, tb = row >> 14, e = row & (NEXP - 1);
        f32x4 v[4]; float mx = 0.f;
#pragma unroll
        for (int j = 0; j < 4; ++j) { v[j] = v2[q][j]; mx = fmaxf(mx, fmaxf(fmaxf(fabsf(v[j].x), fabsf(v[j].y)), fmaxf(fabsf(v[j].z), fabsf(v[j].w)))); }
        const bf16 sc16 = f2bf(mx * (tb ? (1.0f / 6.0f) : (1.0f / 7.0f))); const float sc = bf2f(sc16), inv = sc > 0.f ? 1.0f / sc : 0.f;
        unsigned w[2];
#pragma unroll
        for (int d = 0; d < 2; ++d) { unsigned acc = 0u;
            if (tb) {
#define FP4_PAIR(B) { const int c = 8 * d + 2 * (B); const float x0 = fminf(fmaxf(v[c >> 2][c & 3] * inv, -6.0f), 6.0f), x1 = fminf(fmaxf(v[(c + 1) >> 2][(c + 1) & 3] * inv, -6.0f), 6.0f); \
                    acc = __builtin_amdgcn_cvt_scalef32_pk_fp4_f32(acc, x0, x1, 1.0f, (B)); }
                FP4_PAIR(0) FP4_PAIR(1) FP4_PAIR(2) FP4_PAIR(3)
#undef FP4_PAIR
            } else {
#pragma unroll
                for (int i = 0; i < 8; ++i) { const float x = v[2 * d + (i >> 2)][i & 3]; int q2 = (int)__builtin_rintf(x * inv); q2 = q2 < -7 ? -7 : (q2 > 7 ? 7 : q2); acc |= ((unsigned)q2 & 0xFu) << (4 * i); }
            }
            w[d] = acc; }
        unsigned char* rp = P.PDOWN + (size_t)e * PEER_ROW_BYTES;
        *(v2u*)(rp + 16 * lane + 8 * tb) = (v2u){w[0], w[1]};
        *(bf16*)(rp + 1024 + 4 * lane + 2 * tb) = sc16;
        }
    }
    cvt_stream(P.peer_keys, P.PKEYS, (size_t)8 * 2 * 128 * 128 / 8, gthread, nthreads);
}

template <int CTRL> DI float dppf(float v) { return __uint_as_float((unsigned)__builtin_amdgcn_update_dpp(0, (int)__float_as_uint(v), CTRL, 0xF, 0xF, true)); }
DI float sum8(float v) { v += dppf<0xB1>(v); v += dppf<0x4E>(v); v += dppf<0x141>(v); return v; }
DI float sum32(float v) { v = sum8(v); v += dppf<0x140>(v); v += __shfl_xor(v, 16); return v; }
constexpr int CM_SA_OFF = 0, CM_SB_OFF = 36864, CM_P_OFF = 0, CM_H_OFF = 73728, CM_W2_OFF = CM_H_OFF + 128 * 68 * 4, CM_B_OFF = CM_W2_OFF + 64 * 64 * 4;
DI void compress_unit(const Ptrs& P, LAS unsigned char* lds, int kv, int b, int g, int tid, int wave, int lane) {
    LAS float* Pl = (LAS float*)(lds + CM_P_OFF); LAS float* Hl = (LAS float*)(lds + CM_H_OFF); LAS float* W2l = (LAS float*)(lds + CM_W2_OFF); LAS float* Bl = (LAS float*)(lds + CM_B_OFF);
    const int r = lane & 31, h = lane >> 5, wm = wave >> 1, wn = wave & 1;
    __syncthreads();
    for (int e = tid; e < 64 * 64; e += NTHR) W2l[e] = P.cmp_w2[(size_t)kv * 4096 + e];
    if (tid < 64) { float s = 0.f;
#pragma unroll 8
        for (int l = 0; l < 32; ++l) s += P.B1P[(kv * 32 + l) * 64 + tid];
        Bl[tid] = s; }
    {
        const bf16* abase = P.PROJ + (size_t)b * SEQ * INP + (kv ? C_VC : C_KC) + g * 64;
        const bf16* bbase = P.CW1T + (size_t)kv * 128 * 1024;
        const int srow = tid >> 3, sch = tid & 7;
        v4u ra[2], rb[2];
#define CM_GLOAD(L) { _Pragma("unroll") for (int k2 = 0; k2 < 2; ++k2) { const int row = srow + 64 * k2; \
            ra[k2] = *(const v4u*)(abase + (size_t)(16 * row + (L)) * INP + sch * 8); rb[k2] = *(const v4u*)(bbase + (size_t)row * 1024 + (L) * 64 + sch * 8); } }
#define CM_LSTORE(BUF) { _Pragma("unroll") for (int k2 = 0; k2 < 2; ++k2) { const int row = srow + 64 * k2; \
            *(LAS v4u*)(lds + CM_SA_OFF + (BUF) * 18432 + row * 144 + sch * 16) = ra[k2]; *(LAS v4u*)(lds + CM_SB_OFF + (BUF) * 18432 + row * 144 + sch * 16) = rb[k2]; } }
        CM_GLOAD(0) CM_LSTORE(0) CM_GLOAD(1)
        f32x16 acc[2];
#pragma unroll
        for (int i = 0; i < 16; ++i) { acc[0][i] = 0.f; acc[1][i] = 0.f; }
#pragma unroll 1
        for (int l = 0; l < 16; ++l) {
            __syncthreads();
            if (l + 1 < 16) { CM_LSTORE((l + 1) & 1) if (l + 2 < 16) CM_GLOAD(l + 2) }
            LAS const unsigned char* ap = lds + CM_SA_OFF + (l & 1) * 18432 + (32 * wm + r) * 144 + h * 16;
            LAS const unsigned char* bp = lds + CM_SB_OFF + (l & 1) * 18432 + (64 * wn + r) * 144 + h * 16;
#pragma unroll
            for (int kk = 0; kk < 4; ++kk) { const bf16x8 a = *(LAS const bf16x8*)(ap + kk * 32), b0 = *(LAS const bf16x8*)(bp + kk * 32), b1 = *(LAS const bf16x8*)(bp + 32 * 144 + kk * 32);
                acc[0] = MFMA32(a, b0, acc[0]); acc[1] = MFMA32(a, b1, acc[1]); }
        }
#undef CM_GLOAD
#undef CM_LSTORE
        __syncthreads();
#pragma unroll
        for (int t = 0; t < 2; ++t)
#pragma unroll
            for (int i = 0; i < 16; ++i) Pl[(32 * wm + crow(i, h)) * 132 + 64 * wn + 32 * t + r] = acc[t][i];
    }
    __syncthreads();
    for (int e = tid; e < 128 * 64; e += NTHR) { const int n = e >> 6, j = e & 63;
        Hl[n * 68 + j] = (n < 127) ? gelu_erf(Pl[n * 132 + j] + Pl[(n + 1) * 132 + 64 + j] + Bl[j]) : 0.f; }
    __syncthreads();
    {
        const int n = tid >> 2, jq = tid & 3;
        float o[16];
#pragma unroll
        for (int j = 0; j < 16; ++j) o[j] = 0.f;
#pragma unroll 4
        for (int m = 0; m < 64; ++m) { const float hv = Hl[n * 68 + m];
#pragma unroll
            for (int j4 = 0; j4 < 4; ++j4) { const f32x4 w = *(LAS const f32x4*)(W2l + m * 64 + jq * 16 + 4 * j4); o[4 * j4] += hv * w.x; o[4 * j4 + 1] += hv * w.y; o[4 * j4 + 2] += hv * w.z; o[4 * j4 + 3] += hv * w.w; } }
        if (kv == 0) { float ss = 0.f;
#pragma unroll
            for (int j = 0; j < 16; ++j) ss += o[j] * o[j];
            ss += dppf<0xB1>(ss); ss += dppf<0x4E>(ss);
            const float rr = 1.0f / sqrtf(ss * (1.f / 64.f) + EPS);
#pragma unroll
            for (int j = 0; j < 16; ++j) o[j] = o[j] * rr * P.k_norm_w[jq * 16 + j]; }
        v4u w0, w1; w0.x = pk2(o[0], o[1]); w0.y = pk2(o[2], o[3]); w0.z = pk2(o[4], o[5]); w0.w = pk2(o[6], o[7]); w1.x = pk2(o[8], o[9]); w1.y = pk2(o[10], o[11]); w1.z = pk2(o[12], o[13]); w1.w = pk2(o[14], o[15]);
        bf16* outp = (kv ? P.VCMP : P.KCMP) + ((size_t)((b * 2 + g) * 128 + n)) * 64 + jq * 16;
        *(v4u*)outp = w0; *(v4u*)(outp + 8) = w1;
    }
}
DI void conv_taps(const Ptrs& P, int c8, float (&cw)[3][8], float (&cb)[8]) {
#pragma unroll
    for (int k = 0; k < 3; ++k) { const f32x4 w0 = *(const f32x4*)(P.conv_w + k * 512 + c8), w1 = *(const f32x4*)(P.conv_w + k * 512 + c8 + 4);
        cw[k][0] = w0.x; cw[k][1] = w0.y; cw[k][2] = w0.z; cw[k][3] = w0.w; cw[k][4] = w1.x; cw[k][5] = w1.y; cw[k][6] = w1.z; cw[k][7] = w1.w; }
    const f32x4 w0 = *(const f32x4*)(P.conv_b + c8), w1 = *(const f32x4*)(P.conv_b + c8 + 4);
    cb[0] = w0.x; cb[1] = w0.y; cb[2] = w0.z; cb[3] = w0.w; cb[4] = w1.x; cb[5] = w1.y; cb[6] = w1.z; cb[7] = w1.w;
}
DI void ch_prod(const bf16* row, int c8, float (&u)[8]) {
    const v4u cv = *(const v4u*)(row + C_C + c8), hv = *(const v4u*)(row + C_H + c8);
    u[0] = bflo(cv.x) * bflo(hv.x); u[1] = bfhi(cv.x) * bfhi(hv.x); u[2] = bflo(cv.y) * bflo(hv.y); u[3] = bfhi(cv.y) * bfhi(hv.y);
    u[4] = bflo(cv.z) * bflo(hv.z); u[5] = bfhi(cv.z) * bfhi(hv.z); u[6] = bflo(cv.w) * bflo(hv.w); u[7] = bfhi(cv.w) * bfhi(hv.w);
}
DI void conv_out(const Ptrs& P, int t, int c8, const float (&cw)[3][8], const float (&cb)[8], const float (&u2)[8], const float (&u1)[8], const float (&u0)[8]) {
    const v4u bv = *(const v4u*)(P.PROJ + (size_t)t * INP + C_B + c8);
    const float bg[8] = {bflo(bv.x), bfhi(bv.x), bflo(bv.y), bfhi(bv.y), bflo(bv.z), bfhi(bv.z), bflo(bv.w), bfhi(bv.w)};
    float y[8];
#pragma unroll
    for (int e = 0; e < 8; ++e) y[e] = bg[e] * (cw[0][e] * u2[e] + cw[1][e] * u1[e] + cw[2][e] * u0[e] + cb[e]);
    v4u o; o.x = pk2(y[0], y[1]); o.y = pk2(y[2], y[3]); o.z = pk2(y[4], y[5]); o.w = pk2(y[6], y[7]);
    *(v4u*)(P.YMIX + (size_t)t * DM + c8) = o;
}
DI void proj_post_conv(const Ptrs& P, int mt, int wave, int lane) {
    const int c8 = lane * 8;
    float cw[3][8], cb[8]; conv_taps(P, c8, cw, cb);
    const int t0 = 256 * mt + 32 * wave, first = t0 + (wave == 0 ? 2 : 0);
    float u2[8], u1[8];
    if (wave) { ch_prod(P.PROJ + (size_t)(t0 - 2) * INP, c8, u2); ch_prod(P.PROJ + (size_t)(t0 - 1) * INP, c8, u1); }
    else {
#pragma unroll
        for (int e = 0; e < 8; ++e) { u2[e] = 0.f; u1[e] = 0.f; } }
#pragma unroll 1
    for (int t = t0; t < t0 + 32; t += 8) {
        v4u cv[8], hv[8], bv[8];
#pragma unroll
        for (int j = 0; j < 8; ++j) { const bf16* row = P.PROJ + (size_t)(t + j) * INP + c8; cv[j] = *(const v4u*)(row + C_C); hv[j] = *(const v4u*)(row + C_H); bv[j] = *(const v4u*)(row + C_B); }
#pragma unroll
        for (int j = 0; j < 8; ++j) {
            const float u0[8] = {bflo(cv[j].x) * bflo(hv[j].x), bfhi(cv[j].x) * bfhi(hv[j].x), bflo(cv[j].y) * bflo(hv[j].y), bfhi(cv[j].y) * bfhi(hv[j].y),
                                 bflo(cv[j].z) * bflo(hv[j].z), bfhi(cv[j].z) * bfhi(hv[j].z), bflo(cv[j].w) * bflo(hv[j].w), bfhi(cv[j].w) * bfhi(hv[j].w)};
            const float bg[8] = {bflo(bv[j].x), bfhi(bv[j].x), bflo(bv[j].y), bfhi(bv[j].y), bflo(bv[j].z), bfhi(bv[j].z), bflo(bv[j].w), bfhi(bv[j].w)};
            float y[8];
#pragma unroll
            for (int e = 0; e < 8; ++e) y[e] = bg[e] * (cw[0][e] * u2[e] + cw[1][e] * u1[e] + cw[2][e] * u0[e] + cb[e]);
            v4u o; o.x = pk2(y[0], y[1]); o.y = pk2(y[2], y[3]); o.z = pk2(y[4], y[5]); o.w = pk2(y[6], y[7]);
            if (t + j >= first) *(v4u*)(P.YMIX + (size_t)(t + j) * DM + c8) = o;
#pragma unroll
            for (int e = 0; e < 8; ++e) { u2[e] = u1[e]; u1[e] = u0[e]; }
        }
    }
}
DI void proj_post_knorm(const Ptrs& P, int mt, int wave, int lane) {
    const int grp = (lane >> 3) & 3, ch = lane & 7;
    const f32x4 w0 = *(const f32x4*)(P.k_norm_w + (grp < 2 ? 64 : 128) + ch * 8), w1 = *(const f32x4*)(P.k_norm_w + (grp < 2 ? 64 : 128) + ch * 8 + 4);
#pragma unroll 4
    for (int i = 0; i < 128 / NWAVES; ++i) {
        const int t = 256 * mt + (wave + NWAVES * i) * 2 + (lane >> 5);
        bf16* p = P.PROJ + (size_t)t * INP + (grp < 2 ? C_KS : C_KW) + (grp & 1) * 64 + ch * 8;
        const v4u u = *(const v4u*)p;
        const float a = bflo(u.x), b = bfhi(u.x), c = bflo(u.y), d = bfhi(u.y), e = bflo(u.z), f = bfhi(u.z), g2 = bflo(u.w), k = bfhi(u.w);
        const float ss = sum8(((a * a + b * b) + (c * c + d * d)) + ((e * e + f * f) + (g2 * g2 + k * k)));
        const float rr = 1.0f / sqrtf(ss * (1.f / 64.f) + EPS);
        v4u o; o.x = pk2(a * rr * w0.x, b * rr * w0.y); o.y = pk2(c * rr * w0.z, d * rr * w0.w); o.z = pk2(e * rr * w1.x, f * rr * w1.y); o.w = pk2(g2 * rr * w1.z, k * rr * w1.w);
        *(v4u*)p = o;
    }
}
DI void p2_misc(const Ptrs& P, LAS unsigned char* lds, int vcu, int G, int tid, int wave, int lane, bool do_norm) {
    const int ncw = G >> 2;
    if ((vcu & 3) == 0) {
        for (int u = vcu >> 2; u < 64; u += ncw) compress_unit(P, lds, u >> 5, (u >> 1) & 15, u & 1, tid, wave, lane);
        return;
    }
    const int ov = (vcu >> 2) * 3 + (vcu & 3) - 1, gw = ov * NWAVES + wave, NGW = (G - ncw) * NWAVES;
    if (do_norm) {
        pg8::Gemm g{P.MN, P.XKVT, NMEM, 2048, DM}; pg8::StaticOrder S; S.init(NMEM, 2048, G - ncw, ov);
        pg8::EpiBf16<0> E{P.XKV, 2048, nullptr, 0, 0, 1.f};
        pg8::gemm_phase<pg8::EpiBf16<0>, pg8::StaticOrder, true, true>(lds, g, S, E);
    }
    {
        const int c8 = lane * 8;
        float cw[3][8], cb[8]; conv_taps(P, c8, cw, cb);
        for (int i = gw; i < 2 * (NTOK / 256); i += NGW) {
            const int t = (i >> 1) * 256 + (i & 1), s = t & (SEQ - 1);
            float u[3][8];
#pragma unroll
            for (int k = 0; k < 3; ++k) {
                const int back = 2 - k;
                if (s >= back) ch_prod(P.PROJ + (size_t)(t - back) * INP, c8, u[k]);
                else {
#pragma unroll
                    for (int e = 0; e < 8; ++e) u[k][e] = 0.f; }
            }
            conv_out(P, t, c8, cw, cb, u[0], u[1], u[2]);
        }
    }
}
DI void xk_norm(const Ptrs& P, int gw, int NGW, int lane) {
    for (int it = gw; it < NMEM * 4 / 2; it += NGW) {
        const int rowid = it * 2 + (lane >> 5), m = rowid >> 2, hd = rowid & 3, ch = lane & 31;
        bf16* p = P.XKV + (size_t)m * 2048 + hd * 256 + ch * 8;
        const v4u u = *(const v4u*)p;
        const float a = bflo(u.x), b = bfhi(u.x), c = bflo(u.y), d = bfhi(u.y), e = bflo(u.z), f = bfhi(u.z), g2 = bflo(u.w), k = bfhi(u.w);
        const float ss = sum32(((a * a + b * b) + (c * c + d * d)) + ((e * e + f * f) + (g2 * g2 + k * k)));
        const float rr = 1.0f / sqrtf(ss * (1.f / 256.f) + EPS);
        f32x4 w0 = *(const f32x4*)(P.xk_norm_w + ch * 8), w1 = *(const f32x4*)(P.xk_norm_w + ch * 8 + 4);
        w0 *= *(const f32x4*)(P.xq_norm_w + ch * 8); w1 *= *(const f32x4*)(P.xq_norm_w + ch * 8 + 4);
        v4u o; o.x = pk2(a * rr * w0.x, b * rr * w0.y); o.y = pk2(c * rr * w0.z, d * rr * w0.w); o.z = pk2(e * rr * w1.x, f * rr * w1.y); o.w = pk2(g2 * rr * w1.z, k * rr * w1.w);
        *(v4u*)p = o;
    }
}
DI void p9_quant_h(const Ptrs& P, int gw, int NGW, int lane) {
    const f32x4 w0 = *(const f32x4*)(P.ffn_norm_w + 16 * lane), w1 = *(const f32x4*)(P.ffn_norm_w + 16 * lane + 4), w2 = *(const f32x4*)(P.ffn_norm_w + 16 * lane + 8), w3 = *(const f32x4*)(P.ffn_norm_w + 16 * lane + 12);
    for (int t0 = 4 * gw; t0 < NTOK; t0 += 4 * NGW) {
        v4u ha[4], hb[4];
#pragma unroll
        for (int q = 0; q < 4; ++q) { ha[q] = *(const v4u*)(P.HN + (size_t)(t0 + q) * DM + 16 * lane); hb[q] = *(const v4u*)(P.HN + (size_t)(t0 + q) * DM + 16 * lane + 8); }
#pragma unroll
        for (int q = 0; q < 4; ++q) {
            const float h0 = bflo(ha[q].x) * w0.x, h1 = bfhi(ha[q].x) * w0.y, h2 = bflo(ha[q].y) * w0.z, h3 = bfhi(ha[q].y) * w0.w, h4 = bflo(ha[q].z) * w1.x, h5 = bfhi(ha[q].z) * w1.y, h6 = bflo(ha[q].w) * w1.z, h7 = bfhi(ha[q].w) * w1.w;
            const float h8 = bflo(hb[q].x) * w2.x, h9 = bfhi(hb[q].x) * w2.y, h10 = bflo(hb[q].y) * w2.z, h11 = bfhi(hb[q].y) * w2.w, h12 = bflo(hb[q].z) * w3.x, h13 = bfhi(hb[q].z) * w3.y, h14 = bflo(hb[q].w) * w3.z, h15 = bfhi(hb[q].w) * w3.w;
            float mx = fmaxf(fmaxf(fmaxf(fabsf(h0), fabsf(h1)), fmaxf(fabsf(h2), fabsf(h3))), fmaxf(fmaxf(fabsf(h4), fabsf(h5)), fmaxf(fabsf(h6), fabsf(h7))));
            mx = fmaxf(mx, fmaxf(fmaxf(fmaxf(fabsf(h8), fabsf(h9)), fmaxf(fabsf(h10), fabsf(h11))), fmaxf(fmaxf(fabsf(h12), fabsf(h13)), fmaxf(fabsf(h14), fabsf(h15)))));
            mx = wave_max_u(mx);
            const float inv = mx > 0.f ? 127.0f / mx : 0.f;
            const v4u o = {q8x4(h0, h1, h2, h3, inv), q8x4(h4, h5, h6, h7, inv), q8x4(h8, h9, h10, h11, inv), q8x4(h12, h13, h14, h15, inv)};
            *(v4u*)(P.H8 + (size_t)(t0 + q) * DM + 16 * lane) = o;
            if (lane == 0) P.SH[t0 + q] = mx * (1.0f / 127.0f);
        }
    }
}

DI s16x4 tr_read(LAS const char* p) { return __builtin_bit_cast(s16x4, __builtin_amdgcn_ds_read_tr16_b64_v4i16((LAS s16x4*)p)); }
DI bf16x8 pack8a(const f32x16& x) { v4u p; p.x = pk2(x[0], x[1]); p.y = pk2(x[2], x[3]); p.z = pk2(x[4], x[5]); p.w = pk2(x[6], x[7]); return __builtin_bit_cast(bf16x8, p); }
DI bf16x8 pack8b(const f32x16& x) { v4u p; p.x = pk2(x[8], x[9]); p.y = pk2(x[10], x[11]); p.z = pk2(x[12], x[13]); p.w = pk2(x[14], x[15]); return __builtin_bit_cast(bf16x8, p); }
DI float max16(const f32x16& x) {
    float a = fmaxf(fmaxf(x[0], x[1]), fmaxf(x[2], x[3])), b = fmaxf(fmaxf(x[4], x[5]), fmaxf(x[6], x[7]));
    float c = fmaxf(fmaxf(x[8], x[9]), fmaxf(x[10], x[11])), d = fmaxf(fmaxf(x[12], x[13]), fmaxf(x[14], x[15]));
    return fmaxf(fmaxf(a, b), fmaxf(c, d));
}
DI float sum16(const f32x16& x) {
    return (((x[0] + x[1]) + (x[2] + x[3])) + ((x[4] + x[5]) + (x[6] + x[7]))) + (((x[8] + x[9]) + (x[10] + x[11])) + ((x[12] + x[13]) + (x[14] + x[15])));
}
template <int DH>
DI void qk_tile(LAS const char* ksm, const bf16x8* qf, f32x16& s0, f32x16& s1, int lane) {
    constexpr int KP = (DH + 8) * 2;
    LAS const char* kp = ksm + (lane & 31) * KP + (lane >> 5) * 16;
#pragma unroll
    for (int i = 0; i < 16; ++i) { s0[i] = 0.f; s1[i] = 0.f; }
#pragma unroll
    for (int d0 = 0; d0 < DH / 16; ++d0) {
        const bf16x8 a0 = *(LAS const bf16x8*)(kp + d0 * 32);
        const bf16x8 a1 = *(LAS const bf16x8*)(kp + 32 * KP + d0 * 32);
        s0 = MFMA32(a0, qf[d0], s0); s1 = MFMA32(a1, qf[d0], s1);
        if ((d0 & 3) == 3) __builtin_amdgcn_sched_barrier(0);
    }
}
template <int DH, int ND>
DI void pv_tile(LAS const char* vsm, const f32x16& p0, const f32x16& p1, f32x16* o, int dbase, int lane) {
    constexpr int VP = (DH + 32) * 2;
    const int h = lane >> 5, q4 = (lane & 15) >> 2, p = lane & 3, blk = (lane >> 4) & 1;
    LAS const char* vp = vsm + (4 * h + q4) * VP + (dbase + 16 * blk) * 2 + 8 * p;
    const bf16x8 pb0 = pack8a(p0), pb1 = pack8b(p0), pb2 = pack8a(p1), pb3 = pack8b(p1);
#pragma unroll
    for (int db = 0; db < ND; ++db) {
#define PV_STEP(S4, PB) { const s16x4 lo = tr_read(vp + (16 * (S4)) * VP + db * 64), hi = tr_read(vp + (16 * (S4) + 8) * VP + db * 64); \
        const bf16x8 va = __builtin_shufflevector(lo, hi, 0, 1, 2, 3, 4, 5, 6, 7); o[db] = MFMA32(va, PB, o[db]); }
        PV_STEP(0, pb0) PV_STEP(1, pb1) PV_STEP(2, pb2) PV_STEP(3, pb3)
        __builtin_amdgcn_sched_barrier(0);
#undef PV_STEP
    }
}
template <int DH, int ND>
DI void pv_tile_packed(LAS const char* vsm, const bf16x8& pb0, const bf16x8& pb1, const bf16x8& pb2, const bf16x8& pb3, f32x16* o, int dbase, int lane) {
    constexpr int VP = (DH + 32) * 2;
    const int h = lane >> 5, q4 = (lane & 15) >> 2, p = lane & 3, blk = (lane >> 4) & 1;
    LAS const char* vp = vsm + (4 * h + q4) * VP + (dbase + 16 * blk) * 2 + 8 * p;
#pragma unroll
    for (int db = 0; db < ND; ++db) {
#define PV_STEP(S4, PB) { const s16x4 lo = tr_read(vp + (16 * (S4)) * VP + db * 64), hi = tr_read(vp + (16 * (S4) + 8) * VP + db * 64); \
        const bf16x8 va = __builtin_shufflevector(lo, hi, 0, 1, 2, 3, 4, 5, 6, 7); o[db] = MFMA32(va, PB, o[db]); }
        PV_STEP(0, pb0) PV_STEP(1, pb1) PV_STEP(2, pb2) PV_STEP(3, pb3)
        __builtin_amdgcn_sched_barrier(0);
#undef PV_STEP
    }
}
DI void mask_tile(f32x16& s0, f32x16& s1, int klo, int khi, int h) {
    int hh = 4 * h; asm volatile("" : "+v"(hh));
    const int kl = klo - hh, kh = khi - hh;
#pragma unroll
    for (int i = 0; i < 16; ++i) { const int c0 = (i & 3) + 8 * (i >> 2), c1 = 32 + c0;
        s0[i] = (c0 >= kl && c0 <= kh) ? s0[i] : -INFINITY; s1[i] = (c1 >= kl && c1 <= kh) ? s1[i] : -INFINITY; }
}
DI float fmax3(float a, float b, float c) { float r; asm("v_max3_f32 %0, %1, %2, %3" : "=v"(r) : "v"(a), "v"(b), "v"(c)); return r; }
DI float max32(const f32x16& a, const f32x16& b) {
    float t0 = fmax3(a[0], a[1], a[2]), t1 = fmax3(a[3], a[4], a[5]), t2 = fmax3(a[6], a[7], a[8]), t3 = fmax3(a[9], a[10], a[11]), t4 = fmax3(a[12], a[13], a[14]);
    float u0 = fmax3(b[0], b[1], b[2]), u1 = fmax3(b[3], b[4], b[5]), u2 = fmax3(b[6], b[7], b[8]), u3 = fmax3(b[9], b[10], b[11]), u4 = fmax3(b[12], b[13], b[14]);
    t0 = fmax3(t0, t1, t2); t3 = fmax3(t3, t4, a[15]); u0 = fmax3(u0, u1, u2); u3 = fmax3(u3, u4, b[15]);
    return fmax3(fmax3(t0, t3, u0), u3, u3);
}
DI float max16t(const f32x16& a) {
    const float t0 = fmax3(a[0], a[1], a[2]), t1 = fmax3(a[3], a[4], a[5]), t2 = fmax3(a[6], a[7], a[8]), t3 = fmax3(a[9], a[10], a[11]), t4 = fmax3(a[12], a[13], a[14]);
    return fmax3(fmax3(t0, t1, t2), fmax3(t3, t4, a[15]), t0);
}
template <int ND>
DI void softmax_tile(f32x16& s0, f32x16& s1, f32x16* o, float& m, float& l, float dead) {
    float mx = max32(s0, s1); { const auto rr = __builtin_amdgcn_permlane32_swap(__float_as_uint(mx), __float_as_uint(mx), false, false); mx = fmax3(__uint_as_float(rr[0]), __uint_as_float(rr[1]), mx); }
    const float mn = fmaxf(m, mx), alpha = __builtin_amdgcn_exp2f(m - mn), mnd = mn + dead;
    s0 = s0 - mnd; s1 = s1 - mnd;
#pragma unroll
    for (int i = 0; i < 16; ++i) { s0[i] = __builtin_amdgcn_exp2f(s0[i]); s1[i] = __builtin_amdgcn_exp2f(s1[i]); }
    const f32x16 t = s0 + s1;
    float rs = sum16(t); { const auto rr = __builtin_amdgcn_permlane32_swap(__float_as_uint(rs), __float_as_uint(rs), false, false); rs = __uint_as_float(rr[0]) + __uint_as_float(rr[1]); }
    l = l * alpha + rs; m = mn;
#pragma unroll
    for (int db = 0; db < ND; ++db) o[db] *= alpha;
}
template <int DH>
DI void qk_tile_c(LAS const char* ksm, const bf16x8* qf, const f32x16& cinit, f32x16& s0, f32x16& s1, int lane) {
    constexpr int KP = (DH + 8) * 2;
    LAS const char* kp = ksm + (lane & 31) * KP + (lane >> 5) * 16;
    s0 = MFMA32(*(LAS const bf16x8*)(kp), qf[0], cinit); s1 = MFMA32(*(LAS const bf16x8*)(kp + 32 * KP), qf[0], cinit);
#pragma unroll
    for (int d0 = 1; d0 < DH / 16; ++d0) {
        const bf16x8 a0 = *(LAS const bf16x8*)(kp + d0 * 32);
        const bf16x8 a1 = *(LAS const bf16x8*)(kp + 32 * KP + d0 * 32);
        s0 = MFMA32(a0, qf[d0], s0); s1 = MFMA32(a1, qf[d0], s1);
    }
}
template <int ND>
DI void softmax_tile_ref(f32x16& s0, f32x16& s1, f32x16* o, float& negm, float& l) {
    float mx = max32(s0, s1); { const auto rr = __builtin_amdgcn_permlane32_swap(__float_as_uint(mx), __float_as_uint(mx), false, false); mx = fmax3(__uint_as_float(rr[0]), __uint_as_float(rr[1]), mx); }
    if (__any(mx > 8.0f)) {
        const float delta = mx > 8.0f ? mx : 0.f, f = __builtin_amdgcn_exp2f(-delta);
        s0 = s0 - delta; s1 = s1 - delta; negm = negm - delta; l *= f;
#pragma unroll
        for (int db = 0; db < ND; ++db) o[db] *= f;
    }
#pragma unroll
    for (int i = 0; i < 16; ++i) { s0[i] = __builtin_amdgcn_exp2f(s0[i]); s1[i] = __builtin_amdgcn_exp2f(s1[i]); }
    const f32x16 t = s0 + s1;
    float rs = sum16(t); { const auto rr = __builtin_amdgcn_permlane32_swap(__float_as_uint(rs), __float_as_uint(rs), false, false); rs = __uint_as_float(rr[0]) + __uint_as_float(rr[1]); }
    l += rs;
}
template <int DH>
DI void load_q_frags(const bf16* qrow, const float* w, float scale, bf16x8* qf, int lane) {
    const int h = lane >> 5;
    v4u raw[DH / 16]; float ss = 0.f;
#pragma unroll
    for (int d0 = 0; d0 < DH / 16; ++d0) { raw[d0] = *(const v4u*)(qrow + 16 * d0 + 8 * h);
        const float a = bflo(raw[d0].x), b = bfhi(raw[d0].x), c = bflo(raw[d0].y), d = bfhi(raw[d0].y), e = bflo(raw[d0].z), f = bfhi(raw[d0].z), g = bflo(raw[d0].w), k = bfhi(raw[d0].w);
        ss += ((a * a + b * b) + (c * c + d * d)) + ((e * e + f * f) + (g * g + k * k)); }
    ss += __shfl_xor(ss, 32);
    const float r = scale / sqrtf(ss * (1.f / DH) + EPS);
#pragma unroll
    for (int d0 = 0; d0 < DH / 16; ++d0) { const f32x4 w0 = *(const f32x4*)(w + 16 * d0 + 8 * h), w1 = *(const f32x4*)(w + 16 * d0 + 8 * h + 4);
        v4u o; o.x = pk2(bflo(raw[d0].x) * r * w0.x, bfhi(raw[d0].x) * r * w0.y); o.y = pk2(bflo(raw[d0].y) * r * w0.z, bfhi(raw[d0].y) * r * w0.w);
        o.z = pk2(bflo(raw[d0].z) * r * w1.x, bfhi(raw[d0].z) * r * w1.y); o.w = pk2(bflo(raw[d0].w) * r * w1.z, bfhi(raw[d0].w) * r * w1.w);
        qf[d0] = __builtin_bit_cast(bf16x8, o); }
}
template <int DH>
DI void tile_gload(const bf16* base, size_t pitch, v4u* regs, int tid) {
    constexpr int CPR = DH / 8;
#pragma unroll
    for (int k = 0; k < DH / 64; ++k) { const int id = tid + NTHR * k, row = id / CPR, ch = id % CPR; regs[k] = *(const v4u*)(base + (size_t)row * pitch + ch * 8); }
}
template <int DH, int PADE>
DI void tile_lstore(LAS char* sm, const v4u* regs, int tid) {
    constexpr int CPR = DH / 8, PB = (DH + PADE) * 2;
#pragma unroll
    for (int k = 0; k < DH / 64; ++k) { const int id = tid + NTHR * k, row = id / CPR, ch = id % CPR; *(LAS v4u*)(sm + row * PB + ch * 16) = regs[k]; }
}
DI float sigmoidf_(float x) { return 1.0f / (1.0f + __expf(-x)); }

DI void nsa_tile_fused(LAS const char* ksm, LAS const char* vsm, const bf16x8* qf, const f32x16& c0, f32x16* o, float& nref, float& l, int lane) {
    constexpr int KP = 144, VP = 192;
    LAS const char* kp = ksm + (lane & 31) * KP + (lane >> 5) * 16;
    const int h = lane >> 5, q4 = (lane & 15) >> 2, p = lane & 3, blk = (lane >> 4) & 1;
    LAS const char* vp = vsm + (4 * h + q4) * VP + (16 * blk) * 2 + 8 * p;
    f32x16 s0 = MFMA32(*(LAS const bf16x8*)(kp), qf[0], c0);
#pragma unroll
    for (int d0 = 1; d0 < 4; ++d0) s0 = MFMA32(*(LAS const bf16x8*)(kp + d0 * 32), qf[d0], s0);
    f32x16 s1 = MFMA32(*(LAS const bf16x8*)(kp + 32 * KP), qf[0], c0);
#pragma unroll
    for (int d0 = 1; d0 < 4; ++d0) s1 = MFMA32(*(LAS const bf16x8*)(kp + 32 * KP + d0 * 32), qf[d0], s1);
#define PV_STEP(S4, PB, DB) { const s16x4 lo = tr_read(vp + (16 * (S4)) * VP + (DB) * 64), hi = tr_read(vp + (16 * (S4) + 8) * VP + (DB) * 64); \
        const bf16x8 va = __builtin_shufflevector(lo, hi, 0, 1, 2, 3, 4, 5, 6, 7); o[DB] = MFMA32(va, PB, o[DB]); }
#pragma unroll
    for (int i = 0; i < 16; ++i) s0[i] = __builtin_amdgcn_exp2f(s0[i]);
    float rs = sum16(s0);
    { const bf16x8 pb0 = pack8a(s0), pb1 = pack8b(s0);
      PV_STEP(0, pb0, 0) PV_STEP(1, pb1, 0) PV_STEP(0, pb0, 1) PV_STEP(1, pb1, 1) }
#pragma unroll
    for (int i = 0; i < 16; ++i) s1[i] = __builtin_amdgcn_exp2f(s1[i]);
    rs += sum16(s1);
    { const bf16x8 pb2 = pack8a(s1), pb3 = pack8b(s1);
      PV_STEP(2, pb2, 0) PV_STEP(3, pb3, 0) PV_STEP(2, pb2, 1) PV_STEP(3, pb3, 1) }
#undef PV_STEP
    { const auto rr = __builtin_amdgcn_permlane32_swap(__float_as_uint(rs), __float_as_uint(rs), false, false); rs = __uint_as_float(rr[0]) + __uint_as_float(rr[1]); }
    l += rs;
    if (__any(l > 65536.0f)) {
        const unsigned e = l > 65536.0f ? (__float_as_uint(l) >> 23) - 127u : 0u;
        const float f = __uint_as_float((127u - e) << 23);
        nref -= (float)e; l *= f; o[0] *= f; o[1] *= f;
    }
}
constexpr int NSA_K_OFF = 0, NSA_V_OFF = 18432, NSA_IMP_OFF = 43008, NSA_IMP_PITCH = 36, NSA_SEL_OFF = NSA_IMP_OFF + 4 * 64 * NSA_IMP_PITCH * 4, NSA_TOT_OFF = NSA_SEL_OFF + 256;
template <int NQ>
DI void nsa_cmp_branch(LAS const char* ksm, LAS const char* vsm, LAS float* imph, const bf16x8* qf, int tpos, float gate0, LAS char* totp, int lane) {
    constexpr int KP = 144, VP = 192;
    const int h = lane >> 5;
    f32x16 s[NQ];
    qk_tile<64>(ksm, qf, s[0], s[1], lane);
    if (NQ == 4) qk_tile<64>(ksm + 64 * KP, qf, s[NQ - 2], s[NQ - 1], lane);
    const int nmax = tpos >= 31 ? min(126, (tpos - 31) >> 4) : -1;
    float mx = -INFINITY;
    int hh = 4 * h; asm volatile("" : "+v"(hh));
    const int nm = nmax - hh;
#pragma unroll
    for (int q = 0; q < NQ; ++q)
#pragma unroll
        for (int i = 0; i < 16; ++i) { const int c = 32 * q + (i & 3) + 8 * (i >> 2); s[q][i] = (c <= nm) ? s[q][i] : -INFINITY; mx = fmaxf(mx, s[q][i]); }
    { const auto rr = __builtin_amdgcn_permlane32_swap(__float_as_uint(mx), __float_as_uint(mx), false, false); mx = fmaxf(__uint_as_float(rr[0]), __uint_as_float(rr[1])); }
    const float mm = (mx == -INFINITY) ? 0.f : mx;
    float rs = 0.f;
#pragma unroll
    for (int q = 0; q < NQ; ++q) {
#pragma unroll
        for (int i = 0; i < 16; ++i) s[q][i] = __builtin_amdgcn_exp2f(s[q][i] - mm);
        rs += sum16(s[q]); }
    { const auto rr = __builtin_amdgcn_permlane32_swap(__float_as_uint(rs), __float_as_uint(rs), false, false); rs = __uint_as_float(rr[0]) + __uint_as_float(rr[1]); }
    const float inv = rs > 0.f ? 1.0f / rs : 0.f;
    if (NQ == 4) {
        LAS float* ip = imph + h;
#pragma unroll
        for (int G = 0; G < 16; ++G) { const int q = G >> 2, g4 = G & 3;
            const float sum4 = (s[q][4 * g4] + s[q][4 * g4 + 1]) + (s[q][4 * g4 + 2] + s[q][4 * g4 + 3]);
            const float last = s[q][4 * g4 + 3], prev = G ? s[(G - 1) >> 2][4 * ((G - 1) & 3) + 3] : 0.f;
            const auto rr = __builtin_amdgcn_permlane32_swap(__float_as_uint(prev), __float_as_uint(last), false, false);
            const float extra = h ? __uint_as_float(rr[0]) : __uint_as_float(rr[1]);
            ip[2 * G] = (sum4 + extra) * inv; }
    }
    f32x16 oc[2];
#pragma unroll
    for (int i = 0; i < 16; ++i) { oc[0][i] = 0.f; oc[1][i] = 0.f; }
    pv_tile<64, 2>(vsm, s[0], s[1], oc, 0, lane);
    if (NQ == 4) pv_tile<64, 2>(vsm + 64 * VP, s[NQ - 2], s[NQ - 1], oc, 0, lane);
    const float f = gate0 * inv;
#pragma unroll
    for (int c = 0; c < 8; ++c) { const f32x16& x = oc[c >> 2]; const int e = 4 * (c & 3); *(LAS f32x4*)(totp + c * 1024) = (f32x4){x[e] * f, x[e + 1] * f, x[e + 2] * f, x[e + 3] * f}; }
}
template <int MODE>
DI void nsa_unit(const Ptrs& P, LAS unsigned char* lds, int b, int g, int qi, int tid, int wave, int lane) {
    constexpr int KP = 144, VP = 192;
    const int r = lane & 31, h = lane >> 5;
    const int hd = g * 4 + (wave >> 1), tl = 32 * (wave & 1) + r;
    const size_t tok = (size_t)b * SEQ + 64 * qi + tl;
    const int tpos = 64 * qi + tl;
    LAS char* ksm = (LAS char*)lds + NSA_K_OFF; LAS char* vsm = (LAS char*)lds + NSA_V_OFF;
    LAS float* imp = (LAS float*)(lds + NSA_IMP_OFF); LAS unsigned* selm = (LAS unsigned*)(lds + NSA_SEL_OFF);
    v4u ckr[2], cvr[2];
    { const bf16* kc = P.KCMP + (size_t)(b * 2 + g) * 128 * 64; const bf16* vc = P.VCMP + (size_t)(b * 2 + g) * 128 * 64;
#pragma unroll
      for (int k = 0; k < 2; ++k) { const int id = tid + NTHR * k, row = id >> 3, ch = id & 7; ckr[k] = *(const v4u*)(kc + row * 64 + ch * 8); cvr[k] = *(const v4u*)(vc + row * 64 + ch * 8); } }
    const bf16* kvbase = P.PROJ + (size_t)b * SEQ * INP + g * 64;
    v4u kreg[1], vreg[1];
    tile_gload<64>(kvbase + C_KS, INP, kreg, tid); tile_gload<64>(kvbase + C_VS, INP, vreg, tid);
    bf16x8 qf[4];
    load_q_frags<64>(P.PROJ + tok * INP + C_Q + hd * 64, P.q_norm_w, 0.125f * LOG2E, qf, lane);
    float gate[3];
#pragma unroll
    for (int br = 0; br < 3; ++br) gate[br] = sigmoidf_(bf2f(P.PROJ[tok * INP + C_G + hd * 3 + br]));
    LAS char* totp = (LAS char*)lds + NSA_TOT_OFF + (wave * 512 + lane) * 16;

    __syncthreads();
    {
#pragma unroll
        for (int k = 0; k < 2; ++k) { const int id = tid + NTHR * k, row = id >> 3, ch = id & 7;
            *(LAS v4u*)(ksm + row * KP + ch * 16) = ckr[k]; *(LAS v4u*)(vsm + row * VP + ch * 16) = cvr[k]; }
    }
    __syncthreads();
    if (qi >= 16) nsa_cmp_branch<4>(ksm, vsm, imp + ((wave >> 1) * 64 + tl) * NSA_IMP_PITCH, qf, tpos, gate[0], totp, lane);
    else nsa_cmp_branch<2>(ksm, vsm, imp, qf, tpos, gate[0], totp, lane);
    __syncthreads();
    {
        const int tk = tid >> 3, sub = tid & 7;
        unsigned bits;
        if (qi >= 16) {
            float v[32];
#pragma unroll
            for (int c = 0; c < 8; ++c) { LAS const float* ip = imp + tk * NSA_IMP_PITCH + 4 * c;
                const f32x4 a = *(LAS const f32x4*)ip, b2 = *(LAS const f32x4*)(ip + 64 * NSA_IMP_PITCH), c2 = *(LAS const f32x4*)(ip + 128 * NSA_IMP_PITCH), d2 = *(LAS const f32x4*)(ip + 192 * NSA_IMP_PITCH);
                const f32x4 t = (a + b2) + (c2 + d2);
#pragma unroll
                for (int e = 0; e < 4; ++e) { const int j2 = 4 * c + e; v[j2] = (j2 >= 1 && j2 <= qi - 2) ? t[e] : -1.0f; } }
            bits = 0u;
#pragma unroll
            for (int k = 0; k < 4; ++k) { const int j = sub + 8 * k;
                float vj = v[8 * k];
#pragma unroll
                for (int t = 1; t < 8; ++t) vj = (sub == t) ? v[8 * k + t] : vj;
                int rank = 0;
#pragma unroll
                for (int j2 = 0; j2 < 32; ++j2) {
                    if ((j2 >> 3) < k) rank += (v[j2] >= vj) ? 1 : 0;
                    else if ((j2 >> 3) > k) rank += (v[j2] > vj) ? 1 : 0;
                    else rank += (v[j2] > vj || (v[j2] == vj && (j2 & 7) < sub)) ? 1 : 0; }
                if (j >= 1 && j <= qi - 2 && rank < 13) bits |= 1u << j; }
            bits |= __shfl_xor(bits, 1); bits |= __shfl_xor(bits, 2); bits |= __shfl_xor(bits, 4);
            bits |= 1u | (1u << qi) | (1u << (qi - 1));
        } else bits = (2u << qi) - 1u;
        if (sub == 0) selm[tk] = bits;
    }
    const int nsel = qi + 1, nwin = min(9, qi + 1), ntiles = nsel + nwin;
    f32x16 o[2]; float l = 0.f, nref = 0.f;
#pragma unroll
    for (int i = 0; i < 16; ++i) { o[0][i] = 0.f; o[1][i] = 0.f; }
    unsigned mysel = 0u;
    for (int tt = 0; tt < (MODE >= 5 ? 0 : ntiles); ++tt) {
        if (MODE != 2 || tt == 0) {
        __syncthreads();
        tile_lstore<64, 8>(ksm, kreg, tid); tile_lstore<64, 32>(vsm, vreg, tid);
        __syncthreads(); }
        if (tt == 0) mysel = selm[tl];
        if (MODE != 2 && tt + 1 < ntiles) { const int t2 = tt + 1; const bool w2 = t2 >= nsel; const int j2 = w2 ? qi - (t2 - nsel) : t2;
            tile_gload<64>(kvbase + (size_t)j2 * 64 * INP + (w2 ? C_KW : C_KS), INP, kreg, tid);
            tile_gload<64>(kvbase + (size_t)j2 * 64 * INP + (w2 ? C_VW : C_VS), INP, vreg, tid); }
        const bool win = tt >= nsel; const int j = win ? qi - (tt - nsel) : tt;
        if (tt == nsel) {
            const float f = l > 0.f ? gate[1] / l : 0.f;
#pragma unroll
            for (int c = 0; c < 8; ++c) { const f32x16& x = o[c >> 2]; const int e = 4 * (c & 3); LAS f32x4* tp = (LAS f32x4*)(totp + c * 1024); *tp = *tp + (f32x4){x[e] * f, x[e + 1] * f, x[e + 2] * f, x[e + 3] * f}; }
#pragma unroll
            for (int i = 0; i < 16; ++i) { o[0][i] = 0.f; o[1][i] = 0.f; }
            l = 0.f; nref = 0.f;
        }
        if (MODE == 1) continue;
        const bool dead = !win && !((mysel >> j) & 1u);
        f32x16 c0;
        { const float cv = dead ? -INFINITY : nref;
#pragma unroll
          for (int i = 0; i < 16; ++i) c0[i] = cv; }
        if (j == qi || (win && j == qi - 8)) {
            f32x16 s0, s1;
            qk_tile_c<64>(ksm, qf, c0, s0, s1, lane);
            int klo = 0, khi = 63;
            if (j == qi) khi = tl; else klo = tl + 1;
            mask_tile(s0, s1, klo, khi, h);
            softmax_tile_ref<2>(s0, s1, o, nref, l);
            pv_tile<64, 2>(vsm, s0, s1, o, 0, lane);
        } else nsa_tile_fused(ksm, vsm, qf, c0, o, nref, l, lane);
    }
    { const float f = l > 0.f ? gate[2] / l : 0.f;
      bf16* op = P.YMIX + tok * DM + 512 + hd * 64 + 4 * h;
#pragma unroll
      for (int c = 0; c < 8; ++c) { const f32x16& x = o[c >> 2]; const int e = 4 * (c & 3); const f32x4 t = *(LAS const f32x4*)(totp + c * 1024) + (f32x4){x[e] * f, x[e + 1] * f, x[e + 2] * f, x[e + 3] * f};
          v2u w; w.x = pk2(t[0], t[1]); w.y = pk2(t[2], t[3]);
          *(v2u*)(op + 32 * (c >> 2) + 8 * (c & 3)) = w; } }
}
template <int MODE>
DI void p3_nsa(const Ptrs& P, LAS unsigned char* lds, int vcu, int G, int tid, int wave, int lane) {
    for (int v = vcu; v < 256; v += G) {
        const int bg = v >> 3, s = v & 7;
#pragma unroll 1
        for (int k = 0; k < 4; ++k) { const int qi = (k == 0) ? 31 - s : (k == 1) ? 16 + s : (k == 2) ? 15 - s : s;
            nsa_unit<MODE>(P, lds, bg >> 1, bg & 1, qi, tid, wave, lane); }
    }
}

constexpr int XA_Q_OFF = 0, XA_K_OFF = 67584, XA_V_OFF = 101376, XA_XP_OFF = 138240, XA_XR_OFF = XA_XP_OFF + 16384;
DI void xattn_unit(const Ptrs& P, LAS unsigned char* lds, int b, int hd, int qt, int tid, int wave, int lane) {
    constexpr int KP = 528, VP = 576;
    const int r = lane & 31, h = lane >> 5, rb = wave >> 1, kh = wave & 1;
    const size_t tok0 = (size_t)b * SEQ + 128 * qt;
    LAS char* qsm = (LAS char*)lds + XA_Q_OFF; LAS char* ksm = (LAS char*)lds + XA_K_OFF; LAS char* vsm = (LAS char*)lds + XA_V_OFF;
    LAS const char* qrow = qsm + (32 * rb + r) * KP + h * 16;
    LAS char* xw = (LAS char*)lds + XA_XP_OFF + (wave * 64 + lane) * 16;
    LAS const char* xr0 = (LAS const char*)lds + XA_XP_OFF + (rb * 128 + lane) * 16;
    LAS float* xs = (LAS float*)(lds + XA_XR_OFF);
    const bf16* kb = P.XKV + (size_t)b * MEMT * 2048 + hd * 256; const bf16* vb = kb + 1024;
    v4u kreg[4], vreg[4];
    tile_gload<256>(kb, 2048, kreg, tid); tile_gload<256>(vb, 2048, vreg, tid);
    f32x4 sp0, sp1, sp2, sp3;
    { const float* sp = P.SSP1 + (tok0 + 32 * rb + r) * 16; sp0 = *(const f32x4*)sp; sp1 = *(const f32x4*)(sp + 4); sp2 = *(const f32x4*)(sp + 8); sp3 = *(const f32x4*)(sp + 12); }
    {
        const bf16* qb = P.XQ + tok0 * DM + hd * 256;
        v4u qreg[8];
#pragma unroll
        for (int k = 0; k < 8; ++k) { const int id = tid + NTHR * k, row = id >> 5, ch = id & 31; qreg[k] = *(const v4u*)(qb + (size_t)row * DM + ch * 8); }
        __syncthreads();
#pragma unroll
        for (int k = 0; k < 8; ++k) { const int id = tid + NTHR * k, row = id >> 5, ch = id & 31; *(LAS v4u*)(qsm + row * KP + ch * 16) = qreg[k]; }
    }
    f32x16 o[4]; float nref = 0.f, l = 0.f, cq = 0.f;
#pragma unroll
    for (int db = 0; db < 4; ++db)
#pragma unroll
        for (int i = 0; i < 16; ++i) o[db][i] = 0.f;
#pragma unroll 1
    for (int tt = 0; tt < 4; ++tt) {
        if (tt > 0) __syncthreads();
        tile_lstore<256, 8>(ksm, kreg, tid); tile_lstore<256, 32>(vsm, vreg, tid);
        __syncthreads();
        if (tt + 1 < 4) { tile_gload<256>(kb + (size_t)(tt + 1) * 64 * 2048, 2048, kreg, tid); tile_gload<256>(vb + (size_t)(tt + 1) * 64 * 2048, 2048, vreg, tid); }
        if (tt == 0) {
            float ss = 0.f;
#pragma unroll
            for (int d0 = 0; d0 < 16; ++d0) { const v4u u = *(LAS const v4u*)(qrow + d0 * 32);
                const float a = bflo(u.x), b2 = bfhi(u.x), c = bflo(u.y), d = bfhi(u.y), e = bflo(u.z), f = bfhi(u.z), g = bflo(u.w), k = bfhi(u.w);
                ss += ((a * a + b2 * b2) + (c * c + d * d)) + ((e * e + f * f) + (g * g + k * k)); }
            ss += __shfl_xor(ss, 32);
            const f32x4 p0 = sp0, p1 = sp1, p2 = sp2, p3 = sp3;
            const float rt = 1.0f / sqrtf((((p0.x + p0.y) + (p0.z + p0.w)) + ((p1.x + p1.y) + (p1.z + p1.w)) + ((p2.x + p2.y) + (p2.z + p2.w)) + ((p3.x + p3.y) + (p3.z + p3.w))) * (1.f / DM) + EPS);
            cq = 0.0625f * LOG2E * rt / sqrtf(rt * rt * ss * (1.f / 256.f) + EPS);
        }
        f32x16 s;
        {
            LAS const char* kp = ksm + (32 * kh + r) * KP + h * 16;
#pragma unroll
            for (int i = 0; i < 16; ++i) s[i] = 0.f;
#pragma unroll
            for (int d0 = 0; d0 < 16; ++d0) {
                const bf16x8 a0 = *(LAS const bf16x8*)(kp + d0 * 32), bq = *(LAS const bf16x8*)(qrow + d0 * 32);
                s = MFMA32(a0, bq, s);
                if ((d0 & 3) == 3) __builtin_amdgcn_sched_barrier(0);
            }
        }
        s = s * cq + nref;
#pragma unroll
        for (int i = 0; i < 16; ++i) s[i] = __builtin_amdgcn_exp2f(s[i]);
        { float rs = sum16(s); { const auto rr = __builtin_amdgcn_permlane32_swap(__float_as_uint(rs), __float_as_uint(rs), false, false); rs = __uint_as_float(rr[0]) + __uint_as_float(rr[1]); }
          *(LAS bf16x8*)xw = pack8a(s); *(LAS bf16x8*)(xw + 8192) = pack8b(s); xs[wave * 64 + lane] = rs; }
        __syncthreads();
        {
            const bf16x8 pb0 = *(LAS const bf16x8*)xr0, pb1 = *(LAS const bf16x8*)(xr0 + 8192), pb2 = *(LAS const bf16x8*)(xr0 + 1024), pb3 = *(LAS const bf16x8*)(xr0 + 1024 + 8192);
            l += xs[rb * 128 + lane] + xs[rb * 128 + 64 + lane];
            pv_tile_packed<256, 4>(vsm, pb0, pb1, pb2, pb3, o, 128 * kh, lane);
        }
        if (__any(l > 65536.0f)) {
            const unsigned e = l > 65536.0f ? (__float_as_uint(l) >> 23) - 127u : 0u;
            const float f2 = __uint_as_float((127u - e) << 23);
            nref -= (float)e; l *= f2;
#pragma unroll
            for (int db = 0; db < 4; ++db) o[db] *= f2;
        }
    }
    const float f = 1.0f / l;
    bf16* op = P.YMIX + (tok0 + 32 * rb + r) * DM + hd * 256 + 128 * kh + 4 * h;
#pragma unroll
    for (int db = 0; db < 4; ++db)
#pragma unroll
        for (int g4 = 0; g4 < 4; ++g4) { v2u w; w.x = pk2(o[db][4 * g4] * f, o[db][4 * g4 + 1] * f); w.y = pk2(o[db][4 * g4 + 2] * f, o[db][4 * g4 + 3] * f);
            *(v2u*)(op + 32 * db + 8 * g4) = w; }
}
DI void p7_xattn(const Ptrs& P, LAS unsigned char* lds, int bx, int G, int tid, int wave, int lane) {
    pg8::StaticOrder SO; SO.init(NTOK, DM, G, bx); pg8::Unit un;
    for (int ui = 0; SO.next(ui, un); ++ui) {
        const int b = un.pm >> 3, qt0 = (un.pm & 7) * 2;
        xattn_unit(P, lds, b, un.pn, qt0, tid, wave, lane); xattn_unit(P, lds, b, un.pn, qt0 + 1, tid, wave, lane);
    }
}

DI unsigned umax3(unsigned a, unsigned b, unsigned c) { return max(max(a, b), c); }
DI unsigned umax16(const unsigned* k) {
    return umax3(umax3(umax3(k[0], k[1], k[2]), umax3(k[3], k[4], k[5]), umax3(k[6], k[7], k[8])), umax3(umax3(k[9], k[10], k[11]), umax3(k[12], k[13], k[14]), k[15]), 0u);
}
DI unsigned pair_umax(unsigned m) { const auto rr = __builtin_amdgcn_permlane32_swap(m, m, false, false); return max((unsigned)rr[0], (unsigned)rr[1]); }
constexpr int PK_PITCH = 272;
constexpr int PK_SCR_OFF = 2 * 128 * PK_PITCH;
DI void p11_peer_topk(const Ptrs& P, LAS unsigned char* lds, int bx, int G, int tid, int wave, int lane) {
    const int r = lane & 31, h = lane >> 5;
    LAS char* ksm = (LAS char*)lds;
    LAS unsigned* tvl = (LAS unsigned*)(lds + PK_SCR_OFF + wave * 8192);
    LAS float* bsl = (LAS float*)(tvl + 1024); LAS int* bel = (LAS int*)(tvl + 1536);
    pg8::StaticOrder SO; SO.init(NTOK, 2048, G, bx); pg8::Unit un;
    for (int ui = 0; SO.next(ui, un); ++ui) {
        const int hd = un.pn;
        __syncthreads();
        {
            const bf16* kb = P.PKEYS + (size_t)hd * 2 * 128 * 128;
#pragma unroll
            for (int k = 0; k < 8; ++k) { const int id = tid + NTHR * k, row = id >> 4, ch = id & 15; *(LAS v4u*)(ksm + row * PK_PITCH + ch * 16) = *(const v4u*)(kb + row * 128 + ch * 8); }
        }
        __syncthreads();
        {
        const size_t tok = (size_t)un.pm * 256 + 32 * wave + r;
#pragma unroll 1
        for (int c = 0; c < 2; ++c) {
            bf16x8 qf[8];
#pragma unroll
            for (int d0 = 0; d0 < 8; ++d0) qf[d0] = *(const bf16x8*)(P.PQ + tok * 2048 + hd * 256 + c * 128 + 16 * d0 + 8 * h);
            unsigned key[64];
            unsigned h4 = 4u * (unsigned)h; asm volatile("" : "+v"(h4));
#pragma unroll
            for (int nb = 0; nb < 4; ++nb) {
                f32x16 sc;
#pragma unroll
                for (int i = 0; i < 16; ++i) sc[i] = 64.f;
                LAS const char* kp = ksm + (c * 128 + 32 * nb + r) * PK_PITCH + h * 16;
#pragma unroll
                for (int d0 = 0; d0 < 8; ++d0) sc = MFMA32(*(LAS const bf16x8*)(kp + d0 * 32), qf[d0], sc);
#pragma unroll
                for (int i = 0; i < 16; ++i) key[16 * nb + i] = ((__float_as_uint(sc[i]) & ~0x7Fu) | h4) | (unsigned)(32 * nb + (i & 3) + 8 * (i >> 2));
            }
            unsigned w = pair_umax(umax3(umax16(key), umax16(key + 16), umax3(umax16(key + 32), umax16(key + 48), 0u)));
            if (h == 0) tvl[(c * 16) * 32 + r] = w;
#pragma unroll 1
            for (int k = 1; k < 16; ++k) {
                unsigned d[64];
#pragma unroll
                for (int i = 0; i < 64; ++i) d[i] = key[i] - w;
                w += pair_umax(umax3(umax16(d), umax16(d + 16), umax3(umax16(d + 32), umax16(d + 48), 0u)));
                if (h == 0) tvl[(c * 16 + k) * 32 + r] = w;
            }
        }
        LDS_WAIT(); asm volatile("" ::: "memory");
        float t0[16], t1[16];
#pragma unroll
        for (int k = 0; k < 16; ++k) { t0[k] = __uint_as_float(tvl[k * 32 + r] & ~0x7Fu); t1[k] = __uint_as_float(tvl[(16 + k) * 32 + r] & ~0x7Fu); }
        unsigned cand[25];
        {
            int n = 0;
#pragma unroll
            for (int a = 0; a < 16; ++a)
#pragma unroll
                for (int b = 0; b < 16; ++b)
                    if ((a + 1) * (b + 1) <= 16) {
                        const unsigned key = (__float_as_uint(t0[a] + t1[b]) & ~0xFFu) | (unsigned)(a * 16 + b);
                        if ((n & 1) == 0) cand[n >> 1] = key; else cand[n >> 1] = h ? key : cand[n >> 1];
                        ++n;
                    }
        }
        unsigned w = 0u;
#pragma unroll
        for (int q = 0; q < 25; ++q) w = max(w, cand[q]);
        w = pair_umax(w);
#pragma unroll 1
        for (int k = 0; k < 16; ++k) {
            if (k > 0) { unsigned m = 0u;
#pragma unroll
                for (int q = 0; q < 25; ++q) m = max(m, cand[q] - w);
                w += pair_umax(m); }
            const int ia = (int)((w >> 4) & 15u), ib = (int)(w & 15u);
            const int e0 = (int)(tvl[ia * 32 + r] & 0x7Fu), e1 = (int)(tvl[(16 + ib) * 32 + r] & 0x7Fu);
            if (h == 0) { bsl[k * 32 + r] = __uint_as_float(w & ~0xFFu); bel[k * 32 + r] = e0 * 128 + e1; }
        }
        LDS_WAIT(); asm volatile("" ::: "memory");
        if (h == 0) {
            float bs[16]; int be[16];
#pragma unroll
            for (int k = 0; k < 16; ++k) { bs[k] = bsl[k * 32 + r]; be[k] = bel[k * 32 + r]; }
            const float* sp = P.SSP2 + tok * 16; const f32x4 p0 = *(const f32x4*)sp, p1 = *(const f32x4*)(sp + 4), p2 = *(const f32x4*)(sp + 8), p3 = *(const f32x4*)(sp + 12);
            const float rt = 1.0f / sqrtf((((p0.x + p0.y) + (p0.z + p0.w)) + ((p1.x + p1.y) + (p1.z + p1.w)) + ((p2.x + p2.y) + (p2.z + p2.w)) + ((p3.x + p3.y) + (p3.z + p3.w))) * (1.f / DM) + EPS);
            const float mx = bs[0]; float sum = 0.f;
#pragma unroll
            for (int k = 0; k < 16; ++k) { bs[k] = __expf((bs[k] - mx) * rt); sum += bs[k]; }
            const float inv = 1.0f / sum;
            int* ip = P.PIDX + tok * 128 + hd * 16; float* gp = P.PGATE + tok * 128 + hd * 16;
#pragma unroll
            for (int k4 = 0; k4 < 4; ++k4) {
                *(v4u*)(ip + 4 * k4) = (v4u){(unsigned)be[4 * k4], (unsigned)be[4 * k4 + 1], (unsigned)be[4 * k4 + 2], (unsigned)be[4 * k4 + 3]};
                *(f32x4*)(gp + 4 * k4) = (f32x4){bs[4 * k4] * inv, bs[4 * k4 + 1] * inv, bs[4 * k4 + 2] * inv, bs[4 * k4 + 3] * inv};
            }
        }
        LDS_WAIT(); asm volatile("" ::: "memory");
        }
    }
}

template <int CTRL> DI float dpp_mov(float v) { return __uint_as_float((unsigned)__builtin_amdgcn_update_dpp(0, (int)__float_as_uint(v), CTRL, 0xF, 0xF, true)); }
template <int CTRL> DI int dpp_movi(int v) { return __builtin_amdgcn_update_dpp(0, v, CTRL, 0xF, 0xF, true); }
DI int wave_sum_i(int v) {
    v += dpp_movi<0xB1>(v); v += dpp_movi<0x4E>(v); v += dpp_movi<0x141>(v); v += dpp_movi<0x140>(v);
    return (__builtin_amdgcn_readlane(v, 0) + __builtin_amdgcn_readlane(v, 16)) + (__builtin_amdgcn_readlane(v, 32) + __builtin_amdgcn_readlane(v, 48));
}
DI float wave_max_f(float v) {
    v = fmaxf(v, dpp_mov<0xB1>(v)); v = fmaxf(v, dpp_mov<0x4E>(v)); v = fmaxf(v, dpp_mov<0x141>(v)); v = fmaxf(v, dpp_mov<0x140>(v));
    return fmaxf(fmaxf(rlane(v, 0), rlane(v, 16)), fmaxf(rlane(v, 32), rlane(v, 48)));
}
DI float gelu_as(float v) {
    const float av = fabsf(v), t = __builtin_amdgcn_rcpf(av * 0.2316418882f + 1.0f);
    float q = t * 0.5307027145f + (-0.7265760135f); q = q * t + 0.7107068705f; q = q * t + (-0.142248368f); q = q * t + 0.127414796f; q = q * t;
    const float e = __builtin_amdgcn_exp2f((v * v) * (-0.72134752044f)), m = v * (q * e);
    return v < 0.f ? m : v - m;
}
DI int dot16_i8(const v4u& a, const v4u& b) {
    int c = __builtin_amdgcn_sdot4((int)a.x, (int)b.x, 0, false);
    c = __builtin_amdgcn_sdot4((int)a.y, (int)b.y, c, false); c = __builtin_amdgcn_sdot4((int)a.z, (int)b.z, c, false); c = __builtin_amdgcn_sdot4((int)a.w, (int)b.w, c, false);
    return c;
}
DI void axpy4_u8(float* acc, float a, unsigned u) {
    acc[0] += a * (float)(u & 0xffu); acc[1] += a * (float)((u >> 8) & 0xffu); acc[2] += a * (float)((u >> 16) & 0xffu); acc[3] += a * (float)(u >> 24);
}
DI unsigned quant4(float a, float b, float c, float d, float inv) {
    return ((unsigned)(int)__builtin_rintf(a * inv) & 0xffu) | (((unsigned)(int)__builtin_rintf(b * inv) & 0xffu) << 8) | (((unsigned)(int)__builtin_rintf(c * inv) & 0xffu) << 16) | (((unsigned)(int)__builtin_rintf(d * inv) & 0xffu) << 24);
}
typedef float f32x2 __attribute__((ext_vector_type(2)));
constexpr int PEER_SLICE_SHIFT = 7, PEER_NSLICE = NEXP >> PEER_SLICE_SHIFT;
constexpr int P12_WAVE_LDS = 8192 + 512;
DI void axpy16_fp4(f32x2* acc, float a, const v4u& rw) {
    const v2u uq = {rw.z, rw.w};
    const f32x2 aa = {a, a};
    f32x2 t[4];
    t[0] = __builtin_amdgcn_cvt_scalef32_pk_f32_fp4(uq.x, 1.0f, 0); t[1] = __builtin_amdgcn_cvt_scalef32_pk_f32_fp4(uq.x, 1.0f, 1); t[2] = __builtin_amdgcn_cvt_scalef32_pk_f32_fp4(uq.x, 1.0f, 2); t[3] = __builtin_amdgcn_cvt_scalef32_pk_f32_fp4(uq.x, 1.0f, 3);
    asm volatile("" : "+v"(t[0]), "+v"(t[1]), "+v"(t[2]), "+v"(t[3]));
#pragma unroll
    for (int j = 0; j < 4; ++j) acc[j] = __builtin_elementwise_fma(aa, t[j], acc[j]);
    t[0] = __builtin_amdgcn_cvt_scalef32_pk_f32_fp4(uq.y, 1.0f, 0); t[1] = __builtin_amdgcn_cvt_scalef32_pk_f32_fp4(uq.y, 1.0f, 1); t[2] = __builtin_amdgcn_cvt_scalef32_pk_f32_fp4(uq.y, 1.0f, 2); t[3] = __builtin_amdgcn_cvt_scalef32_pk_f32_fp4(uq.y, 1.0f, 3);
    asm volatile("" : "+v"(t[0]), "+v"(t[1]), "+v"(t[2]), "+v"(t[3]));
#pragma unroll
    for (int j = 0; j < 4; ++j) acc[4 + j] = __builtin_elementwise_fma(aa, t[j], acc[4 + j]);
}
DI int dot16_n4(const v4u& hq, const v4u& dq) {
    int c = __builtin_amdgcn_sdot4((int)hq.x, (int)((dq.x << 4) & 0xF0F0F0F0u), 0, false);
    c = __builtin_amdgcn_sdot4((int)hq.y, (int)(dq.x & 0xF0F0F0F0u), c, false);
    c = __builtin_amdgcn_sdot4((int)hq.z, (int)((dq.y << 4) & 0xF0F0F0F0u), c, false);
    c = __builtin_amdgcn_sdot4((int)hq.w, (int)(dq.y & 0xF0F0F0F0u), c, false);
    return c;
}
DI float reduce4_classes_f(float p0, float p1, float p2, float p3, bool b0, bool b1) {
    float x01 = b0 ? p1 : p0; const float y01 = b0 ? p0 : p1; x01 += dpp_mov<0xB1>(y01);
    float x23 = b0 ? p3 : p2; const float y23 = b0 ? p2 : p3; x23 += dpp_mov<0xB1>(y23);
    float w = b1 ? x23 : x01; const float w2 = b1 ? x01 : x23; w += dpp_mov<0x4E>(w2);
    w += dpp_mov<0x124>(w); w += dpp_mov<0x128>(w);
    { const auto r = __builtin_amdgcn_permlane16_swap(__float_as_uint(w), __float_as_uint(w), false, false); w = __uint_as_float(r[0]) + __uint_as_float(r[1]); }
    { const auto r = __builtin_amdgcn_permlane32_swap(__float_as_uint(w), __float_as_uint(w), false, false); w = __uint_as_float(r[0]) + __uint_as_float(r[1]); }
    return w;
}
template <int MODE>
DI void p12_peer_gather(const Ptrs& P, LAS unsigned char* lds, const float* obase, float* odst, int gw, int NGW, int wave, int lane) {
    LAS v4u* sorted = (LAS v4u*)(lds + wave * P12_WAVE_LDS); LAS unsigned* hist = (LAS unsigned*)(lds + wave * P12_WAVE_LDS + 8192);
    const bool b0 = (lane & 1) != 0, b1 = (lane & 2) != 0; const int cls = lane & 3;
    const int l16 = 16 * lane, l4 = 1024 + 4 * lane;
    const __amdgpu_buffer_rsrc_t rtab = __builtin_amdgcn_make_buffer_rsrc((void*)P.PDOWN, 0, NEXP * PEER_ROW_BYTES, 0x00020000);
    for (int tg = gw; tg < NTOK / 4; tg += NGW) {
        v4u hq[4]; f32x2 acc[4][8]; float asl[4]; float shv = 0.f;
#pragma unroll 1
        for (int u = 0; u < 4; ++u) {
            const size_t o = ((size_t)tg * 4 + u) * 128 + lane;
            const int i0 = P.PIDX[o], i1 = P.PIDX[o + 64];
            const float ga = P.PGATE[o], gb = P.PGATE[o + 64];
            hist[lane] = 0u; hist[64 + lane] = 0u;
            LDS_WAIT(); asm volatile("" ::: "memory");
            const unsigned r0 = __hip_atomic_fetch_add(&hist[i0 >> PEER_SLICE_SHIFT], 1u, __ATOMIC_RELAXED, __HIP_MEMORY_SCOPE_WORKGROUP);
            const unsigned r1 = __hip_atomic_fetch_add(&hist[i1 >> PEER_SLICE_SHIFT], 1u, __ATOMIC_RELAXED, __HIP_MEMORY_SCOPE_WORKGROUP);
            LDS_WAIT(); asm volatile("" ::: "memory");
            const unsigned c0 = hist[2 * lane], c1 = hist[2 * lane + 1]; unsigned incl = c0 + c1;
#pragma unroll
            for (int s2 = 1; s2 < 64; s2 <<= 1) { const unsigned t = __shfl_up(incl, s2); if (lane >= s2) incl += t; }
            const unsigned excl = incl - (c0 + c1);
            LDS_WAIT(); asm volatile("" ::: "memory");
            hist[2 * lane] = excl; hist[2 * lane + 1] = excl + c0;
            LDS_WAIT(); asm volatile("" ::: "memory");
            const unsigned p0 = hist[i0 >> PEER_SLICE_SHIFT] + r0, p1 = hist[i1 >> PEER_SLICE_SHIFT] + r1;
            sorted[u * 128 + p0] = (v4u){__float_as_uint(ga), 0u, (unsigned)i0, 0u};
            sorted[u * 128 + p1] = (v4u){__float_as_uint(gb), 0u, (unsigned)i1, 0u};
            LDS_WAIT(); asm volatile("" ::: "memory");
        }
#pragma unroll
        for (int u = 0; u < 4; ++u) { const size_t t = (size_t)tg * 4 + u;
            const v4u hb8 = *(const v4u*)(P.H8 + t * DM + 16 * lane);
            const float* sp = P.SSP2 + t * 16; const f32x4 p0 = *(const f32x4*)sp, p1 = *(const f32x4*)(sp + 4), p2 = *(const f32x4*)(sp + 8), p3 = *(const f32x4*)(sp + 12);
            const float rt = 1.0f / sqrtf((((p0.x + p0.y) + (p0.z + p0.w)) + ((p1.x + p1.y) + (p1.z + p1.w)) + ((p2.x + p2.y) + (p2.z + p2.w)) + ((p3.x + p3.y) + (p3.z + p3.w))) * (1.f / DM) + EPS);
            shv = (cls == u) ? P.SH[t] * (1.0f / 16.0f) * rt : shv;
            hq[u].x = __builtin_amdgcn_perm(hb8.y, hb8.x, 0x06040200u); hq[u].y = __builtin_amdgcn_perm(hb8.y, hb8.x, 0x07050301u);
            hq[u].z = __builtin_amdgcn_perm(hb8.w, hb8.z, 0x06040200u); hq[u].w = __builtin_amdgcn_perm(hb8.w, hb8.z, 0x07050301u);
            asl[u] = 0.f;
#pragma unroll
            for (int j = 0; j < 8; ++j) acc[u][j] = (f32x2){0.f, 0.f}; }
        v4u rwA[4], rwB[4]; unsigned scA[4], scB[4]; float gtA, gtB;
#define P12_FETCH(BI, RW, SC, GT) { GT = *(LAS const float*)((LAS const char*)sorted + (cls * 128 + (BI)) * 16); \
        _Pragma("unroll") for (int k = 0; k < 4; ++k) { const unsigned w0 = (unsigned)__builtin_amdgcn_readfirstlane((int)sorted[k * 128 + (BI)].z) & (MODE == 1 ? 63u : 0xffffffffu); \
        const int ro = (int)(w0 * (unsigned)PEER_ROW_BYTES);               \
        RW[k] = __builtin_bit_cast(v4u, __builtin_amdgcn_raw_buffer_load_b128(rtab, l16, ro, 0)); SC[k] = (unsigned)__builtin_amdgcn_raw_buffer_load_b32(rtab, l4, ro, 0); } }
#define P12_COMPUTE(RW, SC, GT) if (MODE == 2) { _Pragma("unroll") for (int k = 0; k < 4; ++k) { asl[k] += __uint_as_float((RW[k].x ^ RW[k].y) ^ (RW[k].z ^ RW[k].w) ^ SC[k]); } } else { \
        const float w_ = reduce4_classes_f((float)dot16_n4(hq[0], RW[0]) * bflo(SC[0]), (float)dot16_n4(hq[1], RW[1]) * bflo(SC[1]), \
                                           (float)dot16_n4(hq[2], RW[2]) * bflo(SC[2]), (float)dot16_n4(hq[3], RW[3]) * bflo(SC[3]), b0, b1); \
        const float a_ = gelu_as(w_ * shv) * GT; \
        axpy16_fp4(acc[0], dpp_mov<0x00>(a_) * bfhi(SC[0]), RW[0]); axpy16_fp4(acc[1], dpp_mov<0x55>(a_) * bfhi(SC[1]), RW[1]); \
        axpy16_fp4(acc[2], dpp_mov<0xAA>(a_) * bfhi(SC[2]), RW[2]); axpy16_fp4(acc[3], dpp_mov<0xFF>(a_) * bfhi(SC[3]), RW[3]); }
        P12_FETCH(0, rwA, scA, gtA)
#pragma unroll 1
        for (int bi = 0; bi < 128; bi += 2) {
            P12_FETCH(bi + 1, rwB, scB, gtB)
            P12_COMPUTE(rwA, scA, gtA)
            if (bi + 2 < 128) P12_FETCH(bi + 2, rwA, scA, gtA)
            P12_COMPUTE(rwB, scB, gtB)
        }
#undef P12_FETCH
#undef P12_COMPUTE
#pragma unroll
        for (int u = 0; u < 4; ++u) { const size_t t = (size_t)tg * 4 + u;
            float* op = odst + t * DM + 16 * lane;
            const v4u xa = *(const v4u*)(P.HN + t * DM + 16 * lane), xb = *(const v4u*)(P.HN + t * DM + 16 * lane + 8);
            const float pz = (MODE == 2) ? asl[u] * 1e-30f : 0.f;
            *(f32x4*)(op) = (f32x4){bflo(xa.x) + acc[u][0].x + pz, bfhi(xa.x) + acc[u][0].y, bflo(xa.y) + acc[u][1].x, bfhi(xa.y) + acc[u][1].y};
            *(f32x4*)(op + 4) = (f32x4){bflo(xa.z) + acc[u][2].x, bfhi(xa.z) + acc[u][2].y, bflo(xa.w) + acc[u][3].x, bfhi(xa.w) + acc[u][3].y};
            *(f32x4*)(op + 8) = (f32x4){bflo(xb.x) + acc[u][4].x, bfhi(xb.x) + acc[u][4].y, bflo(xb.y) + acc[u][5].x, bfhi(xb.y) + acc[u][5].y};
            *(f32x4*)(op + 12) = (f32x4){bflo(xb.z) + acc[u][6].x, bfhi(xb.z) + acc[u][6].y, bflo(xb.w) + acc[u][7].x, bfhi(xb.w) + acc[u][7].y}; }
    }
}

struct Args { const float* in[25]; float* out; unsigned char* ws; int ph_lo, ph_hi; };
__global__ void __launch_bounds__(NTHR, 2) layer_fwd(Args args) {
    extern __shared__ __attribute__((aligned(16))) unsigned char lds_raw[];
    LAS unsigned char* lds = (LAS unsigned char*)lds_raw;
    const int tid = threadIdx.x, lane = tid & 63, wave = __builtin_amdgcn_readfirstlane(tid >> 6);
    const int G = gridDim.x; const int bx = blockIdx.x;
    const int vcu = (G % 8 == 0) ? (bx % 8) * (G / 8) + bx / 8 : bx;
    const int gw = vcu * NWAVES + wave, NGW = G * NWAVES;
    unsigned char* ws = args.ws;
    Ptrs P;
    P.x = args.in[0]; P.mem = args.in[1]; P.mix_norm_w = args.in[2]; P.w_in = args.in[3]; P.conv_w = args.in[4]; P.conv_b = args.in[5]; P.cmp_pe = args.in[6];
    P.cmp_w1 = args.in[7]; P.cmp_w2 = args.in[8]; P.q_norm_w = args.in[9]; P.k_norm_w = args.in[10]; P.w_out = args.in[11]; P.xattn_norm_w = args.in[12];
    P.mem_norm_w = args.in[13]; P.xq = args.in[14]; P.xk = args.in[15]; P.xv = args.in[16]; P.xo = args.in[17]; P.xq_norm_w = args.in[18]; P.xk_norm_w = args.in[19];
    P.ffn_norm_w = args.in[20]; P.peer_wq = args.in[21]; P.peer_keys = args.in[22]; P.peer_down = args.in[23]; P.peer_up = args.in[24];
    P.out = args.out;
    P.WIN = (bf16*)(ws + WS_WIN); P.WOUT = (bf16*)(ws + WS_WOUT); P.XQT = (bf16*)(ws + WS_XQT); P.XKVT = (bf16*)(ws + WS_XKVT); P.XOT = (bf16*)(ws + WS_XOT);
    P.PWQT = (bf16*)(ws + WS_PWQT); P.PKEYS = (bf16*)(ws + WS_PKEYS); P.KCMP = (bf16*)(ws + WS_KCMP); P.VCMP = (bf16*)(ws + WS_VCMP); P.MN = (bf16*)(ws + WS_MN);
    P.XKV = (bf16*)(ws + WS_XKV); P.PDOWN = ws + WS_PDOWN; P.PUP = ws + WS_PUP; P.PSC = (float*)(ws + WS_PSC); P.CW1T = (bf16*)(ws + WS_CW1T); P.SSP1 = (float*)(ws + WS_SSP1); P.SSP2 = (float*)(ws + WS_SSP2); P.SA1 = (float*)(ws + WS_SA1); P.SB1 = (float*)(ws + WS_SB1); P.CMX = (float*)(ws + WS_CMX); P.HN8 = ws + WS_HN; P.WIN8 = ws + WS_WIN; P.H8 = ws + WS_PUP; P.PWQ8 = ws + WS_PWQT; P.SH = (float*)(ws + WS_SH); P.SBQ = (float*)(ws + WS_SBQ); P.CMXQ = (float*)(ws + WS_CMXQ); P.HN = (bf16*)(ws + WS_HN); P.YMIX = (bf16*)(ws + WS_YMIX);
    P.PROJ = (bf16*)(ws + WS_PROJ); P.XQ = (bf16*)(ws + WS_XQ); P.PQ = (bf16*)(ws + WS_PQ); P.B1P = (float*)(ws + WS_B1P); P.PGATE = (float*)(ws + WS_PGATE); P.PIDX = (int*)(ws + WS_PIDX);

    volatile LAS unsigned* MISC = (volatile LAS unsigned*)(lds + MISC_OFF);
    if (tid < 64) MISC[tid] = 0u;
    __syncthreads();
    const int lo = args.ph_lo, hi = args.ph_hi;
    const bool multi = (hi - lo) > 1;
    XcdBarrier bar; bar.bar = (unsigned*)(ws + WS_CTL) + CW_BAR; bar.x = 0; bar.st = MISC + 8;
    if (multi) bar = xcd_barrier_post((unsigned*)(ws + WS_CTL) + CW_BAR, MISC + 8);
#ifndef ONLY_PHASE
#define ONLY_PHASE -1
#endif
#define IN(k) ((ONLY_PHASE < 0 || (k) == ONLY_PHASE) && lo <= (k) && (k) < hi)
#define SEAM(k) do { if (IN(k) && IN((k) + 1)) xcd_barrier(bar); } while (0)

#ifndef REPMASK
#define REPMASK 0
#endif
#ifndef P12_PROBE_MODE
#define P12_PROBE_MODE 0
#endif
#ifndef P3_PROBE_MODE
#define P3_PROBE_MODE 0
#endif
#ifndef P0_PROBE_MASK
#define P0_PROBE_MASK 7
#endif
#define NREP(k) (((REPMASK) >> (k)) & 1 ? 2 : 1)
    float* const dummy = (float*)(ws + WS_PROJ);
    if (IN(0)) { for (int rep = 0; rep < NREP(0); ++rep) { const int pm = (rep + 1 < NREP(0)) ? P0_PROBE_MASK : 7; p0_prologue(P, lds, gw, NGW, wave, lane, 0, pm); if (multi && pm == 7) xcd_barrier(bar); p0_prologue(P, lds, gw, NGW, wave, lane, 1, pm); } } SEAM(0);
    if (IN(1)) { for (int rep = 0; rep < NREP(1); ++rep) {
        { pg8::Gemm g{(const bf16*)P.HN8, (const bf16*)P.WIN8, NTOK, INP, DM / 2}; pg8::ProjOrder S; S.init(NTOK, G, vcu);
          pg8::EpiI8Bf16 E{P.PROJ, INP, P.SA1, P.SB1};
          pg8::gemm_phase<pg8::EpiI8Bf16, pg8::ProjOrder, true, true, true>(lds, g, S, E); }
 }
        asm volatile("s_waitcnt vmcnt(0)" ::: "memory"); __syncthreads();
        for (int mt = vcu >> 1; mt < NTOK / 256; mt += G >> 1) { if (vcu & 1) proj_post_knorm(P, mt, wave, lane); else proj_post_conv(P, mt, wave, lane); }
    } SEAM(1);
    if (IN(2)) { for (int rep = 0; rep < NREP(2); ++rep) p2_misc(P, lds, vcu, G, tid, wave, lane, rep == 0); } SEAM(2);
    if (IN(3)) { xk_norm(P, gw, NGW, lane); for (int rep = 0; rep < NREP(3); ++rep) { if (rep + 1 < NREP(3)) p3_nsa<P3_PROBE_MODE>(P, lds, vcu, G, tid, wave, lane); else p3_nsa<0>(P, lds, vcu, G, tid, wave, lane); } } SEAM(3);
    if (IN(4)) { for (int rep = 0; rep < NREP(4); ++rep) { pg8::Gemm g{P.YMIX, P.WOUT, NTOK, DM, DM}; pg8::StaticOrder S; S.init(NTOK, DM, G, bx);
        pg8::EpiResBf16N<false> E{P.x, P.HN, P.SSP1, DM};
        pg8::gemm_phase<pg8::EpiResBf16N<false>, pg8::StaticOrder, true, true>(lds, g, S, E); } } SEAM(4);
    if (IN(6)) { for (int rep = 0; rep < NREP(6); ++rep) { pg8::Gemm g{P.HN, P.XQT, NTOK, DM, DM}; pg8::StaticOrder S; S.init(NTOK, DM, G, bx);
        pg8::EpiBf16<0> E{P.XQ, DM, nullptr, 0, 0, 1.f};
        pg8::gemm_phase<pg8::EpiBf16<0>, pg8::StaticOrder, true, true>(lds, g, S, E); }
        asm volatile("s_waitcnt vmcnt(0)" ::: "memory"); __syncthreads();
        for (int rep = 0; rep < NREP(7); ++rep) p7_xattn(P, lds, bx, G, tid, wave, lane); } SEAM(7);
    if (IN(8)) { for (int rep = 0; rep < NREP(8); ++rep) { pg8::Gemm g{P.YMIX, P.XOT, NTOK, DM, DM}; pg8::StaticOrder S; S.init(NTOK, DM, G, bx);
        pg8::EpiResBf16N<true> E{P.HN, (rep + 1 < NREP(8)) ? (bf16*)dummy : P.HN, P.SSP2, DM};
        pg8::gemm_phase<pg8::EpiResBf16N<true>, pg8::StaticOrder, true, true>(lds, g, S, E); } } SEAM(8);
    if (IN(9)) { for (int rep = 0; rep < NREP(9); ++rep) p9_quant_h(P, gw, NGW, lane); } SEAM(9);
    if (IN(10)) { for (int rep = 0; rep < NREP(10); ++rep) { pg8::Gemm g{(const bf16*)P.H8, (const bf16*)P.PWQ8, NTOK, 2048, DM / 2}; pg8::StaticOrder S; S.init(NTOK, 2048, G, bx);
        pg8::EpiI8Bf16 E{P.PQ, 2048, P.SH, P.SBQ};
        pg8::gemm_phase<pg8::EpiI8Bf16, pg8::StaticOrder, true, true, true>(lds, g, S, E); }
        asm volatile("s_waitcnt vmcnt(0)" ::: "memory"); __syncthreads();
        for (int rep = 0; rep < NREP(11); ++rep) p11_peer_topk(P, lds, bx, G, tid, wave, lane); } SEAM(11);
    if (IN(12)) { for (int rep = 0; rep < NREP(12); ++rep) if (rep + 1 < NREP(12)) p12_peer_gather<P12_PROBE_MODE>(P, lds, P.out, dummy, gw, NGW, wave, lane); else p12_peer_gather<0>(P, lds, P.out, P.out, gw, NGW, wave, lane); }
#undef IN
#undef SEAM
}

#ifndef MK_PER_PHASE
#define MK_PER_PHASE 0
#endif
extern "C" void kernel_launch(void* const* d_in, const int* in_sizes, int n_in, void* d_out, int out_size, void* d_ws, size_t ws_size, hipStream_t stream) {
    static int grid = 0;
    if (grid == 0) {
        if (n_in != 25 || in_sizes[0] != NTOK * DM || out_size != NTOK * DM || ws_size < WS_END) {
            fprintf(stderr, "kernel_launch: unexpected shapes (n_in %d, in0 %d, out %d, ws %zu); nothing launched\n", n_in, n_in > 0 ? in_sizes[0] : -1, out_size, ws_size); grid = -1; return; }
        int dev = 0, cus = 0, per_cu = 0;
        if (hipGetDevice(&dev) != hipSuccess || hipDeviceGetAttribute(&cus, hipDeviceAttributeMultiprocessorCount, dev) != hipSuccess) { grid = -1; return; }
        if (hipFuncSetAttribute((const void*)layer_fwd, hipFuncAttributeMaxDynamicSharedMemorySize, LDS_BYTES) != hipSuccess) { fprintf(stderr, "kernel_launch: hipFuncSetAttribute failed\n"); grid = -1; return; }
        if (hipOccupancyMaxActiveBlocksPerMultiprocessor(&per_cu, (const void*)layer_fwd, NTHR, LDS_BYTES) != hipSuccess || per_cu < 1)
            fprintf(stderr, "kernel_launch: note: occupancy query reports %d workgroups per CU\n", per_cu);
        (void)hipGetLastError();
        grid = cus;
        if (grid != 256) fprintf(stderr, "kernel_launch: note: %d CUs\n", grid);
    }
    if (grid < 0) return;
    if (hipMemsetAsync((char*)d_ws + WS_CTL, 0, CTL_ZERO_BYTES, stream) != hipSuccess) return;
    Args a{};
    for (int i = 0; i < 25; ++i) a.in[i] = (const float*)d_in[i];
    a.out = (float*)d_out; a.ws = (unsigned char*)d_ws;
#if MK_PER_PHASE
    for (int p = 0; p < NPHASE; ++p) { a.ph_lo = p; a.ph_hi = p + 1; hipLaunchKernelGGL(layer_fwd, dim3(grid), dim3(NTHR), LDS_BYTES, stream, a); }
#else
    a.ph_lo = 0; a.ph_hi = NPHASE; hipLaunchKernelGGL(layer_fwd, dim3(grid), dim3(NTHR), LDS_BYTES, stream, a);
#endif
}
```

```cpp
#include <hip/hip_runtime.h>
#include <cstdio>
#include <cstdint>
#include <cmath>
namespace pg8 {
#define PG8_LAS __attribute__((address_space(3)))
typedef unsigned short bf16_t;
typedef short bf16x8 __attribute__((ext_vector_type(8)));
typedef float f32x4 __attribute__((ext_vector_type(4)));
typedef unsigned u32x4 __attribute__((ext_vector_type(4)));
constexpr int BM = 256, BK = 64, HALF = 128, HTB = HALF * BK * 2  , STAGE_BYTES = 8 * HTB, NXCD = 8, WGM = 8;

__host__ __device__ __forceinline__ int lds_byte(int r, int c) { const int st = (r >> 4) * 2 + (c >> 5), rr = r & 15, cc = c & 31, ob = rr * 64 + cc * 2; return st * 1024 + (ob ^ (((ob >> 9) & 1) << 5)); }
__host__ __device__ __forceinline__ void stage_rc(int b, int& R, int& C) { const int st = b / 1024, sb = b % 1024, swz = sb ^ (((sb >> 9) & 1) << 5); R = (st >> 1) * 16 + swz / 64; C = (st & 1) * 32 + (swz % 64) / 2; }
__host__ __device__ __forceinline__ int perm32(int rho) { const int n = rho >> 4, i = rho & 15; return 8 * (i >> 2) + 4 * n + (i & 3); }

struct Unit { int pm, pn; };
struct Gemm { const bf16_t* A; const bf16_t* Bt; int M, N, K; };

struct StaticOrder {
    int nM, nN, nwg, G, c;
    __host__ __device__ void init(int M, int N, int G_, int c_) { nM = M / BM; nN = N / BM; nwg = nM * nN; G = G_; c = c_; }
    __host__ __device__ bool next(int i, Unit& u) const {
        const long L = (long)i * G + c; if (L >= nwg) return false;
        int wgid = (int)L; { const int q = nwg / NXCD, r = nwg % NXCD, xcd = wgid % NXCD, off = wgid / NXCD; wgid = (xcd < r ? xcd * (q + 1) : r * (q + 1) + (xcd - r) * q) + off; }
        const int nig = WGM * nN, gid = wgid / nig, fm = gid * WGM, gsz = (nM - fm) < WGM ? (nM - fm) : WGM;
        u.pm = fm + ((wgid % nig) % gsz); u.pn = (wgid % nig) / gsz; return true;
    }
    __device__ __forceinline__ void a_ready(const Unit&) const {}
    __device__ __forceinline__ void done(const Unit&) const {}
};

struct ProjOrder {
    int nM, G, v;
    __host__ __device__ void init(int M, int G_, int v_) { nM = M / BM; G = G_; v = v_; }
    __host__ __device__ bool next(int i, Unit& u) const {
        const int round = i / 6, k = i - 6 * round, mt = (v >> 1) + round * (G >> 1);
        if (mt >= nM) return false;
        u.pm = mt; u.pn = k < 3 ? 2 * k + (v & 1) : (v & 1) * 3 + 3 + k; return true;
    }
    __device__ __forceinline__ void a_ready(const Unit&) const {}
    __device__ __forceinline__ void done(const Unit&) const {}
};

__device__ __forceinline__ unsigned cvt_pk_bf16(float lo, float hi) { unsigned r; asm volatile("v_cvt_pk_bf16_f32 %0, %1, %2" : "=v"(r) : "v"(lo), "v"(hi)); return r; }
typedef float f32x2 __attribute__((ext_vector_type(2)));
__device__ __forceinline__ f32x2 gelu_pk(f32x2 v) {
    const f32x2 av = __builtin_elementwise_abs(v), d = av * 0.2316418882f + 1.0f;
    f32x2 t; t.x = __builtin_amdgcn_rcpf(d.x); t.y = __builtin_amdgcn_rcpf(d.y);
    f32x2 q = t * 0.5307027145f + (-0.7265760135f); q = q * t + 0.7107068705f; q = q * t + (-0.142248368f); q = q * t + 0.127414796f; q = q * t;
    const f32x2 s = (v * v) * (-0.72134752044f);
    f32x2 e; e.x = __builtin_amdgcn_exp2f(s.x); e.y = __builtin_amdgcn_exp2f(s.y);
    const f32x2 m = v * (q * e), r = v - m;
    f32x2 o; o.x = v.x < 0.f ? m.x : r.x; o.y = v.y < 0.f ? m.y : r.y; return o;
}

template <int ACT  > struct EpiBf16 {
    static constexpr bool PERM = true, AFTER_DRAIN = false; static_assert(ACT == 0 || ACT == 1, "EpiBf16: ACT is 0 (none) or 1 (gelu_pk)");
    bf16_t* O; int ldc; const float* bias; int split_cols; size_t split_stride; float scale0;
    __device__ __forceinline__ void operator()(const f32x4 (&acc)[2][2][4][2], const Unit& u, int wr, int wc, int fr, int fq) const {
        const int row0 = u.pm * BM + wr * 64 + fr; int colt = u.pn * BM; bf16_t* base = O;
        float sc = 1.f; if (split_cols) { const int t = colt / split_cols; base += (size_t)t * split_stride; colt -= t * split_cols; if (t == 0) sc = scale0; }
        const int col0 = colt + wc * 32 + 8 * fq, bcol0 = u.pn * BM + wc * 32 + 8 * fq;
        f32x4 bv[2][2];
#pragma unroll
        for (int bj = 0; bj < 2; ++bj)
#pragma unroll
            for (int n = 0; n < 2; ++n) bv[bj][n] = bias ? *(const f32x4*)(bias + bcol0 + bj * HALF + 4 * n) : (f32x4){0.f, 0.f, 0.f, 0.f};
#pragma unroll
        for (int ai = 0; ai < 2; ++ai)
#pragma unroll
            for (int m = 0; m < 4; ++m) { bf16_t* rowp = base + (size_t)(row0 + ai * HALF + m * 16) * ldc + col0;
#pragma unroll
                for (int bj = 0; bj < 2; ++bj) { f32x4 v0 = acc[ai][bj][m][0] + bv[bj][0], v1 = acc[ai][bj][m][1] + bv[bj][1];
                    if (ACT == 1) { f32x2 a = gelu_pk((f32x2){v0[0], v0[1]}), b = gelu_pk((f32x2){v0[2], v0[3]}), c = gelu_pk((f32x2){v1[0], v1[1]}), d = gelu_pk((f32x2){v1[2], v1[3]});
                        v0 = (f32x4){a.x, a.y, b.x, b.y}; v1 = (f32x4){c.x, c.y, d.x, d.y}; }
                    v0 = v0 * sc; v1 = v1 * sc; u32x4 w; w.x = cvt_pk_bf16(v0[0], v0[1]); w.y = cvt_pk_bf16(v0[2], v0[3]); w.z = cvt_pk_bf16(v1[0], v1[1]); w.w = cvt_pk_bf16(v1[2], v1[3]);
                    *(u32x4*)(rowp + bj * HALF) = w; } }
    }
};

struct EpiResF32 {
    static constexpr bool PERM = false, AFTER_DRAIN = false;
    const float* base; float* out; int ldc;
    __device__ __forceinline__ void operator()(const f32x4 (&acc)[2][2][4][2], const Unit& u, int wr, int wc, int fr, int fq) const {
        const int row0 = u.pm * BM + wr * 64 + fr, col0 = u.pn * BM + wc * 32 + 4 * fq;
#pragma unroll
        for (int ai = 0; ai < 2; ++ai)
#pragma unroll
            for (int m = 0; m < 4; ++m) { const size_t off = (size_t)(row0 + ai * HALF + m * 16) * ldc + col0;
#pragma unroll
                for (int bj = 0; bj < 2; ++bj)
#pragma unroll
                    for (int n = 0; n < 2; ++n) { const f32x4 b = *(const f32x4*)(base + off + bj * HALF + n * 16); *(f32x4*)(out + off + bj * HALF + n * 16) = b + acc[ai][bj][m][n]; } }
    }
};
template <bool BASE_BF16> struct EpiResBf16N {
    static constexpr bool PERM = false, AFTER_DRAIN = false;
    const void* base; bf16_t* xn; float* ssp; int ldc;
    __device__ __forceinline__ void operator()(const f32x4 (&acc)[2][2][4][2], const Unit& u, int wr, int wc, int fr, int fq) const {
        typedef unsigned u32x2 __attribute__((ext_vector_type(2)));
        const int row0 = u.pm * BM + wr * 64 + fr, col0 = u.pn * BM + wc * 32 + 4 * fq;
#pragma unroll
        for (int ai = 0; ai < 2; ++ai)
#pragma unroll
            for (int m = 0; m < 4; ++m) { const int row = row0 + ai * HALF + m * 16; const size_t off = (size_t)row * ldc + col0; float ss = 0.f;
#pragma unroll
                for (int bj = 0; bj < 2; ++bj)
#pragma unroll
                    for (int n = 0; n < 2; ++n) { f32x4 b;
                        if (BASE_BF16) { const u32x2 r = *(const u32x2*)((const bf16_t*)base + off + bj * HALF + n * 16);
                            b = (f32x4){__uint_as_float(r.x << 16), __uint_as_float(r.x & 0xffff0000u), __uint_as_float(r.y << 16), __uint_as_float(r.y & 0xffff0000u)}; }
                        else b = *(const f32x4*)((const float*)base + off + bj * HALF + n * 16);
                        const f32x4 v = b + acc[ai][bj][m][n];
                        ss += (v[0] * v[0] + v[1] * v[1]) + (v[2] * v[2] + v[3] * v[3]);
                        u32x2 w; w.x = cvt_pk_bf16(v[0], v[1]); w.y = cvt_pk_bf16(v[2], v[3]); *(u32x2*)(xn + off + bj * HALF + n * 16) = w; }
                ss += __shfl_xor(ss, 16); ss += __shfl_xor(ss, 32);
                if (fq == 0) ssp[(size_t)row * 16 + u.pn * 4 + wc] = ss; }
    }
};
struct EpiI8Bf16 {
    static constexpr bool PERM = true, AFTER_DRAIN = false;
    bf16_t* O; int ldc; const float* sa; const float* sb;
    __device__ __forceinline__ void operator()(const f32x4 (&acc)[2][2][4][2], const Unit& u, int wr, int wc, int fr, int fq) const {
        typedef int i32x4 __attribute__((ext_vector_type(4)));
        const int row0 = u.pm * BM + wr * 64 + fr, col0 = u.pn * BM + wc * 32 + 8 * fq;
        f32x4 sbv[2][2];
#pragma unroll
        for (int bj = 0; bj < 2; ++bj)
#pragma unroll
            for (int n = 0; n < 2; ++n) sbv[bj][n] = *(const f32x4*)(sb + col0 + bj * HALF + 4 * n);
#pragma unroll
        for (int ai = 0; ai < 2; ++ai)
#pragma unroll
            for (int m = 0; m < 4; ++m) { const int row = row0 + ai * HALF + m * 16; const float sr = sa[row]; bf16_t* rowp = O + (size_t)row * ldc + col0;
#pragma unroll
                for (int bj = 0; bj < 2; ++bj) {
                    const f32x4 v0 = __builtin_convertvector(__builtin_bit_cast(i32x4, acc[ai][bj][m][0]), f32x4) * sr * sbv[bj][0];
                    const f32x4 v1 = __builtin_convertvector(__builtin_bit_cast(i32x4, acc[ai][bj][m][1]), f32x4) * sr * sbv[bj][1];
                    u32x4 w; w.x = cvt_pk_bf16(v0[0], v0[1]); w.y = cvt_pk_bf16(v0[2], v0[3]); w.z = cvt_pk_bf16(v1[0], v1[1]); w.w = cvt_pk_bf16(v1[2], v1[3]);
                    *(u32x4*)(rowp + bj * HALF) = w; } }
    }
};

template <class Epi, class Sched, bool ALIGN_EPI = false, bool SP2 = false, bool I8 = false>
__device__ __forceinline__ void gemm_phase(PG8_LAS unsigned char* lds, const Gemm g, const Sched& S, const Epi& E) {
    const int tid = threadIdx.x, wid = __builtin_amdgcn_readfirstlane(tid >> 6), lane = tid & 63, wr = wid >> 2, wc = wid & 3, fr = lane & 15, fq = lane >> 4;
    const int K = g.K, nt = K / BK;
    unsigned voffA[2], voffB[2];
#pragma unroll
    for (int i = 0; i < 2; ++i) { int R, C; stage_rc(tid * 16 + i * 8192, R, C); const int Rb = Epi::PERM ? ((R & ~31) + perm32(R & 31)) : R;
        voffA[i] = (unsigned)(R * K + C) * 2u; voffB[i] = (unsigned)(Rb * K + C) * 2u; }
    const size_t kstep = (size_t)(BK * 2);
    const size_t hstep = (size_t)HALF * K * 2;
    const size_t tstep = 2 * hstep;
    const unsigned ldsw = (unsigned)wid * 1024u;
    const int aoff = lds_byte(wr * 64 + fr, fq * 8), boff = lds_byte(wc * 32 + fr, fq * 8);
    typedef int i32x4 __attribute__((ext_vector_type(4)));
    auto mma16 = [](const bf16x8& b, const bf16x8& a, const f32x4& c) __attribute__((always_inline)) -> f32x4 {
        if constexpr (I8) return __builtin_bit_cast(f32x4, __builtin_amdgcn_mfma_i32_16x16x64_i8(__builtin_bit_cast(i32x4, b), __builtin_bit_cast(i32x4, a), __builtin_bit_cast(i32x4, c), 0, 0, 0));
        else return __builtin_amdgcn_mfma_f32_16x16x32_bf16(b, a, c, 0, 0, 0);
    };
#define PG8_SA(b, h) (((b) * 2 + (h)) * HTB)
#define PG8_SB(b, h) ((4 + (b) * 2 + (h)) * HTB)
#define PG8_STAGE(bufoff, gbase, voff) do { _Pragma("unroll") for (int _i = 0; _i < 2; ++_i) \
        __builtin_amdgcn_global_load_lds((const unsigned*)((const char*)(gbase) + (voff)[_i]), (PG8_LAS unsigned*)(lds + (bufoff) + ldsw + _i * 8192), 16, 0, 0); } while (0)
#define PG8_LDA(dst, b, h) do { _Pragma("unroll") for (int m = 0; m < 4; ++m) _Pragma("unroll") for (int k = 0; k < 2; ++k) dst[m][k] = *(const PG8_LAS bf16x8*)(lds + PG8_SA(b, h) + aoff + m * 2048 + k * 1024); } while (0)
#define PG8_LDB(dst, b, h) do { _Pragma("unroll") for (int n = 0; n < 2; ++n) _Pragma("unroll") for (int k = 0; k < 2; ++k) dst[n][k] = *(const PG8_LAS bf16x8*)(lds + PG8_SB(b, h) + boff + n * 2048 + k * 1024); } while (0)
#define PG8_MMA(ai, bj, At, Bt) do { __builtin_amdgcn_s_setprio(1); _Pragma("unroll") for (int m = 0; m < 4; ++m) _Pragma("unroll") for (int n = 0; n < 2; ++n) _Pragma("unroll") for (int k = 0; k < 2; ++k) \
        acc[ai][bj][m][n] = mma16(Bt[n][k], At[m][k], acc[ai][bj][m][n]); __builtin_amdgcn_s_setprio(0); } while (0)
#define PG8_WAIT_V(n) asm volatile("s_waitcnt vmcnt(" #n ")" ::: "memory")
#define PG8_WAIT_L(n) asm volatile("s_waitcnt lgkmcnt(" #n ")" ::: "memory")
#define PG8_BAR __builtin_amdgcn_s_barrier()
#define PG8_SCHED __builtin_amdgcn_sched_barrier(0)
    Unit cur, nxt; int ui = 0;
    if (!S.next(0, cur)) return;
    f32x4 acc[2][2][4][2];
#pragma unroll
    for (int a = 0; a < 2; ++a)
#pragma unroll
        for (int b = 0; b < 2; ++b)
#pragma unroll
            for (int m = 0; m < 4; ++m)
#pragma unroll
                for (int n = 0; n < 2; ++n) acc[a][b][m][n] = (f32x4){0.f, 0.f, 0.f, 0.f};
    bf16x8 At[4][2], B0[2][2], B1[2][2];
    const char* cA = (const char*)g.A + (size_t)cur.pm * tstep; const char* cB = (const char*)g.Bt + (size_t)cur.pn * tstep;
    S.a_ready(cur);
    if constexpr (SP2) {
        PG8_STAGE(PG8_SB(0, 0), cB, voffB); PG8_STAGE(PG8_SB(0, 1), cB + hstep, voffB); PG8_STAGE(PG8_SA(0, 0), cA, voffA); PG8_STAGE(PG8_SA(0, 1), cA + hstep, voffA);
        if (wr == 1) PG8_BAR;
        PG8_WAIT_V(2); PG8_BAR;
        PG8_STAGE(PG8_SB(1, 0), cB + kstep, voffB); PG8_STAGE(PG8_SA(1, 0), cA + kstep, voffA); PG8_STAGE(PG8_SB(1, 1), cB + hstep + kstep, voffB);
        PG8_WAIT_V(6); PG8_BAR;
    } else {
        PG8_STAGE(PG8_SB(0, 0), cB, voffB); PG8_STAGE(PG8_SA(0, 0), cA, voffA); PG8_STAGE(PG8_SB(0, 1), cB + hstep, voffB); PG8_STAGE(PG8_SA(0, 1), cA + hstep, voffA);
        if (wr == 1) PG8_BAR;
        PG8_WAIT_V(4); PG8_BAR;
        PG8_STAGE(PG8_SB(1, 0), cB + kstep, voffB); PG8_STAGE(PG8_SA(1, 0), cA + kstep, voffA); PG8_STAGE(PG8_SB(1, 1), cB + hstep + kstep, voffB);
        PG8_WAIT_V(6); PG8_BAR;
    }
    for (;;) {
        const bool has_next = S.next(ui + 1, nxt);
        const char* nA = has_next ? (const char*)g.A + (size_t)nxt.pm * tstep : cA; const char* nB = has_next ? (const char*)g.Bt + (size_t)nxt.pn * tstep : cB;
        for (int t = 0; t < nt; t += 2) {
            const bool last = (t == nt - 2);
            const char* a1 = cA + (size_t)(t + 1) * kstep;
            const char* a2 = last ? nA : cA + (size_t)(t + 2) * kstep; const char* b2 = last ? nB : cB + (size_t)(t + 2) * kstep;
            const char* a3 = a2 + kstep; const char* b3 = b2 + kstep;
            if (last && has_next) S.a_ready(nxt);
            if constexpr (SP2) {
            PG8_LDB(B0, 0, 0); PG8_LDB(B1, 0, 1); PG8_SCHED; PG8_LDA(At, 0, 0); PG8_STAGE(PG8_SA(1, 1), a1 + hstep, voffA);
            PG8_WAIT_V(8); PG8_WAIT_L(0); PG8_BAR; PG8_MMA(0, 0, At, B0); PG8_MMA(0, 1, At, B1); PG8_BAR; PG8_SCHED;
            PG8_LDA(At, 0, 1); PG8_STAGE(PG8_SB(0, 0), b2, voffB); PG8_STAGE(PG8_SB(0, 1), b2 + hstep, voffB); PG8_STAGE(PG8_SA(0, 0), a2, voffA);
            PG8_WAIT_V(8); PG8_WAIT_L(0); PG8_BAR; PG8_MMA(1, 0, At, B0); PG8_MMA(1, 1, At, B1); PG8_BAR; PG8_SCHED;
            PG8_LDB(B0, 1, 0); PG8_LDB(B1, 1, 1); PG8_SCHED; PG8_LDA(At, 1, 0); PG8_STAGE(PG8_SA(0, 1), a2 + hstep, voffA);
            PG8_WAIT_V(8); PG8_WAIT_L(0); PG8_BAR; PG8_MMA(0, 0, At, B0); PG8_MMA(0, 1, At, B1); PG8_BAR; PG8_SCHED;
            PG8_LDA(At, 1, 1); PG8_STAGE(PG8_SB(1, 0), b3, voffB); PG8_STAGE(PG8_SB(1, 1), b3 + hstep, voffB); PG8_STAGE(PG8_SA(1, 0), a3, voffA);
            PG8_WAIT_V(8); PG8_WAIT_L(0); PG8_BAR; PG8_MMA(1, 0, At, B0); PG8_MMA(1, 1, At, B1); PG8_BAR; PG8_SCHED;
            } else {
            PG8_LDB(B0, 0, 0); PG8_SCHED; PG8_LDA(At, 0, 0); PG8_STAGE(PG8_SA(1, 1), a1 + hstep, voffA);
            PG8_WAIT_L(8); PG8_BAR; PG8_WAIT_L(0); PG8_MMA(0, 0, At, B0); PG8_BAR; PG8_SCHED;
            PG8_LDB(B1, 0, 1); PG8_STAGE(PG8_SB(0, 0), b2, voffB);
            PG8_BAR; PG8_WAIT_L(0); PG8_MMA(0, 1, At, B1); PG8_BAR;
            PG8_LDA(At, 0, 1); PG8_STAGE(PG8_SA(0, 0), a2, voffA);
            PG8_BAR; PG8_WAIT_L(0); PG8_MMA(1, 0, At, B0); PG8_BAR; PG8_SCHED;
            PG8_STAGE(PG8_SB(0, 1), b2 + hstep, voffB);
            PG8_WAIT_V(6); PG8_BAR; PG8_MMA(1, 1, At, B1); PG8_BAR;
            PG8_LDB(B0, 1, 0); PG8_SCHED; PG8_LDA(At, 1, 0); PG8_STAGE(PG8_SA(0, 1), a2 + hstep, voffA);
            PG8_WAIT_L(8); PG8_BAR; PG8_WAIT_L(0); PG8_MMA(0, 0, At, B0); PG8_BAR; PG8_SCHED;
            PG8_LDB(B1, 1, 1); PG8_STAGE(PG8_SB(1, 0), b3, voffB);
            PG8_BAR; PG8_WAIT_L(0); PG8_MMA(0, 1, At, B1); PG8_BAR;
            PG8_LDA(At, 1, 1); PG8_STAGE(PG8_SA(1, 0), a3, voffA);
            PG8_BAR; PG8_WAIT_L(0); PG8_MMA(1, 0, At, B0); PG8_BAR; PG8_SCHED;
            PG8_STAGE(PG8_SB(1, 1), b3 + hstep, voffB);
            PG8_WAIT_V(6); PG8_BAR; PG8_MMA(1, 1, At, B1); PG8_BAR;
            }
        }
        if constexpr (ALIGN_EPI) { if (wr == 0) PG8_BAR; }
        if constexpr (!Epi::AFTER_DRAIN) { E(acc, cur, wr, wc, fr, fq); S.done(cur); }
        if (!has_next) break;
#pragma unroll
        for (int a = 0; a < 2; ++a)
#pragma unroll
            for (int b = 0; b < 2; ++b)
#pragma unroll
                for (int m = 0; m < 4; ++m)
#pragma unroll
                    for (int n = 0; n < 2; ++n) acc[a][b][m][n] = (f32x4){0.f, 0.f, 0.f, 0.f};
        cur = nxt; cA = nA; cB = nB; ++ui;
        if constexpr (ALIGN_EPI) { if (wr == 1) PG8_BAR; }
    }
    PG8_WAIT_V(0);
    if constexpr (!ALIGN_EPI) { if (wr == 0) PG8_BAR; }
    PG8_BAR;
    if constexpr (Epi::AFTER_DRAIN) { E.fused(acc, cur, wr, wc, fr, fq, lds, wid, lane); S.done(cur); }
#undef PG8_SA
#undef PG8_SB
#undef PG8_STAGE
#undef PG8_LDA
#undef PG8_LDB
#undef PG8_MMA
#undef PG8_WAIT_V
#undef PG8_WAIT_L
#undef PG8_BAR
#undef PG8_SCHED
}
}

constexpr int NB = 16, SEQ = 2048, DM = 1024, NTOK = NB * SEQ;
constexpr int INC = 2840, INP = 3072;
constexpr int C_B = 0, C_C = 512, C_H = 1024, C_Q = 1536, C_KC = 2048, C_VC = 2176, C_KS = 2304, C_VS = 2432, C_KW = 2560, C_VW = 2688, C_G = 2816;
constexpr int MEMT = 256, NMEM = NB * MEMT;
constexpr int NEXP = 16384;
constexpr int PEER_ROW_BYTES = 1280;
constexpr float EPS = 1e-6f;
constexpr float LOG2E = 1.4426950408889634f;
constexpr int NWAVES = 8, NTHR = 512;
constexpr int NPHASE = 13;

constexpr size_t MiB = 1u << 20;
constexpr size_t WS_CTL = 0, CTL_ZERO_BYTES = 1 * MiB;
constexpr size_t WS_WIN = 2 * MiB, WS_WOUT = 8 * MiB, WS_XQT = 10 * MiB, WS_XKVT = 12 * MiB, WS_XOT = 16 * MiB, WS_PWQT = 18 * MiB;
constexpr size_t WS_PKEYS = 22 * MiB, WS_B1P = 23 * MiB, WS_KCMP = 24 * MiB, WS_VCMP = 24 * MiB + 512 * 1024;
constexpr size_t WS_MN = 26 * MiB, WS_XKV = 34 * MiB;
constexpr size_t WS_CW1T = 22 * MiB + 512 * 1024;
constexpr size_t WS_SA1 = 23 * MiB + 256 * 1024, WS_SB1 = 23 * MiB + 384 * 1024, WS_CMX = 23 * MiB + 448 * 1024;
constexpr size_t WS_PSC = 23 * MiB + 256 * 1024;
constexpr size_t WS_SH = 54 * MiB, WS_SBQ = 54 * MiB + 128 * 1024, WS_CMXQ = 54 * MiB + 256 * 1024;
constexpr size_t WS_SSP1 = 50 * MiB, WS_SSP2 = 52 * MiB;
constexpr size_t WS_PDOWN = 64 * MiB, WS_PUP = 96 * MiB, WS_HN = 128 * MiB, WS_YMIX = 192 * MiB;
constexpr size_t WS_PROJ = 256 * MiB, WS_XQ = 256 * MiB, WS_PQ = 320 * MiB, WS_PIDX = 448 * MiB, WS_PGATE = 464 * MiB, WS_END = 480 * MiB;
constexpr int CW_BAR = 4096;

constexpr int RING_BYTES = 131072;
constexpr int MISC_OFF = 163584;
constexpr int LDS_BYTES = 163840;

#define GAS __attribute__((address_space(1)))
#define LAS __attribute__((address_space(3)))
#define DI __device__ __forceinline__
typedef unsigned short bf16;
typedef unsigned v4u __attribute__((ext_vector_type(4)));
typedef unsigned v2u __attribute__((ext_vector_type(2)));
typedef float f32x4 __attribute__((ext_vector_type(4)));
typedef float f32x16 __attribute__((ext_vector_type(16)));
typedef short bf16x8 __attribute__((ext_vector_type(8)));
typedef short s16x4 __attribute__((ext_vector_type(4)));
typedef float f32x2_t __attribute__((ext_vector_type(2)));
typedef __bf16 bf16x2_t __attribute__((ext_vector_type(2)));
#define RLX_AGENT __ATOMIC_RELAXED, __HIP_MEMORY_SCOPE_AGENT
#define LDS_WAIT() asm volatile("s_waitcnt lgkmcnt(0)" ::: "memory")
#define MFMA32(a, b, c) __builtin_amdgcn_mfma_f32_32x32x16_bf16((a), (b), (c), 0, 0, 0)

DI unsigned pk2(float lo, float hi) { f32x2_t v = {lo, hi}; bf16x2_t b = __builtin_convertvector(v, bf16x2_t); return __builtin_bit_cast(unsigned, b); }
DI bf16 f2bf(float f) { return (bf16)(pk2(f, 0.f) & 0xffffu); }
DI float bf2f(bf16 b) { return __uint_as_float((unsigned)b << 16); }
DI float bflo(unsigned u) { return __uint_as_float(u << 16); }
DI float bfhi(unsigned u) { return __uint_as_float(u & 0xffff0000u); }
DI float rlane(float v, int l);
DI float wave_sum(float v) {
    v += __uint_as_float((unsigned)__builtin_amdgcn_update_dpp(0, (int)__float_as_uint(v), 0xB1, 0xF, 0xF, true));
    v += __uint_as_float((unsigned)__builtin_amdgcn_update_dpp(0, (int)__float_as_uint(v), 0x4E, 0xF, 0xF, true));
    v += __uint_as_float((unsigned)__builtin_amdgcn_update_dpp(0, (int)__float_as_uint(v), 0x141, 0xF, 0xF, true));
    v += __uint_as_float((unsigned)__builtin_amdgcn_update_dpp(0, (int)__float_as_uint(v), 0x140, 0xF, 0xF, true));
    return (rlane(v, 0) + rlane(v, 16)) + (rlane(v, 32) + rlane(v, 48));
}
DI float rlane(float v, int l)   { return __uint_as_float((unsigned)__builtin_amdgcn_readlane((int)__float_as_uint(v), l)); }
DI int crow(int i, int h) { return (i & 3) + 8 * (i >> 2) + 4 * h; }
DI float gelu_erf(float v) { return 0.5f * v * (1.0f + erff(v * 0.70710678118654752f)); }

#define XB_TMO      128
#define XB_XCNT(j)  (256  + 64 * (j))
#define XB_XSUB(j)  (1280 + 64 * (j))
#define XB_XGEN(j)  (2304 + 64 * (j))
#define XB_TOP      3328
#define XB_TOPGEN   3392
#define XCD_BAR_WORDS 3456
#define XB_SPIN_CAP (1u << 22)

DI unsigned xb_ld(unsigned* p)              { return __hip_atomic_load(p, __ATOMIC_RELAXED, __HIP_MEMORY_SCOPE_AGENT); }
DI unsigned xb_add(unsigned* p, unsigned v) { return __hip_atomic_fetch_add(p, v, __ATOMIC_RELAXED, __HIP_MEMORY_SCOPE_AGENT); }
DI unsigned xb_xcc_id() { return (unsigned)__builtin_amdgcn_s_getreg((3 << 11) | 20) & 0xFu; }
#define XB_SPIN(cond, bar) do { unsigned _sp = 0; while (cond) { __builtin_amdgcn_s_sleep(1); \
    if ((++_sp & 255u) == 0u) { if (xb_ld(&(bar)[XB_TMO])) break; if (_sp > XB_SPIN_CAP) { atomicAdd(&(bar)[XB_TMO], 1u); break; } } } } while (0)

struct XcdBarrier { unsigned* bar; unsigned x; volatile LAS unsigned* st; };

DI XcdBarrier xcd_barrier_post(unsigned* bar, volatile LAS unsigned* st) {
    XcdBarrier b; b.bar = bar; b.x = xb_xcc_id(); b.st = st;
    if (threadIdx.x == 0) (void)xb_add(&bar[XB_XCNT(b.x)], 1u);
    return b;
}
DI void xcd_barrier_complete(unsigned* bar, unsigned x, unsigned& nloc, unsigned& nx) {
    const unsigned G = gridDim.x * gridDim.y * gridDim.z;
    unsigned sum, cnt, mine, sp = 0u;
    for (;;) {
        sum = 0u; cnt = 0u; mine = 0u;
#pragma unroll
        for (unsigned j = 0; j < 16; ++j) { const unsigned c = xb_ld(&bar[XB_XCNT(j)]); sum += c; cnt += (c > 0u) ? 1u : 0u; mine = (j == x) ? c : mine; }
        if (sum == G) break;
        __builtin_amdgcn_s_sleep(1);
        if ((++sp & 255u) == 0u) { if (xb_ld(&bar[XB_TMO])) break; if (sp > XB_SPIN_CAP) { atomicAdd(&bar[XB_TMO], 1u); break; } }
    }
    nloc = mine > 0u ? mine : 1u; nx = cnt > 0u ? cnt : 1u;
}
DI void xcd_barrier(const XcdBarrier& b) {
    asm volatile("s_waitcnt vmcnt(0)" ::: "memory");
    __syncthreads();
    if (threadIdx.x == 0) {
        unsigned* bar = b.bar;
        __builtin_amdgcn_s_waitcnt(0);
        unsigned nloc = b.st[0], nx = b.st[1];
        if (nloc == 0u) { xcd_barrier_complete(bar, b.x, nloc, nx); b.st[0] = nloc; b.st[1] = nx; }
        const unsigned old = xb_add(&bar[XB_XSUB(b.x)], 1u);
        const unsigned gen = old / nloc;
        if (old + 1u == (gen + 1u) * nloc) {
            __builtin_amdgcn_fence(__ATOMIC_RELEASE, "agent");
            asm volatile("s_waitcnt vmcnt(0)" ::: "memory");
            const unsigned og = xb_add(&bar[XB_TOP], 1u);
            const unsigned tg = og / nx;
            if (og + 1u == (tg + 1u) * nx) xb_add(&bar[XB_TOPGEN], 1u);
            else XB_SPIN(xb_ld(&bar[XB_TOPGEN]) == tg, bar);
            __builtin_amdgcn_fence(__ATOMIC_ACQUIRE, "agent");
            xb_add(&bar[XB_XGEN(b.x)], 1u);
            asm volatile("s_waitcnt vmcnt(0)" ::: "memory");
        } else {
            XB_SPIN(xb_ld(&bar[XB_XGEN(b.x)]) == gen, bar);
            __builtin_amdgcn_fence(__ATOMIC_ACQUIRE, "agent");
            asm volatile("s_waitcnt vmcnt(0)" ::: "memory");
        }
    }
    __syncthreads();
}

DI void transpose_item(const float* W, int K, int N, int Npad, bf16* WT, int row_off, LAS float* scr, int item, int lane, const float* ks = nullptr) {
    const int nblk = Npad / 32, kb = item / nblk, nb = item % nblk, k0 = 64 * kb, n0 = 32 * nb;
    {
        const int kr = lane >> 3, nq = n0 + 4 * (lane & 7);
        f32x4 v[8];
#pragma unroll
        for (int i = 0; i < 8; ++i) v[i] = (nq < N) ? *(const f32x4*)(W + (size_t)(k0 + 8 * i + kr) * N + nq) : (f32x4){0.f, 0.f, 0.f, 0.f};
#pragma unroll
        for (int i = 0; i < 8; ++i) { const float sc = ks ? ks[k0 + 8 * i + kr] : 1.0f; LAS float* d = scr + (8 * i + kr) * 33 + 4 * (lane & 7);
            d[0] = v[i].x * sc; d[1] = v[i].y * sc; d[2] = v[i].z * sc; d[3] = v[i].w * sc; }
    }
    LDS_WAIT(); asm volatile("" ::: "memory");
    const int c = lane & 7;
#pragma unroll
    for (int j = 0; j < 4; ++j) { const int n = (lane >> 3) + 8 * j; const LAS float* s = scr + (8 * c) * 33 + n;
        v4u o; o.x = pk2(s[0 * 33], s[1 * 33]); o.y = pk2(s[2 * 33], s[3 * 33]); o.z = pk2(s[4 * 33], s[5 * 33]); o.w = pk2(s[6 * 33], s[7 * 33]);
        *(v4u*)(WT + (size_t)(row_off + n0 + n) * K + k0 + 8 * c) = o; }
    LDS_WAIT(); asm volatile("" ::: "memory");
}
template <int NR>
DI void rms_rows_to_bf16(const float* xrow, const float* w, bf16* orow, int lane) {
    const f32x4* wr = (const f32x4*)w + lane;
    f32x4 v[NR][4]; float s[NR];
#pragma unroll
    for (int q = 0; q < NR; ++q) { const f32x4* xr = (const f32x4*)(xrow + (size_t)q * DM) + lane;
#pragma unroll
        for (int j = 0; j < 4; ++j) v[q][j] = xr[64 * j]; }
#pragma unroll
    for (int q = 0; q < NR; ++q) { s[q] = 0.f;
#pragma unroll
        for (int j = 0; j < 4; ++j) s[q] += (v[q][j].x * v[q][j].x + v[q][j].y * v[q][j].y) + (v[q][j].z * v[q][j].z + v[q][j].w * v[q][j].w); }
#pragma unroll
    for (int q = 0; q < NR; ++q) { const float r = 1.0f / sqrtf(wave_sum(s[q]) * (1.f / DM) + EPS);
        v2u* o8 = (v2u*)(orow + (size_t)q * DM) + lane;
#pragma unroll
        for (int j = 0; j < 4; ++j) { const f32x4 ww = wr[64 * j]; v2u o; o.x = pk2(v[q][j].x * r * ww.x, v[q][j].y * r * ww.y); o.y = pk2(v[q][j].z * r * ww.z, v[q][j].w * r * ww.w); o8[64 * j] = o; } }
}
DI float wave_max_u(float v) {
    v = fmaxf(v, __uint_as_float((unsigned)__builtin_amdgcn_update_dpp(0, (int)__float_as_uint(v), 0xB1, 0xF, 0xF, true)));
    v = fmaxf(v, __uint_as_float((unsigned)__builtin_amdgcn_update_dpp(0, (int)__float_as_uint(v), 0x4E, 0xF, 0xF, true)));
    v = fmaxf(v, __uint_as_float((unsigned)__builtin_amdgcn_update_dpp(0, (int)__float_as_uint(v), 0x141, 0xF, 0xF, true)));
    v = fmaxf(v, __uint_as_float((unsigned)__builtin_amdgcn_update_dpp(0, (int)__float_as_uint(v), 0x140, 0xF, 0xF, true)));
    return fmaxf(fmaxf(rlane(v, 0), rlane(v, 16)), fmaxf(rlane(v, 32), rlane(v, 48)));
}
DI unsigned q8x4(float a, float b, float c, float d, float inv) {
    return ((unsigned)(int)__builtin_rintf(a * inv) & 0xffu) | (((unsigned)(int)__builtin_rintf(b * inv) & 0xffu) << 8) | (((unsigned)(int)__builtin_rintf(c * inv) & 0xffu) << 16) | (((unsigned)(int)__builtin_rintf(d * inv) & 0xffu) << 24);
}
template <int NR>
DI void rms_rows_to_i8(const float* xrow, const float* w, unsigned char* orow, float* srow, int lane) {
    const f32x4* wr = (const f32x4*)w + lane;
    f32x4 v[NR][4]; float s[NR];
#pragma unroll
    for (int q = 0; q < NR; ++q) { const f32x4* xr = (const f32x4*)(xrow + (size_t)q * DM) + lane;
#pragma unroll
        for (int j = 0; j < 4; ++j) v[q][j] = xr[64 * j]; }
#pragma unroll
    for (int q = 0; q < NR; ++q) { s[q] = 0.f;
#pragma unroll
        for (int j = 0; j < 4; ++j) s[q] += (v[q][j].x * v[q][j].x + v[q][j].y * v[q][j].y) + (v[q][j].z * v[q][j].z + v[q][j].w * v[q][j].w); }
#pragma unroll
    for (int q = 0; q < NR; ++q) { const float r = 1.0f / sqrtf(wave_sum(s[q]) * (1.f / DM) + EPS); float mx = 0.f;
#pragma unroll
        for (int j = 0; j < 4; ++j) { v[q][j] = v[q][j] * r * wr[64 * j]; mx = fmaxf(mx, fmaxf(fmaxf(fabsf(v[q][j].x), fabsf(v[q][j].y)), fmaxf(fabsf(v[q][j].z), fabsf(v[q][j].w)))); }
        mx = wave_max_u(mx); const float inv = mx > 0.f ? 127.0f / mx : 0.f;
        unsigned* o4 = (unsigned*)(orow + (size_t)q * DM) + lane;
#pragma unroll
        for (int j = 0; j < 4; ++j) o4[64 * j] = q8x4(v[q][j].x, v[q][j].y, v[q][j].z, v[q][j].w, inv);
        if (lane == 0) srow[q] = mx * (1.0f / 127.0f); }
}
DI void transpose_item_i8(const float* W, int NR, int NP, const float* cmx, unsigned char* WT, float* sb, LAS float* scr, int item, int lane) {
    const int nblk = NP / 32, kb = item / nblk, nb = item % nblk, k0 = 64 * kb, n0 = 32 * nb;
    const int nn = n0 + (lane & 31);
    float cm = 0.f;
#pragma unroll
    for (int kc = 0; kc < 16; ++kc) cm = fmaxf(cm, cmx[kc * NP + nn]);
    const float inv = cm > 0.f ? 127.0f / cm : 0.f;
    if (kb == 0 && lane < 32) sb[nn] = cm * (1.0f / 127.0f);
    {
        const int kr = lane >> 3, nc = lane & 7, nq = n0 + 4 * nc;
        const float i0 = __shfl(inv, 4 * nc), i1 = __shfl(inv, 4 * nc + 1), i2 = __shfl(inv, 4 * nc + 2), i3 = __shfl(inv, 4 * nc + 3);
        f32x4 v[8];
#pragma unroll
        for (int i = 0; i < 8; ++i) v[i] = (nq < NR) ? *(const f32x4*)(W + (size_t)(k0 + 8 * i + kr) * NR + nq) : (f32x4){0.f, 0.f, 0.f, 0.f};
#pragma unroll
        for (int i = 0; i < 8; ++i) { LAS float* d = scr + (8 * i + kr) * 33 + 4 * nc; d[0] = v[i].x * i0; d[1] = v[i].y * i1; d[2] = v[i].z * i2; d[3] = v[i].w * i3; }
    }
    LDS_WAIT(); asm volatile("" ::: "memory");
    const int c = lane & 7;
#pragma unroll
    for (int j = 0; j < 4; ++j) { const int n = (lane >> 3) + 8 * j; const LAS float* s = scr + (8 * c) * 33 + n;
        v2u o; o.x = q8x4(s[0 * 33], s[1 * 33], s[2 * 33], s[3 * 33], 1.0f); o.y = q8x4(s[4 * 33], s[5 * 33], s[6 * 33], s[7 * 33], 1.0f);
        *(v2u*)(WT + (size_t)(n0 + n) * DM + k0 + 8 * c) = o; }
    LDS_WAIT(); asm volatile("" ::: "memory");
}
DI void cvt_stream(const float* src, bf16* dst, size_t n8, int gthread, int nthreads) {
    for (size_t i = gthread; i < n8; i += nthreads) {
        const f32x4 a = ((const f32x4*)src)[2 * i], b = ((const f32x4*)src)[2 * i + 1];
        v4u o; o.x = pk2(a.x, a.y); o.y = pk2(a.z, a.w); o.z = pk2(b.x, b.y); o.w = pk2(b.z, b.w);
        ((v4u*)dst)[i] = o;
    }
}

DI void colmax_item(const float* W, int NR, int NP, float* cmx, int it, int lane) {
    const int kc = it / (NP / 64), n = 64 * (it % (NP / 64)) + 4 * (lane & 15), kr = lane >> 4; f32x4 mx = {0.f, 0.f, 0.f, 0.f};
    if (n < NR) {
#pragma unroll
        for (int i = 0; i < 16; ++i) { const f32x4 v = *(const f32x4*)(W + (size_t)(64 * kc + 4 * i + kr) * NR + n);
            mx.x = fmaxf(mx.x, fabsf(v.x)); mx.y = fmaxf(mx.y, fabsf(v.y)); mx.z = fmaxf(mx.z, fabsf(v.z)); mx.w = fmaxf(mx.w, fabsf(v.w)); } }
    mx.x = fmaxf(mx.x, __shfl_xor(mx.x, 16)); mx.y = fmaxf(mx.y, __shfl_xor(mx.y, 16)); mx.z = fmaxf(mx.z, __shfl_xor(mx.z, 16)); mx.w = fmaxf(mx.w, __shfl_xor(mx.w, 16));
    mx.x = fmaxf(mx.x, __shfl_xor(mx.x, 32)); mx.y = fmaxf(mx.y, __shfl_xor(mx.y, 32)); mx.z = fmaxf(mx.z, __shfl_xor(mx.z, 32)); mx.w = fmaxf(mx.w, __shfl_xor(mx.w, 32));
    if (kr == 0) *(f32x4*)(cmx + kc * NP + n) = mx;
}
struct Ptrs {
    const float *x, *mem, *mix_norm_w, *w_in, *conv_w, *conv_b, *cmp_pe, *cmp_w1, *cmp_w2, *q_norm_w, *k_norm_w, *w_out, *xattn_norm_w, *mem_norm_w,
                *xq, *xk, *xv, *xo, *xq_norm_w, *xk_norm_w, *ffn_norm_w, *peer_wq, *peer_keys, *peer_down, *peer_up;
    float* out;
    bf16 *WIN, *WOUT, *XQT, *XKVT, *XOT, *PWQT, *PKEYS, *KCMP, *VCMP, *MN, *XKV, *HN, *YMIX, *PROJ, *XQ, *PQ;
    unsigned char *PDOWN, *PUP;
    float *B1P, *PGATE, *PSC, *SSP1, *SSP2, *SA1, *SB1, *CMX, *SH, *SBQ, *CMXQ; int* PIDX; bf16* CW1T; unsigned char *HN8, *WIN8, *H8, *PWQ8;
};

DI void p0_prologue(const Ptrs& P, LAS unsigned char* lds, int gw, int NGW, int wave, int lane, int part, int pm = 7) {
    LAS float* scr = (LAS float*)(lds + wave * 16384);
    if (part == 1 && !(pm & 1)) return;
    if (part == 1) {
        for (int it = gw; it < (DM / 64) * (INP / 32) + (DM / 64) * (2048 / 32); it += NGW) {
            if (it < (DM / 64) * (INP / 32)) transpose_item_i8(P.w_in, INC, INP, P.CMX, P.WIN8, P.SB1, scr, it, lane);
            else transpose_item_i8(P.peer_wq, 2048, 2048, P.CMXQ, P.PWQ8, P.SBQ, scr, it - (DM / 64) * (INP / 32), lane); }
        return;
    }
    if (pm & 1) for (int it = gw; it < 16 * (INP / 64) + 16 * (2048 / 64); it += NGW) {
        if (it < 16 * (INP / 64)) colmax_item(P.w_in, INC, INP, P.CMX, it, lane); else colmax_item(P.peer_wq, 2048, 2048, P.CMXQ, it - 16 * (INP / 64), lane); }
    constexpr int I_IN = (DM / 64) * (INP / 32), I_SQ = (DM / 64) * (DM / 32), I_PQ = (DM / 64) * (2048 / 32);
    constexpr int NITEMS = 5 * I_SQ;
    if (pm & 1) for (int it = gw; it < NITEMS; it += NGW) {
        int r = it;
        if (r < I_SQ) { transpose_item(P.w_out, DM, DM, DM, P.WOUT, 0, scr, r, lane); continue; } r -= I_SQ;
        if (r < I_SQ) { transpose_item(P.xq, DM, DM, DM, P.XQT, 0, scr, r, lane, P.xattn_norm_w); continue; } r -= I_SQ;
        if (r < I_SQ) { transpose_item(P.xk, DM, DM, DM, P.XKVT, 0, scr, r, lane); continue; } r -= I_SQ;
        if (r < I_SQ) { transpose_item(P.xv, DM, DM, DM, P.XKVT, DM, scr, r, lane); continue; } r -= I_SQ;
        transpose_item(P.xo, DM, DM, DM, P.XOT, 0, scr, r, lane);
    }
    for (int it = gw; it < 128; it += NGW) {
        const int q = it >> 5, r = it & 31;
        transpose_item(P.cmp_w1 + (size_t)q * 1024 * 64, 1024, 64, 64, P.CW1T + (size_t)(q >> 1) * 128 * 1024, (q & 1) * 64, scr, r, lane);
    }
    for (int it = gw; it < 64; it += NGW) {
        const int kv = it >> 5, l = it & 31;
        const float pv = P.cmp_pe[(kv * 32 + l) * 64 + lane];
        const float* w1 = P.cmp_w1 + ((size_t)kv * 2048 + l * 64) * 64 + lane;
        float acc = 0.f;
#pragma unroll 16
        for (int d = 0; d < 64; ++d) acc += rlane(pv, d) * w1[d * 64];
        P.B1P[it * 64 + lane] = acc;
    }
    if (pm & 2) for (int m = 4 * gw; m < NTOK; m += 4 * NGW) rms_rows_to_i8<4>(P.x + (size_t)m * DM, P.mix_norm_w, P.HN8 + (size_t)m * DM, P.SA1 + m, lane);
    if (pm & 2) for (int m = 2 * gw; m < NMEM; m += 2 * NGW) rms_rows_to_bf16<2>(P.mem + (size_t)m * DM, P.mem_norm_w, P.MN + (size_t)m * DM, lane);
    const int gthread = gw * 64 + lane, nthreads = NGW * 64;
    if (pm & 4) for (int row0 = 2 * gw; row0 < 2 * NEXP; row0 += 2 * NGW) {
        f32x4 v2[2][4];
#pragma unroll
        for (int q = 0; q < 2; ++q) { const int row = row0 + q, tb = row >> 14, e = row & (NEXP - 1);
            const f32x4* src = (const f32x4*)((tb ? P.peer_up : P.peer_down) + (size_t)e * DM) + 4 * lane;
#pragma unroll
            for (int j = 0; j < 4; ++j) v2[q][j] = src[j]; }
#pragma unroll
        for (int q = 0; q < 2; ++q) { const int row = row0 + q, tb = row >> 14, e = row & (NEXP - 1);
        f32x4 v[4]; float mx = 0.f;
#pragma unroll
        for (int j = 0; j < 4; ++j) { v[j] = v2[q][j]; mx = fmaxf(mx, fmaxf(fmaxf(fabsf(v[j].x), fabsf(v[j].y)), fmaxf(fabsf(v[j].z), fabsf(v[j].w)))); }
        const bf16 sc16 = f2bf(mx * (tb ? (1.0f / 6.0f) : (1.0f / 7.0f))); const float sc = bf2f(sc16), inv = sc > 0.f ? 1.0f / sc : 0.f;
        unsigned w[2];
#pragma unroll
        for (int d = 0; d < 2; ++d) { unsigned acc = 0u;
            if (tb) {
#define FP4_PAIR(B) { const int c = 8 * d + 2 * (B); const float x0 = fminf(fmaxf(v[c >> 2][c & 3] * inv, -6.0f), 6.0f), x1 = fminf(fmaxf(v[(c + 1) >> 2][(c + 1) & 3] * inv, -6.0f), 6.0f); \
                    acc = __builtin_amdgcn_cvt_scalef32_pk_fp4_f32(acc, x0, x1, 1.0f, (B)); }
                FP4_PAIR(0) FP4_PAIR(1) FP4_PAIR(2) FP4_PAIR(3)
#undef FP4_PAIR
            } else {
#pragma unroll
                for (int i = 0; i < 8; ++i) { const float x = v[2 * d + (i >> 2)][i & 3]; int q2 = (int)__builtin_rintf(x * inv); q2 = q2 < -7 ? -7 : (q2 > 7 ? 7 : q2); acc |= ((unsigned)q2 & 0xFu) << (4 * i); }
            }
            w[d] = acc; }
        unsigned char* rp = P.PDOWN + (size_t)e * PEER_ROW_BYTES;
        *(v2u*)(rp + 16 * lane + 8 * tb) = (v2u){w[0], w[1]};
        *(bf16*)(rp + 1024 + 4 * lane + 2 * tb) = sc16;
        }
    }
    cvt_stream(P.peer_keys, P.PKEYS, (size_t)8 * 2 * 128 * 128 / 8, gthread, nthreads);
}

template <int CTRL> DI float dppf(float v) { return __uint_as_float((unsigned)__builtin_amdgcn_update_dpp(0, (int)__float_as_uint(v), CTRL, 0xF, 0xF, true)); }
DI float sum8(float v) { v += dppf<0xB1>(v); v += dppf<0x4E>(v); v += dppf<0x141>(v); return v; }
DI float sum32(float v) { v = sum8(v); v += dppf<0x140>(v); v += __shfl_xor(v, 16); return v; }
constexpr int CM_SA_OFF = 0, CM_SB_OFF = 36864, CM_P_OFF = 0, CM_H_OFF = 73728, CM_W2_OFF = CM_H_OFF + 128 * 68 * 4, CM_B_OFF = CM_W2_OFF + 64 * 64 * 4;
DI void compress_unit(const Ptrs& P, LAS unsigned char* lds, int kv, int b, int g, int tid, int wave, int lane) {
    LAS float* Pl = (LAS float*)(lds + CM_P_OFF); LAS float* Hl = (LAS float*)(lds + CM_H_OFF); LAS float* W2l = (LAS float*)(lds + CM_W2_OFF); LAS float* Bl = (LAS float*)(lds + CM_B_OFF);
    const int r = lane & 31, h = lane >> 5, wm = wave >> 1, wn = wave & 1;
    __syncthreads();
    for (int e = tid; e < 64 * 64; e += NTHR) W2l[e] = P.cmp_w2[(size_t)kv * 4096 + e];
    if (tid < 64) { float s = 0.f;
#pragma unroll 8
        for (int l = 0; l < 32; ++l) s += P.B1P[(kv * 32 + l) * 64 + tid];
        Bl[tid] = s; }
    {
        const bf16* abase = P.PROJ + (size_t)b * SEQ * INP + (kv ? C_VC : C_KC) + g * 64;
        const bf16* bbase = P.CW1T + (size_t)kv * 128 * 1024;
        const int srow = tid >> 3, sch = tid & 7;
        v4u ra[2], rb[2];
#define CM_GLOAD(L) { _Pragma("unroll") for (int k2 = 0; k2 < 2; ++k2) { const int row = srow + 64 * k2; \
            ra[k2] = *(const v4u*)(abase + (size_t)(16 * row + (L)) * INP + sch * 8); rb[k2] = *(const v4u*)(bbase + (size_t)row * 1024 + (L) * 64 + sch * 8); } }
#define CM_LSTORE(BUF) { _Pragma("unroll") for (int k2 = 0; k2 < 2; ++k2) { const int row = srow + 64 * k2; \
            *(LAS v4u*)(lds + CM_SA_OFF + (BUF) * 18432 + row * 144 + sch * 16) = ra[k2]; *(LAS v4u*)(lds + CM_SB_OFF + (BUF) * 18432 + row * 144 + sch * 16) = rb[k2]; } }
        CM_GLOAD(0) CM_LSTORE(0) CM_GLOAD(1)
        f32x16 acc[2];
#pragma unroll
        for (int i = 0; i < 16; ++i) { acc[0][i] = 0.f; acc[1][i] = 0.f; }
#pragma unroll 1
        for (int l = 0; l < 16; ++l) {
            __syncthreads();
            if (l + 1 < 16) { CM_LSTORE((l + 1) & 1) if (l + 2 < 16) CM_GLOAD(l + 2) }
            LAS const unsigned char* ap = lds + CM_SA_OFF + (l & 1) * 18432 + (32 * wm + r) * 144 + h * 16;
            LAS const unsigned char* bp = lds + CM_SB_OFF + (l & 1) * 18432 + (64 * wn + r) * 144 + h * 16;
#pragma unroll
            for (int kk = 0; kk < 4; ++kk) { const bf16x8 a = *(LAS const bf16x8*)(ap + kk * 32), b0 = *(LAS const bf16x8*)(bp + kk * 32), b1 = *(LAS const bf16x8*)(bp + 32 * 144 + kk * 32);
                acc[0] = MFMA32(a, b0, acc[0]); acc[1] = MFMA32(a, b1, acc[1]); }
        }
#undef CM_GLOAD
#undef CM_LSTORE
        __syncthreads();
#pragma unroll
        for (int t = 0; t < 2; ++t)
#pragma unroll
            for (int i = 0; i < 16; ++i) Pl[(32 * wm + crow(i, h)) * 132 + 64 * wn + 32 * t + r] = acc[t][i];
    }
    __syncthreads();
    for (int e = tid; e < 128 * 64; e += NTHR) { const int n = e >> 6, j = e & 63;
        Hl[n * 68 + j] = (n < 127) ? gelu_erf(Pl[n * 132 + j] + Pl[(n + 1) * 132 + 64 + j] + Bl[j]) : 0.f; }
    __syncthreads();
    {
        const int n = tid >> 2, jq = tid & 3;
        float o[16];
#pragma unroll
        for (int j = 0; j < 16; ++j) o[j] = 0.f;
#pragma unroll 4
        for (int m = 0; m < 64; ++m) { const float hv = Hl[n * 68 + m];
#pragma unroll
            for (int j4 = 0; j4 < 4; ++j4) { const f32x4 w = *(LAS const f32x4*)(W2l + m * 64 + jq * 16 + 4 * j4); o[4 * j4] += hv * w.x; o[4 * j4 + 1] += hv * w.y; o[4 * j4 + 2] += hv * w.z; o[4 * j4 + 3] += hv * w.w; } }
        if (kv == 0) { float ss = 0.f;
#pragma unroll
            for (int j = 0; j < 16; ++j) ss += o[j] * o[j];
            ss += dppf<0xB1>(ss); ss += dppf<0x4E>(ss);
            const float rr = 1.0f / sqrtf(ss * (1.f / 64.f) + EPS);
#pragma unroll
            for (int j = 0; j < 16; ++j) o[j] = o[j] * rr * P.k_norm_w[jq * 16 + j]; }
        v4u w0, w1; w0.x = pk2(o[0], o[1]); w0.y = pk2(o[2], o[3]); w0.z = pk2(o[4], o[5]); w0.w = pk2(o[6], o[7]); w1.x = pk2(o[8], o[9]); w1.y = pk2(o[10], o[11]); w1.z = pk2(o[12], o[13]); w1.w = pk2(o[14], o[15]);
        bf16* outp = (kv ? P.VCMP : P.KCMP) + ((size_t)((b * 2 + g) * 128 + n)) * 64 + jq * 16;
        *(v4u*)outp = w0; *(v4u*)(outp + 8) = w1;
    }
}
DI void conv_taps(const Ptrs& P, int c8, float (&cw)[3][8], float (&cb)[8]) {
#pragma unroll
    for (int k = 0; k < 3; ++k) { const f32x4 w0 = *(const f32x4*)(P.conv_w + k * 512 + c8), w1 = *(const f32x4*)(P.conv_w + k * 512 + c8 + 4);
        cw[k][0] = w0.x; cw[k][1] = w0.y; cw[k][2] = w0.z; cw[k][3] = w0.w; cw[k][4] = w1.x; cw[k][5] = w1.y; cw[k][6] = w1.z; cw[k][7] = w1.w; }
    const f32x4 w0 = *(const f32x4*)(P.conv_b + c8), w1 = *(const f32x4*)(P.conv_b + c8 + 4);
    cb[0] = w0.x; cb[1] = w0.y; cb[2] = w0.z; cb[3] = w0.w; cb[4] = w1.x; cb[5] = w1.y; cb[6] = w1.z; cb[7] = w1.w;
}
DI void ch_prod(const bf16* row, int c8, float (&u)[8]) {
    const v4u cv = *(const v4u*)(row + C_C + c8), hv = *(const v4u*)(row + C_H + c8);
    u[0] = bflo(cv.x) * bflo(hv.x); u[1] = bfhi(cv.x) * bfhi(hv.x); u[2] = bflo(cv.y) * bflo(hv.y); u[3] = bfhi(cv.y) * bfhi(hv.y);
    u[4] = bflo(cv.z) * bflo(hv.z); u[5] = bfhi(cv.z) * bfhi(hv.z); u[6] = bflo(cv.w) * bflo(hv.w); u[7] = bfhi(cv.w) * bfhi(hv.w);
}
DI void conv_out(const Ptrs& P, int t, int c8, const float (&cw)[3][8], const float (&cb)[8], const float (&u2)[8], const float (&u1)[8], const float (&u0)[8]) {
    const v4u bv = *(const v4u*)(P.PROJ + (size_t)t * INP + C_B + c8);
    const float bg[8] = {bflo(bv.x), bfhi(bv.x), bflo(bv.y), bfhi(bv.y), bflo(bv.z), bfhi(bv.z), bflo(bv.w), bfhi(bv.w)};
    float y[8];
#pragma unroll
    for (int e = 0; e < 8; ++e) y[e] = bg[e] * (cw[0][e] * u2[e] + cw[1][e] * u1[e] + cw[2][e] * u0[e] + cb[e]);
    v4u o; o.x = pk2(y[0], y[1]); o.y = pk2(y[2], y[3]); o.z = pk2(y[4], y[5]); o.w = pk2(y[6], y[7]);
    *(v4u*)(P.YMIX + (size_t)t * DM + c8) = o;
}
DI void proj_post_conv(const Ptrs& P, int mt, int chb, int wave, int lane) {
    const int c8 = chb + (lane & 31) * 8, stream = wave * 2 + (lane >> 5);
    float cw[3][8], cb[8]; conv_taps(P, c8, cw, cb);
    const int t0 = 256 * mt + 16 * stream, first = t0 + (stream == 0 ? 2 : 0);
    float u2[8], u1[8];
    if (stream) { ch_prod(P.PROJ + (size_t)(t0 - 2) * INP, c8, u2); ch_prod(P.PROJ + (size_t)(t0 - 1) * INP, c8, u1); }
    else {
#pragma unroll
        for (int e = 0; e < 8; ++e) { u2[e] = 0.f; u1[e] = 0.f; } }
#pragma unroll 1
    for (int t = t0; t < t0 + 16; t += 8) {
        v4u cv[8], hv[8], bv[8];
#pragma unroll
        for (int j = 0; j < 8; ++j) { const bf16* row = P.PROJ + (size_t)(t + j) * INP + c8; cv[j] = *(const v4u*)(row + C_C); hv[j] = *(const v4u*)(row + C_H); bv[j] = *(const v4u*)(row + C_B); }
#pragma unroll
        for (int j = 0; j < 8; ++j) {
            const float u0[8] = {bflo(cv[j].x) * bflo(hv[j].x), bfhi(cv[j].x) * bfhi(hv[j].x), bflo(cv[j].y) * bflo(hv[j].y), bfhi(cv[j].y) * bfhi(hv[j].y),
                                 bflo(cv[j].z) * bflo(hv[j].z), bfhi(cv[j].z) * bfhi(hv[j].z), bflo(cv[j].w) * bflo(hv[j].w), bfhi(cv[j].w) * bfhi(hv[j].w)};
            const float bg[8] = {bflo(bv[j].x), bfhi(bv[j].x), bflo(bv[j].y), bfhi(bv[j].y), bflo(bv[j].z), bfhi(bv[j].z), bflo(bv[j].w), bfhi(bv[j].w)};
            float y[8];
#pragma unroll
            for (int e = 0; e < 8; ++e) y[e] = bg[e] * (cw[0][e] * u2[e] + cw[1][e] * u1[e] + cw[2][e] * u0[e] + cb[e]);
            v4u o; o.x = pk2(y[0], y[1]); o.y = pk2(y[2], y[3]); o.z = pk2(y[4], y[5]); o.w = pk2(y[6], y[7]);
            if (t + j >= first) *(v4u*)(P.YMIX + (size_t)(t + j) * DM + c8) = o;
#pragma unroll
            for (int e = 0; e < 8; ++e) { u2[e] = u1[e]; u1[e] = u0[e]; }
        }
    }
}
DI void proj_post_knorm(const Ptrs& P, int mt, int wave, int lane) {
    const int grp = (lane >> 3) & 3, ch = lane & 7;
    const f32x4 w0 = *(const f32x4*)(P.k_norm_w + (grp < 2 ? 64 : 128) + ch * 8), w1 = *(const f32x4*)(P.k_norm_w + (grp < 2 ? 64 : 128) + ch * 8 + 4);
#pragma unroll 4
    for (int i = 0; i < 128 / NWAVES; ++i) {
        const int t = 256 * mt + (wave + NWAVES * i) * 2 + (lane >> 5);
        bf16* p = P.PROJ + (size_t)t * INP + (grp < 2 ? C_KS : C_KW) + (grp & 1) * 64 + ch * 8;
        const v4u u = *(const v4u*)p;
        const float a = bflo(u.x), b = bfhi(u.x), c = bflo(u.y), d = bfhi(u.y), e = bflo(u.z), f = bfhi(u.z), g2 = bflo(u.w), k = bfhi(u.w);
        const float ss = sum8(((a * a + b * b) + (c * c + d * d)) + ((e * e + f * f) + (g2 * g2 + k * k)));
        const float rr = 1.0f / sqrtf(ss * (1.f / 64.f) + EPS);
        v4u o; o.x = pk2(a * rr * w0.x, b * rr * w0.y); o.y = pk2(c * rr * w0.z, d * rr * w0.w); o.z = pk2(e * rr * w1.x, f * rr * w1.y); o.w = pk2(g2 * rr * w1.z, k * rr * w1.w);
        *(v4u*)p = o;
    }
}
DI void p2_misc(const Ptrs& P, LAS unsigned char* lds, int vcu, int G, int tid, int wave, int lane, bool do_norm) {
    const int ncw = G >> 2;
    if ((vcu & 3) == 0) {
        for (int u = vcu >> 2; u < 64; u += ncw) compress_unit(P, lds, u >> 5, (u >> 1) & 15, u & 1, tid, wave, lane);
        return;
    }
    const int ov = (vcu >> 2) * 3 + (vcu & 3) - 1, gw = ov * NWAVES + wave, NGW = (G - ncw) * NWAVES;
    if (do_norm) {
        pg8::Gemm g{P.MN, P.XKVT, NMEM, 2048, DM}; pg8::StaticOrder S; S.init(NMEM, 2048, G - ncw, ov);
        pg8::EpiBf16<0> E{P.XKV, 2048, nullptr, 0, 0, 1.f};
        pg8::gemm_phase<pg8::EpiBf16<0>, pg8::StaticOrder, true, true>(lds, g, S, E);
    }
    {
        const int c8 = lane * 8;
        float cw[3][8], cb[8]; conv_taps(P, c8, cw, cb);
        for (int i = gw; i < 2 * (NTOK / 256); i += NGW) {
            const int t = (i >> 1) * 256 + (i & 1), s = t & (SEQ - 1);
            float u[3][8];
#pragma unroll
            for (int k = 0; k < 3; ++k) {
                const int back = 2 - k;
                if (s >= back) ch_prod(P.PROJ + (size_t)(t - back) * INP, c8, u[k]);
                else {
#pragma unroll
                    for (int e = 0; e < 8; ++e) u[k][e] = 0.f; }
            }
            conv_out(P, t, c8, cw, cb, u[0], u[1], u[2]);
        }
    }
}
DI void xk_norm(const Ptrs& P, int gw, int NGW, int lane) {
    for (int it = gw; it < NMEM * 4 / 2; it += NGW) {
        const int rowid = it * 2 + (lane >> 5), m = rowid >> 2, hd = rowid & 3, ch = lane & 31;
        bf16* p = P.XKV + (size_t)m * 2048 + hd * 256 + ch * 8;
        const v4u u = *(const v4u*)p;
        const float a = bflo(u.x), b = bfhi(u.x), c = bflo(u.y), d = bfhi(u.y), e = bflo(u.z), f = bfhi(u.z), g2 = bflo(u.w), k = bfhi(u.w);
        const float ss = sum32(((a * a + b * b) + (c * c + d * d)) + ((e * e + f * f) + (g2 * g2 + k * k)));
        const float rr = 1.0f / sqrtf(ss * (1.f / 256.f) + EPS);
        f32x4 w0 = *(const f32x4*)(P.xk_norm_w + ch * 8), w1 = *(const f32x4*)(P.xk_norm_w + ch * 8 + 4);
        w0 *= *(const f32x4*)(P.xq_norm_w + ch * 8); w1 *= *(const f32x4*)(P.xq_norm_w + ch * 8 + 4);
        v4u o; o.x = pk2(a * rr * w0.x, b * rr * w0.y); o.y = pk2(c * rr * w0.z, d * rr * w0.w); o.z = pk2(e * rr * w1.x, f * rr * w1.y); o.w = pk2(g2 * rr * w1.z, k * rr * w1.w);
        *(v4u*)p = o;
    }
}
DI void p9_quant_h(const Ptrs& P, int gw, int NGW, int lane) {
    const f32x4 w0 = *(const f32x4*)(P.ffn_norm_w + 16 * lane), w1 = *(const f32x4*)(P.ffn_norm_w + 16 * lane + 4), w2 = *(const f32x4*)(P.ffn_norm_w + 16 * lane + 8), w3 = *(const f32x4*)(P.ffn_norm_w + 16 * lane + 12);
    for (int t0 = 4 * gw; t0 < NTOK; t0 += 4 * NGW) {
        v4u ha[4], hb[4];
#pragma unroll
        for (int q = 0; q < 4; ++q) { ha[q] = *(const v4u*)(P.HN + (size_t)(t0 + q) * DM + 16 * lane); hb[q] = *(const v4u*)(P.HN + (size_t)(t0 + q) * DM + 16 * lane + 8); }
#pragma unroll
        for (int q = 0; q < 4; ++q) {
            const float h0 = bflo(ha[q].x) * w0.x, h1 = bfhi(ha[q].x) * w0.y, h2 = bflo(ha[q].y) * w0.z, h3 = bfhi(ha[q].y) * w0.w, h4 = bflo(ha[q].z) * w1.x, h5 = bfhi(ha[q].z) * w1.y, h6 = bflo(ha[q].w) * w1.z, h7 = bfhi(ha[q].w) * w1.w;
            const float h8 = bflo(hb[q].x) * w2.x, h9 = bfhi(hb[q].x) * w2.y, h10 = bflo(hb[q].y) * w2.z, h11 = bfhi(hb[q].y) * w2.w, h12 = bflo(hb[q].z) * w3.x, h13 = bfhi(hb[q].z) * w3.y, h14 = bflo(hb[q].w) * w3.z, h15 = bfhi(hb[q].w) * w3.w;
            float mx = fmaxf(fmaxf(fmaxf(fabsf(h0), fabsf(h1)), fmaxf(fabsf(h2), fabsf(h3))), fmaxf(fmaxf(fabsf(h4), fabsf(h5)), fmaxf(fabsf(h6), fabsf(h7))));
            mx = fmaxf(mx, fmaxf(fmaxf(fmaxf(fabsf(h8), fabsf(h9)), fmaxf(fabsf(h10), fabsf(h11))), fmaxf(fmaxf(fabsf(h12), fabsf(h13)), fmaxf(fabsf(h14), fabsf(h15)))));
            mx = wave_max_u(mx);
            const float inv = mx > 0.f ? 127.0f / mx : 0.f;
            const v4u o = {q8x4(h0, h1, h2, h3, inv), q8x4(h4, h5, h6, h7, inv), q8x4(h8, h9, h10, h11, inv), q8x4(h12, h13, h14, h15, inv)};
            *(v4u*)(P.H8 + (size_t)(t0 + q) * DM + 16 * lane) = o;
            if (lane == 0) P.SH[t0 + q] = mx * (1.0f / 127.0f);
        }
    }
}

DI s16x4 tr_read(LAS const char* p) { return __builtin_bit_cast(s16x4, __builtin_amdgcn_ds_read_tr16_b64_v4i16((LAS s16x4*)p)); }
DI bf16x8 pack8a(const f32x16& x) { v4u p; p.x = pk2(x[0], x[1]); p.y = pk2(x[2], x[3]); p.z = pk2(x[4], x[5]); p.w = pk2(x[6], x[7]); return __builtin_bit_cast(bf16x8, p); }
DI bf16x8 pack8b(const f32x16& x) { v4u p; p.x = pk2(x[8], x[9]); p.y = pk2(x[10], x[11]); p.z = pk2(x[12], x[13]); p.w = pk2(x[14], x[15]); return __builtin_bit_cast(bf16x8, p); }
DI float max16(const f32x16& x) {
    float a = fmaxf(fmaxf(x[0], x[1]), fmaxf(x[2], x[3])), b = fmaxf(fmaxf(x[4], x[5]), fmaxf(x[6], x[7]));
    float c = fmaxf(fmaxf(x[8], x[9]), fmaxf(x[10], x[11])), d = fmaxf(fmaxf(x[12], x[13]), fmaxf(x[14], x[15]));
    return fmaxf(fmaxf(a, b), fmaxf(c, d));
}
DI float sum16(const f32x16& x) {
    return (((x[0] + x[1]) + (x[2] + x[3])) + ((x[4] + x[5]) + (x[6] + x[7]))) + (((x[8] + x[9]) + (x[10] + x[11])) + ((x[12] + x[13]) + (x[14] + x[15])));
}
template <int DH>
DI void qk_tile(LAS const char* ksm, const bf16x8* qf, f32x16& s0, f32x16& s1, int lane) {
    constexpr int KP = (DH + 8) * 2;
    LAS const char* kp = ksm + (lane & 31) * KP + (lane >> 5) * 16;
#pragma unroll
    for (int i = 0; i < 16; ++i) { s0[i] = 0.f; s1[i] = 0.f; }
#pragma unroll
    for (int d0 = 0; d0 < DH / 16; ++d0) {
        const bf16x8 a0 = *(LAS const bf16x8*)(kp + d0 * 32);
        const bf16x8 a1 = *(LAS const bf16x8*)(kp + 32 * KP + d0 * 32);
        s0 = MFMA32(a0, qf[d0], s0); s1 = MFMA32(a1, qf[d0], s1);
        if ((d0 & 3) == 3) __builtin_amdgcn_sched_barrier(0);
    }
}
template <int DH, int ND>
DI void pv_tile(LAS const char* vsm, const f32x16& p0, const f32x16& p1, f32x16* o, int dbase, int lane) {
    constexpr int VP = (DH + 32) * 2;
    const int h = lane >> 5, q4 = (lane & 15) >> 2, p = lane & 3, blk = (lane >> 4) & 1;
    LAS const char* vp = vsm + (4 * h + q4) * VP + (dbase + 16 * blk) * 2 + 8 * p;
    const bf16x8 pb0 = pack8a(p0), pb1 = pack8b(p0), pb2 = pack8a(p1), pb3 = pack8b(p1);
#pragma unroll
    for (int db = 0; db < ND; ++db) {
#define PV_STEP(S4, PB) { const s16x4 lo = tr_read(vp + (16 * (S4)) * VP + db * 64), hi = tr_read(vp + (16 * (S4) + 8) * VP + db * 64); \
        const bf16x8 va = __builtin_shufflevector(lo, hi, 0, 1, 2, 3, 4, 5, 6, 7); o[db] = MFMA32(va, PB, o[db]); }
        PV_STEP(0, pb0) PV_STEP(1, pb1) PV_STEP(2, pb2) PV_STEP(3, pb3)
        __builtin_amdgcn_sched_barrier(0);
#undef PV_STEP
    }
}
template <int DH, int ND>
DI void pv_tile_packed(LAS const char* vsm, const bf16x8& pb0, const bf16x8& pb1, const bf16x8& pb2, const bf16x8& pb3, f32x16* o, int dbase, int lane) {
    constexpr int VP = (DH + 32) * 2;
    const int h = lane >> 5, q4 = (lane & 15) >> 2, p = lane & 3, blk = (lane >> 4) & 1;
    LAS const char* vp = vsm + (4 * h + q4) * VP + (dbase + 16 * blk) * 2 + 8 * p;
#pragma unroll
    for (int db = 0; db < ND; ++db) {
#define PV_STEP(S4, PB) { const s16x4 lo = tr_read(vp + (16 * (S4)) * VP + db * 64), hi = tr_read(vp + (16 * (S4) + 8) * VP + db * 64); \
        const bf16x8 va = __builtin_shufflevector(lo, hi, 0, 1, 2, 3, 4, 5, 6, 7); o[db] = MFMA32(va, PB, o[db]); }
        PV_STEP(0, pb0) PV_STEP(1, pb1) PV_STEP(2, pb2) PV_STEP(3, pb3)
        __builtin_amdgcn_sched_barrier(0);
#undef PV_STEP
    }
}
DI void mask_tile(f32x16& s0, f32x16& s1, int klo, int khi, int h) {
    int hh = 4 * h; asm volatile("" : "+v"(hh));
    const int kl = klo - hh, kh = khi - hh;
#pragma unroll
    for (int i = 0; i < 16; ++i) { const int c0 = (i & 3) + 8 * (i >> 2), c1 = 32 + c0;
        s0[i] = (c0 >= kl && c0 <= kh) ? s0[i] : -INFINITY; s1[i] = (c1 >= kl && c1 <= kh) ? s1[i] : -INFINITY; }
}
DI float fmax3(float a, float b, float c) { float r; asm("v_max3_f32 %0, %1, %2, %3" : "=v"(r) : "v"(a), "v"(b), "v"(c)); return r; }
DI float max32(const f32x16& a, const f32x16& b) {
    float t0 = fmax3(a[0], a[1], a[2]), t1 = fmax3(a[3], a[4], a[5]), t2 = fmax3(a[6], a[7], a[8]), t3 = fmax3(a[9], a[10], a[11]), t4 = fmax3(a[12], a[13], a[14]);
    float u0 = fmax3(b[0], b[1], b[2]), u1 = fmax3(b[3], b[4], b[5]), u2 = fmax3(b[6], b[7], b[8]), u3 = fmax3(b[9], b[10], b[11]), u4 = fmax3(b[12], b[13], b[14]);
    t0 = fmax3(t0, t1, t2); t3 = fmax3(t3, t4, a[15]); u0 = fmax3(u0, u1, u2); u3 = fmax3(u3, u4, b[15]);
    return fmax3(fmax3(t0, t3, u0), u3, u3);
}
DI float max16t(const f32x16& a) {
    const float t0 = fmax3(a[0], a[1], a[2]), t1 = fmax3(a[3], a[4], a[5]), t2 = fmax3(a[6], a[7], a[8]), t3 = fmax3(a[9], a[10], a[11]), t4 = fmax3(a[12], a[13], a[14]);
    return fmax3(fmax3(t0, t1, t2), fmax3(t3, t4, a[15]), t0);
}
template <int ND>
DI void softmax_tile(f32x16& s0, f32x16& s1, f32x16* o, float& m, float& l, float dead) {
    float mx = max32(s0, s1); { const auto rr = __builtin_amdgcn_permlane32_swap(__float_as_uint(mx), __float_as_uint(mx), false, false); mx = fmax3(__uint_as_float(rr[0]), __uint_as_float(rr[1]), mx); }
    const float mn = fmaxf(m, mx), alpha = __builtin_amdgcn_exp2f(m - mn), mnd = mn + dead;
    s0 = s0 - mnd; s1 = s1 - mnd;
#pragma unroll
    for (int i = 0; i < 16; ++i) { s0[i] = __builtin_amdgcn_exp2f(s0[i]); s1[i] = __builtin_amdgcn_exp2f(s1[i]); }
    const f32x16 t = s0 + s1;
    float rs = sum16(t); { const auto rr = __builtin_amdgcn_permlane32_swap(__float_as_uint(rs), __float_as_uint(rs), false, false); rs = __uint_as_float(rr[0]) + __uint_as_float(rr[1]); }
    l = l * alpha + rs; m = mn;
#pragma unroll
    for (int db = 0; db < ND; ++db) o[db] *= alpha;
}
template <int DH>
DI void qk_tile_c(LAS const char* ksm, const bf16x8* qf, const f32x16& cinit, f32x16& s0, f32x16& s1, int lane) {
    constexpr int KP = (DH + 8) * 2;
    LAS const char* kp = ksm + (lane & 31) * KP + (lane >> 5) * 16;
    s0 = MFMA32(*(LAS const bf16x8*)(kp), qf[0], cinit); s1 = MFMA32(*(LAS const bf16x8*)(kp + 32 * KP), qf[0], cinit);
#pragma unroll
    for (int d0 = 1; d0 < DH / 16; ++d0) {
        const bf16x8 a0 = *(LAS const bf16x8*)(kp + d0 * 32);
        const bf16x8 a1 = *(LAS const bf16x8*)(kp + 32 * KP + d0 * 32);
        s0 = MFMA32(a0, qf[d0], s0); s1 = MFMA32(a1, qf[d0], s1);
    }
}
template <int ND>
DI void softmax_tile_ref(f32x16& s0, f32x16& s1, f32x16* o, float& negm, float& l) {
    float mx = max32(s0, s1); { const auto rr = __builtin_amdgcn_permlane32_swap(__float_as_uint(mx), __float_as_uint(mx), false, false); mx = fmax3(__uint_as_float(rr[0]), __uint_as_float(rr[1]), mx); }
    if (__any(mx > 8.0f)) {
        const float delta = mx > 8.0f ? mx : 0.f, f = __builtin_amdgcn_exp2f(-delta);
        s0 = s0 - delta; s1 = s1 - delta; negm = negm - delta; l *= f;
#pragma unroll
        for (int db = 0; db < ND; ++db) o[db] *= f;
    }
#pragma unroll
    for (int i = 0; i < 16; ++i) { s0[i] = __builtin_amdgcn_exp2f(s0[i]); s1[i] = __builtin_amdgcn_exp2f(s1[i]); }
    const f32x16 t = s0 + s1;
    float rs = sum16(t); { const auto rr = __builtin_amdgcn_permlane32_swap(__float_as_uint(rs), __float_as_uint(rs), false, false); rs = __uint_as_float(rr[0]) + __uint_as_float(rr[1]); }
    l += rs;
}
template <int DH>
DI void load_q_frags(const bf16* qrow, const float* w, float scale, bf16x8* qf, int lane) {
    const int h = lane >> 5;
    v4u raw[DH / 16]; float ss = 0.f;
#pragma unroll
    for (int d0 = 0; d0 < DH / 16; ++d0) { raw[d0] = *(const v4u*)(qrow + 16 * d0 + 8 * h);
        const float a = bflo(raw[d0].x), b = bfhi(raw[d0].x), c = bflo(raw[d0].y), d = bfhi(raw[d0].y), e = bflo(raw[d0].z), f = bfhi(raw[d0].z), g = bflo(raw[d0].w), k = bfhi(raw[d0].w);
        ss += ((a * a + b * b) + (c * c + d * d)) + ((e * e + f * f) + (g * g + k * k)); }
    ss += __shfl_xor(ss, 32);
    const float r = scale / sqrtf(ss * (1.f / DH) + EPS);
#pragma unroll
    for (int d0 = 0; d0 < DH / 16; ++d0) { const f32x4 w0 = *(const f32x4*)(w + 16 * d0 + 8 * h), w1 = *(const f32x4*)(w + 16 * d0 + 8 * h + 4);
        v4u o; o.x = pk2(bflo(raw[d0].x) * r * w0.x, bfhi(raw[d0].x) * r * w0.y); o.y = pk2(bflo(raw[d0].y) * r * w0.z, bfhi(raw[d0].y) * r * w0.w);
        o.z = pk2(bflo(raw[d0].z) * r * w1.x, bfhi(raw[d0].z) * r * w1.y); o.w = pk2(bflo(raw[d0].w) * r * w1.z, bfhi(raw[d0].w) * r * w1.w);
        qf[d0] = __builtin_bit_cast(bf16x8, o); }
}
template <int DH>
DI void tile_gload(const bf16* base, size_t pitch, v4u* regs, int tid) {
    constexpr int CPR = DH / 8;
#pragma unroll
    for (int k = 0; k < DH / 64; ++k) { const int id = tid + NTHR * k, row = id / CPR, ch = id % CPR; regs[k] = *(const v4u*)(base + (size_t)row * pitch + ch * 8); }
}
template <int DH, int PADE>
DI void tile_lstore(LAS char* sm, const v4u* regs, int tid) {
    constexpr int CPR = DH / 8, PB = (DH + PADE) * 2;
#pragma unroll
    for (int k = 0; k < DH / 64; ++k) { const int id = tid + NTHR * k, row = id / CPR, ch = id % CPR; *(LAS v4u*)(sm + row * PB + ch * 16) = regs[k]; }
}
DI float sigmoidf_(float x) { return 1.0f / (1.0f + __expf(-x)); }

DI void nsa_tile_fused(LAS const char* ksm, LAS const char* vsm, const bf16x8* qf, const f32x16& c0, f32x16* o, float& nref, float& l, int lane) {
    constexpr int KP = 144, VP = 192;
    LAS const char* kp = ksm + (lane & 31) * KP + (lane >> 5) * 16;
    const int h = lane >> 5, q4 = (lane & 15) >> 2, p = lane & 3, blk = (lane >> 4) & 1;
    LAS const char* vp = vsm + (4 * h + q4) * VP + (16 * blk) * 2 + 8 * p;
    f32x16 s0 = MFMA32(*(LAS const bf16x8*)(kp), qf[0], c0);
#pragma unroll
    for (int d0 = 1; d0 < 4; ++d0) s0 = MFMA32(*(LAS const bf16x8*)(kp + d0 * 32), qf[d0], s0);
    f32x16 s1 = MFMA32(*(LAS const bf16x8*)(kp + 32 * KP), qf[0], c0);
#pragma unroll
    for (int d0 = 1; d0 < 4; ++d0) s1 = MFMA32(*(LAS const bf16x8*)(kp + 32 * KP + d0 * 32), qf[d0], s1);
#define PV_STEP(S4, PB, DB) { const s16x4 lo = tr_read(vp + (16 * (S4)) * VP + (DB) * 64), hi = tr_read(vp + (16 * (S4) + 8) * VP + (DB) * 64); \
        const bf16x8 va = __builtin_shufflevector(lo, hi, 0, 1, 2, 3, 4, 5, 6, 7); o[DB] = MFMA32(va, PB, o[DB]); }
#pragma unroll
    for (int i = 0; i < 16; ++i) s0[i] = __builtin_amdgcn_exp2f(s0[i]);
    float rs = sum16(s0);
    { const bf16x8 pb0 = pack8a(s0), pb1 = pack8b(s0);
      PV_STEP(0, pb0, 0) PV_STEP(1, pb1, 0) PV_STEP(0, pb0, 1) PV_STEP(1, pb1, 1) }
#pragma unroll
    for (int i = 0; i < 16; ++i) s1[i] = __builtin_amdgcn_exp2f(s1[i]);
    rs += sum16(s1);
    { const bf16x8 pb2 = pack8a(s1), pb3 = pack8b(s1);
      PV_STEP(2, pb2, 0) PV_STEP(3, pb3, 0) PV_STEP(2, pb2, 1) PV_STEP(3, pb3, 1) }
#undef PV_STEP
    { const auto rr = __builtin_amdgcn_permlane32_swap(__float_as_uint(rs), __float_as_uint(rs), false, false); rs = __uint_as_float(rr[0]) + __uint_as_float(rr[1]); }
    l += rs;
    if (__any(l > 65536.0f)) {
        const unsigned e = l > 65536.0f ? (__float_as_uint(l) >> 23) - 127u : 0u;
        const float f = __uint_as_float((127u - e) << 23);
        nref -= (float)e; l *= f; o[0] *= f; o[1] *= f;
    }
}
constexpr int NSA_K_OFF = 0, NSA_V_OFF = 18432, NSA_IMP_OFF = 43008, NSA_IMP_PITCH = 36, NSA_SEL_OFF = NSA_IMP_OFF + 4 * 64 * NSA_IMP_PITCH * 4, NSA_TOT_OFF = NSA_SEL_OFF + 256;
template <int NQ>
DI void nsa_cmp_branch(LAS const char* ksm, LAS const char* vsm, LAS float* imph, const bf16x8* qf, int tpos, float gate0, LAS char* totp, int lane) {
    constexpr int KP = 144, VP = 192;
    const int h = lane >> 5;
    f32x16 s[NQ];
    qk_tile<64>(ksm, qf, s[0], s[1], lane);
    if (NQ == 4) qk_tile<64>(ksm + 64 * KP, qf, s[NQ - 2], s[NQ - 1], lane);
    const int nmax = tpos >= 31 ? min(126, (tpos - 31) >> 4) : -1;
    float mx = -INFINITY;
    int hh = 4 * h; asm volatile("" : "+v"(hh));
    const int nm = nmax - hh;
#pragma unroll
    for (int q = 0; q < NQ; ++q)
#pragma unroll
        for (int i = 0; i < 16; ++i) { const int c = 32 * q + (i & 3) + 8 * (i >> 2); s[q][i] = (c <= nm) ? s[q][i] : -INFINITY; mx = fmaxf(mx, s[q][i]); }
    { const auto rr = __builtin_amdgcn_permlane32_swap(__float_as_uint(mx), __float_as_uint(mx), false, false); mx = fmaxf(__uint_as_float(rr[0]), __uint_as_float(rr[1])); }
    const float mm = (mx == -INFINITY) ? 0.f : mx;
    float rs = 0.f;
#pragma unroll
    for (int q = 0; q < NQ; ++q) {
#pragma unroll
        for (int i = 0; i < 16; ++i) s[q][i] = __builtin_amdgcn_exp2f(s[q][i] - mm);
        rs += sum16(s[q]); }
    { const auto rr = __builtin_amdgcn_permlane32_swap(__float_as_uint(rs), __float_as_uint(rs), false, false); rs = __uint_as_float(rr[0]) + __uint_as_float(rr[1]); }
    const float inv = rs > 0.f ? 1.0f / rs : 0.f;
    if (NQ == 4) {
        LAS float* ip = imph + h;
#pragma unroll
        for (int G = 0; G < 16; ++G) { const int q = G >> 2, g4 = G & 3;
            const float sum4 = (s[q][4 * g4] + s[q][4 * g4 + 1]) + (s[q][4 * g4 + 2] + s[q][4 * g4 + 3]);
            const float last = s[q][4 * g4 + 3], prev = G ? s[(G - 1) >> 2][4 * ((G - 1) & 3) + 3] : 0.f;
            const auto rr = __builtin_amdgcn_permlane32_swap(__float_as_uint(prev), __float_as_uint(last), false, false);
            const float extra = h ? __uint_as_float(rr[0]) : __uint_as_float(rr[1]);
            ip[2 * G] = (sum4 + extra) * inv; }
    }
    f32x16 oc[2];
#pragma unroll
    for (int i = 0; i < 16; ++i) { oc[0][i] = 0.f; oc[1][i] = 0.f; }
    pv_tile<64, 2>(vsm, s[0], s[1], oc, 0, lane);
    if (NQ == 4) pv_tile<64, 2>(vsm + 64 * VP, s[NQ - 2], s[NQ - 1], oc, 0, lane);
    const float f = gate0 * inv;
#pragma unroll
    for (int c = 0; c < 8; ++c) { const f32x16& x = oc[c >> 2]; const int e = 4 * (c & 3); *(LAS f32x4*)(totp + c * 1024) = (f32x4){x[e] * f, x[e + 1] * f, x[e + 2] * f, x[e + 3] * f}; }
}
template <int MODE>
DI void nsa_unit(const Ptrs& P, LAS unsigned char* lds, int b, int g, int qi, int tid, int wave, int lane) {
    constexpr int KP = 144, VP = 192;
    const int r = lane & 31, h = lane >> 5;
    const int hd = g * 4 + (wave >> 1), tl = 32 * (wave & 1) + r;
    const size_t tok = (size_t)b * SEQ + 64 * qi + tl;
    const int tpos = 64 * qi + tl;
    LAS char* ksm = (LAS char*)lds + NSA_K_OFF; LAS char* vsm = (LAS char*)lds + NSA_V_OFF;
    LAS float* imp = (LAS float*)(lds + NSA_IMP_OFF); LAS unsigned* selm = (LAS unsigned*)(lds + NSA_SEL_OFF);
    v4u ckr[2], cvr[2];
    { const bf16* kc = P.KCMP + (size_t)(b * 2 + g) * 128 * 64; const bf16* vc = P.VCMP + (size_t)(b * 2 + g) * 128 * 64;
#pragma unroll
      for (int k = 0; k < 2; ++k) { const int id = tid + NTHR * k, row = id >> 3, ch = id & 7; ckr[k] = *(const v4u*)(kc + row * 64 + ch * 8); cvr[k] = *(const v4u*)(vc + row * 64 + ch * 8); } }
    const bf16* kvbase = P.PROJ + (size_t)b * SEQ * INP + g * 64;
    v4u kreg[1], vreg[1];
    tile_gload<64>(kvbase + C_KS, INP, kreg, tid); tile_gload<64>(kvbase + C_VS, INP, vreg, tid);
    bf16x8 qf[4];
    load_q_frags<64>(P.PROJ + tok * INP + C_Q + hd * 64, P.q_norm_w, 0.125f * LOG2E, qf, lane);
    float gate[3];
#pragma unroll
    for (int br = 0; br < 3; ++br) gate[br] = sigmoidf_(bf2f(P.PROJ[tok * INP + C_G + hd * 3 + br]));
    LAS char* totp = (LAS char*)lds + NSA_TOT_OFF + (wave * 512 + lane) * 16;

    __syncthreads();
    {
#pragma unroll
        for (int k = 0; k < 2; ++k) { const int id = tid + NTHR * k, row = id >> 3, ch = id & 7;
            *(LAS v4u*)(ksm + row * KP + ch * 16) = ckr[k]; *(LAS v4u*)(vsm + row * VP + ch * 16) = cvr[k]; }
    }
    __syncthreads();
    if (qi >= 16) nsa_cmp_branch<4>(ksm, vsm, imp + ((wave >> 1) * 64 + tl) * NSA_IMP_PITCH, qf, tpos, gate[0], totp, lane);
    else nsa_cmp_branch<2>(ksm, vsm, imp, qf, tpos, gate[0], totp, lane);
    __syncthreads();
    {
        const int tk = tid >> 3, sub = tid & 7;
        unsigned bits;
        if (qi >= 16) {
            float v[32];
#pragma unroll
            for (int c = 0; c < 8; ++c) { LAS const float* ip = imp + tk * NSA_IMP_PITCH + 4 * c;
                const f32x4 a = *(LAS const f32x4*)ip, b2 = *(LAS const f32x4*)(ip + 64 * NSA_IMP_PITCH), c2 = *(LAS const f32x4*)(ip + 128 * NSA_IMP_PITCH), d2 = *(LAS const f32x4*)(ip + 192 * NSA_IMP_PITCH);
                const f32x4 t = (a + b2) + (c2 + d2);
#pragma unroll
                for (int e = 0; e < 4; ++e) { const int j2 = 4 * c + e; v[j2] = (j2 >= 1 && j2 <= qi - 2) ? t[e] : -1.0f; } }
            bits = 0u;
#pragma unroll
            for (int k = 0; k < 4; ++k) { const int j = sub + 8 * k;
                float vj = v[8 * k];
#pragma unroll
                for (int t = 1; t < 8; ++t) vj = (sub == t) ? v[8 * k + t] : vj;
                int rank = 0;
#pragma unroll
                for (int j2 = 0; j2 < 32; ++j2) {
                    if ((j2 >> 3) < k) rank += (v[j2] >= vj) ? 1 : 0;
                    else if ((j2 >> 3) > k) rank += (v[j2] > vj) ? 1 : 0;
                    else rank += (v[j2] > vj || (v[j2] == vj && (j2 & 7) < sub)) ? 1 : 0; }
                if (j >= 1 && j <= qi - 2 && rank < 13) bits |= 1u << j; }
            bits |= __shfl_xor(bits, 1); bits |= __shfl_xor(bits, 2); bits |= __shfl_xor(bits, 4);
            bits |= 1u | (1u << qi) | (1u << (qi - 1));
        } else bits = (2u << qi) - 1u;
        if (sub == 0) selm[tk] = bits;
    }
    const int nsel = qi + 1, nwin = min(9, qi + 1), ntiles = nsel + nwin;
    f32x16 o[2]; float l = 0.f, nref = 0.f;
#pragma unroll
    for (int i = 0; i < 16; ++i) { o[0][i] = 0.f; o[1][i] = 0.f; }
    unsigned mysel = 0u;
    for (int tt = 0; tt < (MODE >= 5 ? 0 : ntiles); ++tt) {
        if (MODE != 2 || tt == 0) {
        __syncthreads();
        tile_lstore<64, 8>(ksm, kreg, tid); tile_lstore<64, 32>(vsm, vreg, tid);
        __syncthreads(); }
        if (tt == 0) mysel = selm[tl];
        if (MODE != 2 && tt + 1 < ntiles) { const int t2 = tt + 1; const bool w2 = t2 >= nsel; const int j2 = w2 ? qi - (t2 - nsel) : t2;
            tile_gload<64>(kvbase + (size_t)j2 * 64 * INP + (w2 ? C_KW : C_KS), INP, kreg, tid);
            tile_gload<64>(kvbase + (size_t)j2 * 64 * INP + (w2 ? C_VW : C_VS), INP, vreg, tid); }
        const bool win = tt >= nsel; const int j = win ? qi - (tt - nsel) : tt;
        if (tt == nsel) {
            const float f = l > 0.f ? gate[1] / l : 0.f;
#pragma unroll
            for (int c = 0; c < 8; ++c) { const f32x16& x = o[c >> 2]; const int e = 4 * (c & 3); LAS f32x4* tp = (LAS f32x4*)(totp + c * 1024); *tp = *tp + (f32x4){x[e] * f, x[e + 1] * f, x[e + 2] * f, x[e + 3] * f}; }
#pragma unroll
            for (int i = 0; i < 16; ++i) { o[0][i] = 0.f; o[1][i] = 0.f; }
            l = 0.f; nref = 0.f;
        }
        if (MODE == 1) continue;
        const bool dead = !win && !((mysel >> j) & 1u);
        f32x16 c0;
        { const float cv = dead ? -INFINITY : nref;
#pragma unroll
          for (int i = 0; i < 16; ++i) c0[i] = cv; }
        if (j == qi || (win && j == qi - 8)) {
            f32x16 s0, s1;
            qk_tile_c<64>(ksm, qf, c0, s0, s1, lane);
            int klo = 0, khi = 63;
            if (j == qi) khi = tl; else klo = tl + 1;
            mask_tile(s0, s1, klo, khi, h);
            softmax_tile_ref<2>(s0, s1, o, nref, l);
            pv_tile<64, 2>(vsm, s0, s1, o, 0, lane);
        } else nsa_tile_fused(ksm, vsm, qf, c0, o, nref, l, lane);
    }
    { const float f = l > 0.f ? gate[2] / l : 0.f;
      bf16* op = P.YMIX + tok * DM + 512 + hd * 64 + 4 * h;
#pragma unroll
      for (int c = 0; c < 8; ++c) { const f32x16& x = o[c >> 2]; const int e = 4 * (c & 3); const f32x4 t = *(LAS const f32x4*)(totp + c * 1024) + (f32x4){x[e] * f, x[e + 1] * f, x[e + 2] * f, x[e + 3] * f};
          v2u w; w.x = pk2(t[0], t[1]); w.y = pk2(t[2], t[3]);
          *(v2u*)(op + 32 * (c >> 2) + 8 * (c & 3)) = w; } }
}
template <int MODE>
DI void p3_nsa(const Ptrs& P, LAS unsigned char* lds, int vcu, int G, int tid, int wave, int lane) {
    for (int v = vcu; v < 256; v += G) {
        const int bg = v >> 3, s = v & 7;
#pragma unroll 1
        for (int k = 0; k < 4; ++k) { const int qi = (k == 0) ? 31 - s : (k == 1) ? 16 + s : (k == 2) ? 15 - s : s;
            nsa_unit<MODE>(P, lds, bg >> 1, bg & 1, qi, tid, wave, lane); }
    }
}

constexpr int XA_Q_OFF = 0, XA_K_OFF = 67584, XA_V_OFF = 101376, XA_XP_OFF = 138240, XA_XR_OFF = XA_XP_OFF + 16384;
DI void xattn_unit(const Ptrs& P, LAS unsigned char* lds, int b, int hd, int qt, int tid, int wave, int lane) {
    constexpr int KP = 528, VP = 576;
    const int r = lane & 31, h = lane >> 5, rb = wave >> 1, kh = wave & 1;
    const size_t tok0 = (size_t)b * SEQ + 128 * qt;
    LAS char* qsm = (LAS char*)lds + XA_Q_OFF; LAS char* ksm = (LAS char*)lds + XA_K_OFF; LAS char* vsm = (LAS char*)lds + XA_V_OFF;
    LAS const char* qrow = qsm + (32 * rb + r) * KP + h * 16;
    LAS char* xw = (LAS char*)lds + XA_XP_OFF + (wave * 64 + lane) * 16;
    LAS const char* xr0 = (LAS const char*)lds + XA_XP_OFF + (rb * 128 + lane) * 16;
    LAS float* xs = (LAS float*)(lds + XA_XR_OFF);
    const bf16* kb = P.XKV + (size_t)b * MEMT * 2048 + hd * 256; const bf16* vb = kb + 1024;
    v4u kreg[4], vreg[4];
    tile_gload<256>(kb, 2048, kreg, tid); tile_gload<256>(vb, 2048, vreg, tid);
    f32x4 sp0, sp1, sp2, sp3;
    { const float* sp = P.SSP1 + (tok0 + 32 * rb + r) * 16; sp0 = *(const f32x4*)sp; sp1 = *(const f32x4*)(sp + 4); sp2 = *(const f32x4*)(sp + 8); sp3 = *(const f32x4*)(sp + 12); }
    {
        const bf16* qb = P.XQ + tok0 * DM + hd * 256;
        v4u qreg[8];
#pragma unroll
        for (int k = 0; k < 8; ++k) { const int id = tid + NTHR * k, row = id >> 5, ch = id & 31; qreg[k] = *(const v4u*)(qb + (size_t)row * DM + ch * 8); }
        __syncthreads();
#pragma unroll
        for (int k = 0; k < 8; ++k) { const int id = tid + NTHR * k, row = id >> 5, ch = id & 31; *(LAS v4u*)(qsm + row * KP + ch * 16) = qreg[k]; }
    }
    f32x16 o[4]; float nref = 0.f, l = 0.f, cq = 0.f;
#pragma unroll
    for (int db = 0; db < 4; ++db)
#pragma unroll
        for (int i = 0; i < 16; ++i) o[db][i] = 0.f;
#pragma unroll 1
    for (int tt = 0; tt < 4; ++tt) {
        if (tt > 0) __syncthreads();
        tile_lstore<256, 8>(ksm, kreg, tid); tile_lstore<256, 32>(vsm, vreg, tid);
        __syncthreads();
        if (tt + 1 < 4) { tile_gload<256>(kb + (size_t)(tt + 1) * 64 * 2048, 2048, kreg, tid); tile_gload<256>(vb + (size_t)(tt + 1) * 64 * 2048, 2048, vreg, tid); }
        if (tt == 0) {
            float ss = 0.f;
#pragma unroll
            for (int d0 = 0; d0 < 16; ++d0) { const v4u u = *(LAS const v4u*)(qrow + d0 * 32);
                const float a = bflo(u.x), b2 = bfhi(u.x), c = bflo(u.y), d = bfhi(u.y), e = bflo(u.z), f = bfhi(u.z), g = bflo(u.w), k = bfhi(u.w);
                ss += ((a * a + b2 * b2) + (c * c + d * d)) + ((e * e + f * f) + (g * g + k * k)); }
            ss += __shfl_xor(ss, 32);
            const f32x4 p0 = sp0, p1 = sp1, p2 = sp2, p3 = sp3;
            const float rt = 1.0f / sqrtf((((p0.x + p0.y) + (p0.z + p0.w)) + ((p1.x + p1.y) + (p1.z + p1.w)) + ((p2.x + p2.y) + (p2.z + p2.w)) + ((p3.x + p3.y) + (p3.z + p3.w))) * (1.f / DM) + EPS);
            cq = 0.0625f * LOG2E * rt / sqrtf(rt * rt * ss * (1.f / 256.f) + EPS);
        }
        f32x16 s;
        {
            LAS const char* kp = ksm + (32 * kh + r) * KP + h * 16;
#pragma unroll
            for (int i = 0; i < 16; ++i) s[i] = 0.f;
#pragma unroll
            for (int d0 = 0; d0 < 16; ++d0) {
                const bf16x8 a0 = *(LAS const bf16x8*)(kp + d0 * 32), bq = *(LAS const bf16x8*)(qrow + d0 * 32);
                s = MFMA32(a0, bq, s);
                if ((d0 & 3) == 3) __builtin_amdgcn_sched_barrier(0);
            }
        }
        s = s * cq + nref;
#pragma unroll
        for (int i = 0; i < 16; ++i) s[i] = __builtin_amdgcn_exp2f(s[i]);
        { float rs = sum16(s); { const auto rr = __builtin_amdgcn_permlane32_swap(__float_as_uint(rs), __float_as_uint(rs), false, false); rs = __uint_as_float(rr[0]) + __uint_as_float(rr[1]); }
          *(LAS bf16x8*)xw = pack8a(s); *(LAS bf16x8*)(xw + 8192) = pack8b(s); xs[wave * 64 + lane] = rs; }
        __syncthreads();
        {
            const bf16x8 pb0 = *(LAS const bf16x8*)xr0, pb1 = *(LAS const bf16x8*)(xr0 + 8192), pb2 = *(LAS const bf16x8*)(xr0 + 1024), pb3 = *(LAS const bf16x8*)(xr0 + 1024 + 8192);
            l += xs[rb * 128 + lane] + xs[rb * 128 + 64 + lane];
            pv_tile_packed<256, 4>(vsm, pb0, pb1, pb2, pb3, o, 128 * kh, lane);
        }
        if (__any(l > 65536.0f)) {
            const unsigned e = l > 65536.0f ? (__float_as_uint(l) >> 23) - 127u : 0u;
            const float f2 = __uint_as_float((127u - e) << 23);
            nref -= (float)e; l *= f2;
#pragma unroll
            for (int db = 0; db < 4; ++db) o[db] *= f2;
        }
    }
    const float f = 1.0f / l;
    bf16* op = P.YMIX + (tok0 + 32 * rb + r) * DM + hd * 256 + 128 * kh + 4 * h;
#pragma unroll
    for (int db = 0; db < 4; ++db)
#pragma unroll
        for (int g4 = 0; g4 < 4; ++g4) { v2u w; w.x = pk2(o[db][4 * g4] * f, o[db][4 * g4 + 1] * f); w.y = pk2(o[db][4 * g4 + 2] * f, o[db][4 * g4 + 3] * f);
            *(v2u*)(op + 32 * db + 8 * g4) = w; }
}
DI void p7_xattn(const Ptrs& P, LAS unsigned char* lds, int bx, int G, int tid, int wave, int lane) {
    pg8::StaticOrder SO; SO.init(NTOK, DM, G, bx); pg8::Unit un;
    for (int ui = 0; SO.next(ui, un); ++ui) {
        const int b = un.pm >> 3, qt0 = (un.pm & 7) * 2;
        xattn_unit(P, lds, b, un.pn, qt0, tid, wave, lane); xattn_unit(P, lds, b, un.pn, qt0 + 1, tid, wave, lane);
    }
}

DI unsigned umax3(unsigned a, unsigned b, unsigned c) { return max(max(a, b), c); }
DI unsigned umax16(const unsigned* k) {
    return umax3(umax3(umax3(k[0], k[1], k[2]), umax3(k[3], k[4], k[5]), umax3(k[6], k[7], k[8])), umax3(umax3(k[9], k[10], k[11]), umax3(k[12], k[13], k[14]), k[15]), 0u);
}
DI unsigned pair_umax(unsigned m) { const auto rr = __builtin_amdgcn_permlane32_swap(m, m, false, false); return max((unsigned)rr[0], (unsigned)rr[1]); }
DI void ce_desc(unsigned& a, unsigned& b) { const unsigned hi = max(a, b), lo = min(a, b); a = hi; b = lo; }
DI void bitonic_sort16_desc(unsigned* k) {
#pragma unroll
    for (int kk = 2; kk <= 16; kk <<= 1)
#pragma unroll
        for (int j = kk >> 1; j > 0; j >>= 1)
#pragma unroll
            for (int i = 0; i < 16; ++i) { const int l = i ^ j; if (l > i) { if ((i & kk) == 0) ce_desc(k[i], k[l]); else ce_desc(k[l], k[i]); } }
}
DI void bitonic_merge16_desc(unsigned* k) {
#pragma unroll
    for (int j = 8; j > 0; j >>= 1)
#pragma unroll
        for (int i = 0; i < 16; ++i) { const int l = i ^ j; if (l > i) ce_desc(k[i], k[l]); }
}
DI void top16_of_two_desc(unsigned* x, const unsigned* y) {
#pragma unroll
    for (int i = 0; i < 16; ++i) x[i] = max(x[i], y[15 - i]);
    bitonic_merge16_desc(x);
}
constexpr int PK_PITCH = 272;
constexpr int PK_SCR_OFF = 2 * 128 * PK_PITCH;
DI void p11_peer_topk(const Ptrs& P, LAS unsigned char* lds, int bx, int G, int tid, int wave, int lane) {
    const int r = lane & 31, h = lane >> 5;
    LAS char* ksm = (LAS char*)lds;
    LAS unsigned* tvl = (LAS unsigned*)(lds + PK_SCR_OFF + wave * 8192);
    LAS float* bsl = (LAS float*)(tvl + 1024); LAS int* bel = (LAS int*)(tvl + 1536);
    pg8::StaticOrder SO; SO.init(NTOK, 2048, G, bx); pg8::Unit un;
    for (int ui = 0; SO.next(ui, un); ++ui) {
        const int hd = un.pn;
        __syncthreads();
        {
            const bf16* kb = P.PKEYS + (size_t)hd * 2 * 128 * 128;
#pragma unroll
            for (int k = 0; k < 8; ++k) { const int id = tid + NTHR * k, row = id >> 4, ch = id & 15; *(LAS v4u*)(ksm + row * PK_PITCH + ch * 16) = *(const v4u*)(kb + row * 128 + ch * 8); }
        }
        __syncthreads();
        {
        const size_t tok = (size_t)un.pm * 256 + 32 * wave + r;
#pragma unroll 1
        for (int c = 0; c < 2; ++c) {
            bf16x8 qf[8];
#pragma unroll
            for (int d0 = 0; d0 < 8; ++d0) qf[d0] = *(const bf16x8*)(P.PQ + tok * 2048 + hd * 256 + c * 128 + 16 * d0 + 8 * h);
            unsigned key[64];
            unsigned h4 = 4u * (unsigned)h; asm volatile("" : "+v"(h4));
#pragma unroll
            for (int nb = 0; nb < 4; ++nb) {
                f32x16 sc;
#pragma unroll
                for (int i = 0; i < 16; ++i) sc[i] = 64.f;
                LAS const char* kp = ksm + (c * 128 + 32 * nb + r) * PK_PITCH + h * 16;
#pragma unroll
                for (int d0 = 0; d0 < 8; ++d0) sc = MFMA32(*(LAS const bf16x8*)(kp + d0 * 32), qf[d0], sc);
#pragma unroll
                for (int i = 0; i < 16; ++i) key[16 * nb + i] = ((__float_as_uint(sc[i]) & ~0x7Fu) | h4) | (unsigned)(32 * nb + (i & 3) + 8 * (i >> 2));
            }
            bitonic_sort16_desc(key); bitonic_sort16_desc(key + 16); bitonic_sort16_desc(key + 32); bitonic_sort16_desc(key + 48);
            top16_of_two_desc(key, key + 16); top16_of_two_desc(key + 32, key + 48); top16_of_two_desc(key, key + 32);
            unsigned pk[16];
#pragma unroll
            for (int i = 0; i < 16; ++i) { const auto rr = __builtin_amdgcn_permlane32_swap(key[i], key[i], false, false); pk[i] = h ? (unsigned)rr[0] : (unsigned)rr[1]; }
            top16_of_two_desc(key, pk);
            if (h == 0) {
#pragma unroll
                for (int k = 0; k < 16; ++k) tvl[(c * 16 + k) * 32 + r] = key[k]; }
        }
        LDS_WAIT(); asm volatile("" ::: "memory");
        float t0[16], t1[16];
#pragma unroll
        for (int k = 0; k < 16; ++k) { t0[k] = __uint_as_float(tvl[k * 32 + r] & ~0x7Fu); t1[k] = __uint_as_float(tvl[(16 + k) * 32 + r] & ~0x7Fu); }
        unsigned cand[25];
        {
            int n = 0;
#pragma unroll
            for (int a = 0; a < 16; ++a)
#pragma unroll
                for (int b = 0; b < 16; ++b)
                    if ((a + 1) * (b + 1) <= 16) {
                        const unsigned key = (__float_as_uint(t0[a] + t1[b]) & ~0xFFu) | (unsigned)(a * 16 + b);
                        if ((n & 1) == 0) cand[n >> 1] = key; else cand[n >> 1] = h ? key : cand[n >> 1];
                        ++n;
                    }
        }
        unsigned w = 0u;
#pragma unroll
        for (int q = 0; q < 25; ++q) w = max(w, cand[q]);
        w = pair_umax(w);
#pragma unroll 1
        for (int k = 0; k < 16; ++k) {
            if (k > 0) { unsigned m = 0u;
#pragma unroll
                for (int q = 0; q < 25; ++q) m = max(m, cand[q] - w);
                w += pair_umax(m); }
            const int ia = (int)((w >> 4) & 15u), ib = (int)(w & 15u);
            const int e0 = (int)(tvl[ia * 32 + r] & 0x7Fu), e1 = (int)(tvl[(16 + ib) * 32 + r] & 0x7Fu);
            if (h == 0) { bsl[k * 32 + r] = __uint_as_float(w & ~0xFFu); bel[k * 32 + r] = e0 * 128 + e1; }
        }
        LDS_WAIT(); asm volatile("" ::: "memory");
        if (h == 0) {
            float bs[16]; int be[16];
#pragma unroll
            for (int k = 0; k < 16; ++k) { bs[k] = bsl[k * 32 + r]; be[k] = bel[k * 32 + r]; }
            const float* sp = P.SSP2 + tok * 16; const f32x4 p0 = *(const f32x4*)sp, p1 = *(const f32x4*)(sp + 4), p2 = *(const f32x4*)(sp + 8), p3 = *(const f32x4*)(sp + 12);
            const float rt = 1.0f / sqrtf((((p0.x + p0.y) + (p0.z + p0.w)) + ((p1.x + p1.y) + (p1.z + p1.w)) + ((p2.x + p2.y) + (p2.z + p2.w)) + ((p3.x + p3.y) + (p3.z + p3.w))) * (1.f / DM) + EPS);
            const float mx = bs[0]; float sum = 0.f;
#pragma unroll
            for (int k = 0; k < 16; ++k) { bs[k] = __expf((bs[k] - mx) * rt); sum += bs[k]; }
            const float inv = 1.0f / sum;
            int* ip = P.PIDX + tok * 128 + hd * 16; float* gp = P.PGATE + tok * 128 + hd * 16;
#pragma unroll
            for (int k4 = 0; k4 < 4; ++k4) {
                *(v4u*)(ip + 4 * k4) = (v4u){(unsigned)be[4 * k4], (unsigned)be[4 * k4 + 1], (unsigned)be[4 * k4 + 2], (unsigned)be[4 * k4 + 3]};
                *(f32x4*)(gp + 4 * k4) = (f32x4){bs[4 * k4] * inv, bs[4 * k4 + 1] * inv, bs[4 * k4 + 2] * inv, bs[4 * k4 + 3] * inv};
            }
        }
        LDS_WAIT(); asm volatile("" ::: "memory");
        }
    }
}

template <int CTRL> DI float dpp_mov(float v) { return __uint_as_float((unsigned)__builtin_amdgcn_update_dpp(0, (int)__float_as_uint(v), CTRL, 0xF, 0xF, true)); }
template <int CTRL> DI int dpp_movi(int v) { return __builtin_amdgcn_update_dpp(0, v, CTRL, 0xF, 0xF, true); }
DI int wave_sum_i(int v) {
    v += dpp_movi<0xB1>(v); v += dpp_movi<0x4E>(v); v += dpp_movi<0x141>(v); v += dpp_movi<0x140>(v);
    return (__builtin_amdgcn_readlane(v, 0) + __builtin_amdgcn_readlane(v, 16)) + (__builtin_amdgcn_readlane(v, 32) + __builtin_amdgcn_readlane(v, 48));
}
DI float wave_max_f(float v) {
    v = fmaxf(v, dpp_mov<0xB1>(v)); v = fmaxf(v, dpp_mov<0x4E>(v)); v = fmaxf(v, dpp_mov<0x141>(v)); v = fmaxf(v, dpp_mov<0x140>(v));
    return fmaxf(fmaxf(rlane(v, 0), rlane(v, 16)), fmaxf(rlane(v, 32), rlane(v, 48)));
}
DI float gelu_as(float v) {
    const float av = fabsf(v), t = __builtin_amdgcn_rcpf(av * 0.2316418882f + 1.0f);
    float q = t * 0.5307027145f + (-0.7265760135f); q = q * t + 0.7107068705f; q = q * t + (-0.142248368f); q = q * t + 0.127414796f; q = q * t;
    const float e = __builtin_amdgcn_exp2f((v * v) * (-0.72134752044f)), m = v * (q * e);
    return v < 0.f ? m : v - m;
}
DI int dot16_i8(const v4u& a, const v4u& b) {
    int c = __builtin_amdgcn_sdot4((int)a.x, (int)b.x, 0, false);
    c = __builtin_amdgcn_sdot4((int)a.y, (int)b.y, c, false); c = __builtin_amdgcn_sdot4((int)a.z, (int)b.z, c, false); c = __builtin_amdgcn_sdot4((int)a.w, (int)b.w, c, false);
    return c;
}
DI void axpy4_u8(float* acc, float a, unsigned u) {
    acc[0] += a * (float)(u & 0xffu); acc[1] += a * (float)((u >> 8) & 0xffu); acc[2] += a * (float)((u >> 16) & 0xffu); acc[3] += a * (float)(u >> 24);
}
DI unsigned quant4(float a, float b, float c, float d, float inv) {
    return ((unsigned)(int)__builtin_rintf(a * inv) & 0xffu) | (((unsigned)(int)__builtin_rintf(b * inv) & 0xffu) << 8) | (((unsigned)(int)__builtin_rintf(c * inv) & 0xffu) << 16) | (((unsigned)(int)__builtin_rintf(d * inv) & 0xffu) << 24);
}
typedef float f32x2 __attribute__((ext_vector_type(2)));
constexpr int PEER_SLICE_SHIFT = 7, PEER_NSLICE = NEXP >> PEER_SLICE_SHIFT;
constexpr int P12_WAVE_LDS = 8192 + 512;
DI void axpy16_fp4(f32x2* acc, float a, const v4u& rw) {
    const v2u uq = {rw.z, rw.w};
    const f32x2 aa = {a, a};
    f32x2 t[4];
    t[0] = __builtin_amdgcn_cvt_scalef32_pk_f32_fp4(uq.x, 1.0f, 0); t[1] = __builtin_amdgcn_cvt_scalef32_pk_f32_fp4(uq.x, 1.0f, 1); t[2] = __builtin_amdgcn_cvt_scalef32_pk_f32_fp4(uq.x, 1.0f, 2); t[3] = __builtin_amdgcn_cvt_scalef32_pk_f32_fp4(uq.x, 1.0f, 3);
    asm volatile("" : "+v"(t[0]), "+v"(t[1]), "+v"(t[2]), "+v"(t[3]));
#pragma unroll
    for (int j = 0; j < 4; ++j) acc[j] = __builtin_elementwise_fma(aa, t[j], acc[j]);
    t[0] = __builtin_amdgcn_cvt_scalef32_pk_f32_fp4(uq.y, 1.0f, 0); t[1] = __builtin_amdgcn_cvt_scalef32_pk_f32_fp4(uq.y, 1.0f, 1); t[2] = __builtin_amdgcn_cvt_scalef32_pk_f32_fp4(uq.y, 1.0f, 2); t[3] = __builtin_amdgcn_cvt_scalef32_pk_f32_fp4(uq.y, 1.0f, 3);
    asm volatile("" : "+v"(t[0]), "+v"(t[1]), "+v"(t[2]), "+v"(t[3]));
#pragma unroll
    for (int j = 0; j < 4; ++j) acc[4 + j] = __builtin_elementwise_fma(aa, t[j], acc[4 + j]);
}
DI int dot16_n4(const v4u& hq, const v4u& dq) {
    int c = __builtin_amdgcn_sdot4((int)hq.x, (int)((dq.x << 4) & 0xF0F0F0F0u), 0, false);
    c = __builtin_amdgcn_sdot4((int)hq.y, (int)(dq.x & 0xF0F0F0F0u), c, false);
    c = __builtin_amdgcn_sdot4((int)hq.z, (int)((dq.y << 4) & 0xF0F0F0F0u), c, false);
    c = __builtin_amdgcn_sdot4((int)hq.w, (int)(dq.y & 0xF0F0F0F0u), c, false);
    return c;
}
DI float reduce4_classes_f(float p0, float p1, float p2, float p3, bool b0, bool b1) {
    float x01 = b0 ? p1 : p0; const float y01 = b0 ? p0 : p1; x01 += dpp_mov<0xB1>(y01);
    float x23 = b0 ? p3 : p2; const float y23 = b0 ? p2 : p3; x23 += dpp_mov<0xB1>(y23);
    float w = b1 ? x23 : x01; const float w2 = b1 ? x01 : x23; w += dpp_mov<0x4E>(w2);
    w += dpp_mov<0x124>(w); w += dpp_mov<0x128>(w);
    { const auto r = __builtin_amdgcn_permlane16_swap(__float_as_uint(w), __float_as_uint(w), false, false); w = __uint_as_float(r[0]) + __uint_as_float(r[1]); }
    { const auto r = __builtin_amdgcn_permlane32_swap(__float_as_uint(w), __float_as_uint(w), false, false); w = __uint_as_float(r[0]) + __uint_as_float(r[1]); }
    return w;
}
template <int MODE>
DI void p12_peer_gather(const Ptrs& P, LAS unsigned char* lds, const float* obase, float* odst, int gw, int NGW, int wave, int lane) {
    LAS v4u* sorted = (LAS v4u*)(lds + wave * P12_WAVE_LDS); LAS unsigned* hist = (LAS unsigned*)(lds + wave * P12_WAVE_LDS + 8192);
    const bool b0 = (lane & 1) != 0, b1 = (lane & 2) != 0; const int cls = lane & 3;
    const int l16 = 16 * lane, l4 = 1024 + 4 * lane;
    const __amdgpu_buffer_rsrc_t rtab = __builtin_amdgcn_make_buffer_rsrc((void*)P.PDOWN, 0, NEXP * PEER_ROW_BYTES, 0x00020000);
    for (int tg = gw; tg < NTOK / 4; tg += NGW) {
        v4u hq[4]; f32x2 acc[4][8]; float asl[4]; float shv = 0.f;
#pragma unroll 1
        for (int u = 0; u < 4; ++u) {
            const size_t o = ((size_t)tg * 4 + u) * 128 + lane;
            const int i0 = P.PIDX[o], i1 = P.PIDX[o + 64];
            const float ga = P.PGATE[o], gb = P.PGATE[o + 64];
            hist[lane] = 0u; hist[64 + lane] = 0u;
            LDS_WAIT(); asm volatile("" ::: "memory");
            const unsigned r0 = __hip_atomic_fetch_add(&hist[i0 >> PEER_SLICE_SHIFT], 1u, __ATOMIC_RELAXED, __HIP_MEMORY_SCOPE_WORKGROUP);
            const unsigned r1 = __hip_atomic_fetch_add(&hist[i1 >> PEER_SLICE_SHIFT], 1u, __ATOMIC_RELAXED, __HIP_MEMORY_SCOPE_WORKGROUP);
            LDS_WAIT(); asm volatile("" ::: "memory");
            const unsigned c0 = hist[2 * lane], c1 = hist[2 * lane + 1]; unsigned incl = c0 + c1;
#pragma unroll
            for (int s2 = 1; s2 < 64; s2 <<= 1) { const unsigned t = __shfl_up(incl, s2); if (lane >= s2) incl += t; }
            const unsigned excl = incl - (c0 + c1);
            LDS_WAIT(); asm volatile("" ::: "memory");
            hist[2 * lane] = excl; hist[2 * lane + 1] = excl + c0;
            LDS_WAIT(); asm volatile("" ::: "memory");
            const unsigned p0 = hist[i0 >> PEER_SLICE_SHIFT] + r0, p1 = hist[i1 >> PEER_SLICE_SHIFT] + r1;
            sorted[u * 128 + p0] = (v4u){__float_as_uint(ga), 0u, (unsigned)i0, 0u};
            sorted[u * 128 + p1] = (v4u){__float_as_uint(gb), 0u, (unsigned)i1, 0u};
            LDS_WAIT(); asm volatile("" ::: "memory");
        }
#pragma unroll
        for (int u = 0; u < 4; ++u) { const size_t t = (size_t)tg * 4 + u;
            const v4u hb8 = *(const v4u*)(P.H8 + t * DM + 16 * lane);
            const float* sp = P.SSP2 + t * 16; const f32x4 p0 = *(const f32x4*)sp, p1 = *(const f32x4*)(sp + 4), p2 = *(const f32x4*)(sp + 8), p3 = *(const f32x4*)(sp + 12);
            const float rt = 1.0f / sqrtf((((p0.x + p0.y) + (p0.z + p0.w)) + ((p1.x + p1.y) + (p1.z + p1.w)) + ((p2.x + p2.y) + (p2.z + p2.w)) + ((p3.x + p3.y) + (p3.z + p3.w))) * (1.f / DM) + EPS);
            shv = (cls == u) ? P.SH[t] * (1.0f / 16.0f) * rt : shv;
            hq[u].x = __builtin_amdgcn_perm(hb8.y, hb8.x, 0x06040200u); hq[u].y = __builtin_amdgcn_perm(hb8.y, hb8.x, 0x07050301u);
            hq[u].z = __builtin_amdgcn_perm(hb8.w, hb8.z, 0x06040200u); hq[u].w = __builtin_amdgcn_perm(hb8.w, hb8.z, 0x07050301u);
            asl[u] = 0.f;
#pragma unroll
            for (int j = 0; j < 8; ++j) acc[u][j] = (f32x2){0.f, 0.f}; }
        v4u rwA[4], rwB[4]; unsigned scA[4], scB[4]; float gtA, gtB;
#define P12_FETCH(BI, RW, SC, GT) { GT = *(LAS const float*)((LAS const char*)sorted + (cls * 128 + (BI)) * 16); \
        _Pragma("unroll") for (int k = 0; k < 4; ++k) { const unsigned w0 = (unsigned)__builtin_amdgcn_readfirstlane((int)sorted[k * 128 + (BI)].z) & (MODE == 1 ? 63u : 0xffffffffu); \
        const int ro = (int)(w0 * (unsigned)PEER_ROW_BYTES);               \
        RW[k] = __builtin_bit_cast(v4u, __builtin_amdgcn_raw_buffer_load_b128(rtab, l16, ro, 0)); SC[k] = (unsigned)__builtin_amdgcn_raw_buffer_load_b32(rtab, l4, ro, 0); } }
#define P12_COMPUTE(RW, SC, GT) if (MODE == 2) { _Pragma("unroll") for (int k = 0; k < 4; ++k) { asl[k] += __uint_as_float((RW[k].x ^ RW[k].y) ^ (RW[k].z ^ RW[k].w) ^ SC[k]); } } else { \
        const float w_ = reduce4_classes_f((float)dot16_n4(hq[0], RW[0]) * bflo(SC[0]), (float)dot16_n4(hq[1], RW[1]) * bflo(SC[1]), \
                                           (float)dot16_n4(hq[2], RW[2]) * bflo(SC[2]), (float)dot16_n4(hq[3], RW[3]) * bflo(SC[3]), b0, b1); \
        const float a_ = gelu_as(w_ * shv) * GT; \
        axpy16_fp4(acc[0], dpp_mov<0x00>(a_) * bfhi(SC[0]), RW[0]); axpy16_fp4(acc[1], dpp_mov<0x55>(a_) * bfhi(SC[1]), RW[1]); \
        axpy16_fp4(acc[2], dpp_mov<0xAA>(a_) * bfhi(SC[2]), RW[2]); axpy16_fp4(acc[3], dpp_mov<0xFF>(a_) * bfhi(SC[3]), RW[3]); }
        P12_FETCH(0, rwA, scA, gtA)
#pragma unroll 1
        for (int bi = 0; bi < 128; bi += 2) {
            P12_FETCH(bi + 1, rwB, scB, gtB)
            P12_COMPUTE(rwA, scA, gtA)
            if (bi + 2 < 128) P12_FETCH(bi + 2, rwA, scA, gtA)
            P12_COMPUTE(rwB, scB, gtB)
        }
#undef P12_FETCH
#undef P12_COMPUTE
#pragma unroll
        for (int u = 0; u < 4; ++u) { const size_t t = (size_t)tg * 4 + u;
            float* op = odst + t * DM + 16 * lane;
            const v4u xa = *(const v4u*)(P.HN + t * DM + 16 * lane), xb = *(const v4u*)(P.HN + t * DM + 16 * lane + 8);
            const float pz = (MODE == 2) ? asl[u] * 1e-30f : 0.f;
            *(f32x4*)(op) = (f32x4){bflo(xa.x) + acc[u][0].x + pz, bfhi(xa.x) + acc[u][0].y, bflo(xa.y) + acc[u][1].x, bfhi(xa.y) + acc[u][1].y};
            *(f32x4*)(op + 4) = (f32x4){bflo(xa.z) + acc[u][2].x, bfhi(xa.z) + acc[u][2].y, bflo(xa.w) + acc[u][3].x, bfhi(xa.w) + acc[u][3].y};
            *(f32x4*)(op + 8) = (f32x4){bflo(xb.x) + acc[u][4].x, bfhi(xb.x) + acc[u][4].y, bflo(xb.y) + acc[u][5].x, bfhi(xb.y) + acc[u][5].y};
            *(f32x4*)(op + 12) = (f32x4){bflo(xb.z) + acc[u][6].x, bfhi(xb.z) + acc[u][6].y, bflo(xb.w) + acc[u][7].x, bfhi(xb.w) + acc[u][7].y}; }
    }
}

struct Args { const float* in[25]; float* out; unsigned char* ws; int ph_lo, ph_hi; };
__global__ void __launch_bounds__(NTHR, 2) layer_fwd(Args args) {
    extern __shared__ __attribute__((aligned(16))) unsigned char lds_raw[];
    LAS unsigned char* lds = (LAS unsigned char*)lds_raw;
    const int tid = threadIdx.x, lane = tid & 63, wave = __builtin_amdgcn_readfirstlane(tid >> 6);
    const int G = gridDim.x; const int bx = blockIdx.x;
    const int vcu = (G % 8 == 0) ? (bx % 8) * (G / 8) + bx / 8 : bx;
    const int gw = vcu * NWAVES + wave, NGW = G * NWAVES;
    unsigned char* ws = args.ws;
    Ptrs P;
    P.x = args.in[0]; P.mem = args.in[1]; P.mix_norm_w = args.in[2]; P.w_in = args.in[3]; P.conv_w = args.in[4]; P.conv_b = args.in[5]; P.cmp_pe = args.in[6];
    P.cmp_w1 = args.in[7]; P.cmp_w2 = args.in[8]; P.q_norm_w = args.in[9]; P.k_norm_w = args.in[10]; P.w_out = args.in[11]; P.xattn_norm_w = args.in[12];
    P.mem_norm_w = args.in[13]; P.xq = args.in[14]; P.xk = args.in[15]; P.xv = args.in[16]; P.xo = args.in[17]; P.xq_norm_w = args.in[18]; P.xk_norm_w = args.in[19];
    P.ffn_norm_w = args.in[20]; P.peer_wq = args.in[21]; P.peer_keys = args.in[22]; P.peer_down = args.in[23]; P.peer_up = args.in[24];
    P.out = args.out;
    P.WIN = (bf16*)(ws + WS_WIN); P.WOUT = (bf16*)(ws + WS_WOUT); P.XQT = (bf16*)(ws + WS_XQT); P.XKVT = (bf16*)(ws + WS_XKVT); P.XOT = (bf16*)(ws + WS_XOT);
    P.PWQT = (bf16*)(ws + WS_PWQT); P.PKEYS = (bf16*)(ws + WS_PKEYS); P.KCMP = (bf16*)(ws + WS_KCMP); P.VCMP = (bf16*)(ws + WS_VCMP); P.MN = (bf16*)(ws + WS_MN);
    P.XKV = (bf16*)(ws + WS_XKV); P.PDOWN = ws + WS_PDOWN; P.PUP = ws + WS_PUP; P.PSC = (float*)(ws + WS_PSC); P.CW1T = (bf16*)(ws + WS_CW1T); P.SSP1 = (float*)(ws + WS_SSP1); P.SSP2 = (float*)(ws + WS_SSP2); P.SA1 = (float*)(ws + WS_SA1); P.SB1 = (float*)(ws + WS_SB1); P.CMX = (float*)(ws + WS_CMX); P.HN8 = ws + WS_HN; P.WIN8 = ws + WS_WIN; P.H8 = ws + WS_PUP; P.PWQ8 = ws + WS_PWQT; P.SH = (float*)(ws + WS_SH); P.SBQ = (float*)(ws + WS_SBQ); P.CMXQ = (float*)(ws + WS_CMXQ); P.HN = (bf16*)(ws + WS_HN); P.YMIX = (bf16*)(ws + WS_YMIX);
    P.PROJ = (bf16*)(ws + WS_PROJ); P.XQ = (bf16*)(ws + WS_XQ); P.PQ = (bf16*)(ws + WS_PQ); P.B1P = (float*)(ws + WS_B1P); P.PGATE = (float*)(ws + WS_PGATE); P.PIDX = (int*)(ws + WS_PIDX);

    volatile LAS unsigned* MISC = (volatile LAS unsigned*)(lds + MISC_OFF);
    if (tid < 64) MISC[tid] = 0u;
    __syncthreads();
    const int lo = args.ph_lo, hi = args.ph_hi;
    const bool multi = (hi - lo) > 1;
    XcdBarrier bar; bar.bar = (unsigned*)(ws + WS_CTL) + CW_BAR; bar.x = 0; bar.st = MISC + 8;
    if (multi) bar = xcd_barrier_post((unsigned*)(ws + WS_CTL) + CW_BAR, MISC + 8);
#ifndef ONLY_PHASE
#define ONLY_PHASE -1
#endif
#define IN(k) ((ONLY_PHASE < 0 || (k) == ONLY_PHASE) && lo <= (k) && (k) < hi)
#define SEAM(k) do { if (IN(k) && IN((k) + 1)) xcd_barrier(bar); } while (0)

#ifndef REPMASK
#define REPMASK 0
#endif
#ifndef P12_PROBE_MODE
#define P12_PROBE_MODE 0
#endif
#ifndef P3_PROBE_MODE
#define P3_PROBE_MODE 0
#endif
#ifndef P0_PROBE_MASK
#define P0_PROBE_MASK 7
#endif
#define NREP(k) (((REPMASK) >> (k)) & 1 ? 2 : 1)
    float* const dummy = (float*)(ws + WS_PROJ);
    if (IN(0)) { for (int rep = 0; rep < NREP(0); ++rep) { const int pm = (rep + 1 < NREP(0)) ? P0_PROBE_MASK : 7; p0_prologue(P, lds, gw, NGW, wave, lane, 0, pm); if (multi && pm == 7) xcd_barrier(bar); p0_prologue(P, lds, gw, NGW, wave, lane, 1, pm); } } SEAM(0);
    if (IN(1)) { for (int rep = 0; rep < NREP(1); ++rep) {
        { pg8::Gemm g{(const bf16*)P.HN8, (const bf16*)P.WIN8, NTOK, INP, DM / 2}; pg8::ProjOrder S; S.init(NTOK, G, vcu);
          pg8::EpiI8Bf16 E{P.PROJ, INP, P.SA1, P.SB1};
          pg8::gemm_phase<pg8::EpiI8Bf16, pg8::ProjOrder, true, true, true>(lds, g, S, E); }
 }
        asm volatile("s_waitcnt vmcnt(0)" ::: "memory"); __syncthreads();
        for (int mt = vcu >> 1; mt < NTOK / 256; mt += G >> 1) { proj_post_conv(P, mt, (vcu & 1) * 256, wave, lane); if (vcu & 1) proj_post_knorm(P, mt, wave, lane); }
    } SEAM(1);
    if (IN(2)) { for (int rep = 0; rep < NREP(2); ++rep) p2_misc(P, lds, vcu, G, tid, wave, lane, rep == 0); } SEAM(2);
    if (IN(3)) { xk_norm(P, gw, NGW, lane); for (int rep = 0; rep < NREP(3); ++rep) { if (rep + 1 < NREP(3)) p3_nsa<P3_PROBE_MODE>(P, lds, vcu, G, tid, wave, lane); else p3_nsa<0>(P, lds, vcu, G, tid, wave, lane); } } SEAM(3);
    if (IN(4)) { for (int rep = 0; rep < NREP(4); ++rep) { pg8::Gemm g{P.YMIX, P.WOUT, NTOK, DM, DM}; pg8::StaticOrder S; S.init(NTOK, DM, G, bx);
        pg8::EpiResBf16N<false> E{P.x, P.HN, P.SSP1, DM};
        pg8::gemm_phase<pg8::EpiResBf16N<false>, pg8::StaticOrder, true, true>(lds, g, S, E); } } SEAM(4);
    if (IN(6)) { for (int rep = 0; rep < NREP(6); ++rep) { pg8::Gemm g{P.HN, P.XQT, NTOK, DM, DM}; pg8::StaticOrder S; S.init(NTOK, DM, G, bx);
        pg8::EpiBf16<0> E{P.XQ, DM, nullptr, 0, 0, 1.f};
        pg8::gemm_phase<pg8::EpiBf16<0>, pg8::StaticOrder, true, true>(lds, g, S, E); }
        asm volatile("s_waitcnt vmcnt(0)" ::: "memory"); __syncthreads();
        for (int rep = 0; rep < NREP(7); ++rep) p7_xattn(P, lds, bx, G, tid, wave, lane); } SEAM(7);
    if (IN(8)) { for (int rep = 0; rep < NREP(8); ++rep) { pg8::Gemm g{P.YMIX, P.XOT, NTOK, DM, DM}; pg8::StaticOrder S; S.init(NTOK, DM, G, bx);
        pg8::EpiResBf16N<true> E{P.HN, (rep + 1 < NREP(8)) ? (bf16*)dummy : P.HN, P.SSP2, DM};
        pg8::gemm_phase<pg8::EpiResBf16N<true>, pg8::StaticOrder, true, true>(lds, g, S, E); } } SEAM(8);
    if (IN(9)) { for (int rep = 0; rep < NREP(9); ++rep) p9_quant_h(P, gw, NGW, lane); } SEAM(9);
    if (IN(10)) { for (int rep = 0; rep < NREP(10); ++rep) { pg8::Gemm g{(const bf16*)P.H8, (const bf16*)P.PWQ8, NTOK, 2048, DM / 2}; pg8::StaticOrder S; S.init(NTOK, 2048, G, bx);
        pg8::EpiI8Bf16 E{P.PQ, 2048, P.SH, P.SBQ};
        pg8::gemm_phase<pg8::EpiI8Bf16, pg8::StaticOrder, true, true, true>(lds, g, S, E); }
        asm volatile("s_waitcnt vmcnt(0)" ::: "memory"); __syncthreads();
        for (int rep = 0; rep < NREP(11); ++rep) p11_peer_topk(P, lds, bx, G, tid, wave, lane); } SEAM(11);
    if (IN(12)) { for (int rep = 0; rep < NREP(12); ++rep) if (rep + 1 < NREP(12)) p12_peer_gather<P12_PROBE_MODE>(P, lds, P.out, dummy, gw, NGW, wave, lane); else p12_peer_gather<0>(P, lds, P.out, P.out, gw, NGW, wave, lane); }
#undef IN
#undef SEAM
}

#ifndef MK_PER_PHASE
#define MK_PER_PHASE 0
#endif
extern "C" void kernel_launch(void* const* d_in, const int* in_sizes, int n_in, void* d_out, int out_size, void* d_ws, size_t ws_size, hipStream_t stream) {
    static int grid = 0;
    if (grid == 0) {
        if (n_in != 25 || in_sizes[0] != NTOK * DM || out_size != NTOK * DM || ws_size < WS_END) {
            fprintf(stderr, "kernel_launch: unexpected shapes (n_in %d, in0 %d, out %d, ws %zu); nothing launched\n", n_in, n_in > 0 ? in_sizes[0] : -1, out_size, ws_size); grid = -1; return; }
        int dev = 0, cus = 0, per_cu = 0;
        if (hipGetDevice(&dev) != hipSuccess || hipDeviceGetAttribute(&cus, hipDeviceAttributeMultiprocessorCount, dev) != hipSuccess) { grid = -1; return; }
        if (hipFuncSetAttribute((const void*)layer_fwd, hipFuncAttributeMaxDynamicSharedMemorySize, LDS_BYTES) != hipSuccess) { fprintf(stderr, "kernel_launch: hipFuncSetAttribute failed\n"); grid = -1; return; }
        if (hipOccupancyMaxActiveBlocksPerMultiprocessor(&per_cu, (const void*)layer_fwd, NTHR, LDS_BYTES) != hipSuccess || per_cu < 1)
            fprintf(stderr, "kernel_launch: note: occupancy query reports %d workgroups per CU\n", per_cu);
        (void)hipGetLastError();
        grid = cus;
        if (grid != 256) fprintf(stderr, "kernel_launch: note: %d CUs\n", grid);
    }
    if (grid < 0) return;
    if (hipMemsetAsync((char*)d_ws + WS_CTL, 0, CTL_ZERO_BYTES, stream) != hipSuccess) return;
    Args a{};
    for (int i = 0; i < 25; ++i) a.in[i] = (const float*)d_in[i];
    a.out = (float*)d_out; a.ws = (unsigned char*)d_ws;
#if MK_PER_PHASE
    for (int p = 0; p < NPHASE; ++p) { a.ph_lo = p; a.ph_hi = p + 1; hipLaunchKernelGGL(layer_fwd, dim3(grid), dim3(NTHR), LDS_BYTES, stream, a); }
#else
    a.ph_lo = 0; a.ph_hi = NPHASE; hipLaunchKernelGGL(layer_fwd, dim3(grid), dim3(NTHR), LDS_BYTES, stream, a);
#endif
}
```

```cpp
#include <hip/hip_runtime.h>
#include <cstdio>
#include <cstdint>
#include <cmath>
namespace pg8 {
#define PG8_LAS __attribute__((address_space(3)))
typedef unsigned short bf16_t;
typedef short bf16x8 __attribute__((ext_vector_type(8)));
typedef float f32x4 __attribute__((ext_vector_type(4)));
typedef unsigned u32x4 __attribute__((ext_vector_type(4)));
constexpr int BM = 256, BK = 64, HALF = 128, HTB = HALF * BK * 2  , STAGE_BYTES = 8 * HTB, NXCD = 8, WGM = 8;

__host__ __device__ __forceinline__ int lds_byte(int r, int c) { const int st = (r >> 4) * 2 + (c >> 5), rr = r & 15, cc = c & 31, ob = rr * 64 + cc * 2; return st * 1024 + (ob ^ (((ob >> 9) & 1) << 5)); }
__host__ __device__ __forceinline__ void stage_rc(int b, int& R, int& C) { const int st = b / 1024, sb = b % 1024, swz = sb ^ (((sb >> 9) & 1) << 5); R = (st >> 1) * 16 + swz / 64; C = (st & 1) * 32 + (swz % 64) / 2; }
__host__ __device__ __forceinline__ int perm32(int rho) { const int n = rho >> 4, i = rho & 15; return 8 * (i >> 2) + 4 * n + (i & 3); }

struct Unit { int pm, pn; };
struct Gemm { const bf16_t* A; const bf16_t* Bt; int M, N, K; };

struct StaticOrder {
    int nM, nN, nwg, G, c;
    __host__ __device__ void init(int M, int N, int G_, int c_) { nM = M / BM; nN = N / BM; nwg = nM * nN; G = G_; c = c_; }
    __host__ __device__ bool next(int i, Unit& u) const {
        const long L = (long)i * G + c; if (L >= nwg) return false;
        int wgid = (int)L; { const int q = nwg / NXCD, r = nwg % NXCD, xcd = wgid % NXCD, off = wgid / NXCD; wgid = (xcd < r ? xcd * (q + 1) : r * (q + 1) + (xcd - r) * q) + off; }
        const int nig = WGM * nN, gid = wgid / nig, fm = gid * WGM, gsz = (nM - fm) < WGM ? (nM - fm) : WGM;
        u.pm = fm + ((wgid % nig) % gsz); u.pn = (wgid % nig) / gsz; return true;
    }
    __device__ __forceinline__ void a_ready(const Unit&) const {}
    __device__ __forceinline__ void done(const Unit&) const {}
};

struct ProjOrder {
    int nM, G, v;
    __host__ __device__ void init(int M, int G_, int v_) { nM = M / BM; G = G_; v = v_; }
    __host__ __device__ bool next(int i, Unit& u) const {
        const int round = i / 6, k = i - 6 * round, mt = (v >> 1) + round * (G >> 1);
        if (mt >= nM) return false;
        u.pm = mt; u.pn = k < 3 ? 2 * k + (v & 1) : (v & 1) * 3 + 3 + k; return true;
    }
    __device__ __forceinline__ void a_ready(const Unit&) const {}
    __device__ __forceinline__ void done(const Unit&) const {}
};

__device__ __forceinline__ unsigned cvt_pk_bf16(float lo, float hi) { unsigned r; asm volatile("v_cvt_pk_bf16_f32 %0, %1, %2" : "=v"(r) : "v"(lo), "v"(hi)); return r; }
typedef float f32x2 __attribute__((ext_vector_type(2)));
__device__ __forceinline__ f32x2 gelu_pk(f32x2 v) {
    const f32x2 av = __builtin_elementwise_abs(v), d = av * 0.2316418882f + 1.0f;
    f32x2 t; t.x = __builtin_amdgcn_rcpf(d.x); t.y = __builtin_amdgcn_rcpf(d.y);
    f32x2 q = t * 0.5307027145f + (-0.7265760135f); q = q * t + 0.7107068705f; q = q * t + (-0.142248368f); q = q * t + 0.127414796f; q = q * t;
    const f32x2 s = (v * v) * (-0.72134752044f);
    f32x2 e; e.x = __builtin_amdgcn_exp2f(s.x); e.y = __builtin_amdgcn_exp2f(s.y);
    const f32x2 m = v * (q * e), r = v - m;
    f32x2 o; o.x = v.x < 0.f ? m.x : r.x; o.y = v.y < 0.f ? m.y : r.y; return o;
}

template <int ACT  > struct EpiBf16 {
    static constexpr bool PERM = true, AFTER_DRAIN = false; static_assert(ACT == 0 || ACT == 1, "EpiBf16: ACT is 0 (none) or 1 (gelu_pk)");
    bf16_t* O; int ldc; const float* bias; int split_cols; size_t split_stride; float scale0;
    __device__ __forceinline__ void operator()(const f32x4 (&acc)[2][2][4][2], const Unit& u, int wr, int wc, int fr, int fq) const {
        const int row0 = u.pm * BM + wr * 64 + fr; int colt = u.pn * BM; bf16_t* base = O;
        float sc = 1.f; if (split_cols) { const int t = colt / split_cols; base += (size_t)t * split_stride; colt -= t * split_cols; if (t == 0) sc = scale0; }
        const int col0 = colt + wc * 32 + 8 * fq, bcol0 = u.pn * BM + wc * 32 + 8 * fq;
        f32x4 bv[2][2];
#pragma unroll
        for (int bj = 0; bj < 2; ++bj)
#pragma unroll
            for (int n = 0; n < 2; ++n) bv[bj][n] = bias ? *(const f32x4*)(bias + bcol0 + bj * HALF + 4 * n) : (f32x4){0.f, 0.f, 0.f, 0.f};
#pragma unroll
        for (int ai = 0; ai < 2; ++ai)
#pragma unroll
            for (int m = 0; m < 4; ++m) { bf16_t* rowp = base + (size_t)(row0 + ai * HALF + m * 16) * ldc + col0;
#pragma unroll
                for (int bj = 0; bj < 2; ++bj) { f32x4 v0 = acc[ai][bj][m][0] + bv[bj][0], v1 = acc[ai][bj][m][1] + bv[bj][1];
                    if (ACT == 1) { f32x2 a = gelu_pk((f32x2){v0[0], v0[1]}), b = gelu_pk((f32x2){v0[2], v0[3]}), c = gelu_pk((f32x2){v1[0], v1[1]}), d = gelu_pk((f32x2){v1[2], v1[3]});
                        v0 = (f32x4){a.x, a.y, b.x, b.y}; v1 = (f32x4){c.x, c.y, d.x, d.y}; }
                    v0 = v0 * sc; v1 = v1 * sc; u32x4 w; w.x = cvt_pk_bf16(v0[0], v0[1]); w.y = cvt_pk_bf16(v0[2], v0[3]); w.z = cvt_pk_bf16(v1[0], v1[1]); w.w = cvt_pk_bf16(v1[2], v1[3]);
                    *(u32x4*)(rowp + bj * HALF) = w; } }
    }
};

struct EpiResF32 {
    static constexpr bool PERM = false, AFTER_DRAIN = false;
    const float* base; float* out; int ldc;
    __device__ __forceinline__ void operator()(const f32x4 (&acc)[2][2][4][2], const Unit& u, int wr, int wc, int fr, int fq) const {
        const int row0 = u.pm * BM + wr * 64 + fr, col0 = u.pn * BM + wc * 32 + 4 * fq;
#pragma unroll
        for (int ai = 0; ai < 2; ++ai)
#pragma unroll
            for (int m = 0; m < 4; ++m) { const size_t off = (size_t)(row0 + ai * HALF + m * 16) * ldc + col0;
#pragma unroll
                for (int bj = 0; bj < 2; ++bj)
#pragma unroll
                    for (int n = 0; n < 2; ++n) { const f32x4 b = *(const f32x4*)(base + off + bj * HALF + n * 16); *(f32x4*)(out + off + bj * HALF + n * 16) = b + acc[ai][bj][m][n]; } }
    }
};
template <bool BASE_BF16> struct EpiResBf16N {
    static constexpr bool PERM = false, AFTER_DRAIN = false;
    const void* base; bf16_t* xn; float* ssp; int ldc;
    __device__ __forceinline__ void operator()(const f32x4 (&acc)[2][2][4][2], const Unit& u, int wr, int wc, int fr, int fq) const {
        typedef unsigned u32x2 __attribute__((ext_vector_type(2)));
        const int row0 = u.pm * BM + wr * 64 + fr, col0 = u.pn * BM + wc * 32 + 4 * fq;
#pragma unroll
        for (int ai = 0; ai < 2; ++ai)
#pragma unroll
            for (int m = 0; m < 4; ++m) { const int row = row0 + ai * HALF + m * 16; const size_t off = (size_t)row * ldc + col0; float ss = 0.f;
#pragma unroll
                for (int bj = 0; bj < 2; ++bj)
#pragma unroll
                    for (int n = 0; n < 2; ++n) { f32x4 b;
                        if (BASE_BF16) { const u32x2 r = *(const u32x2*)((const bf16_t*)base + off + bj * HALF + n * 16);
                            b = (f32x4){__uint_as_float(r.x << 16), __uint_as_float(r.x & 0xffff0000u), __uint_as_float(r.y << 16), __uint_as_float(r.y & 0xffff0000u)}; }
                        else b = *(const f32x4*)((const float*)base + off + bj * HALF + n * 16);
                        const f32x4 v = b + acc[ai][bj][m][n];
                        ss += (v[0] * v[0] + v[1] * v[1]) + (v[2] * v[2] + v[3] * v[3]);
                        u32x2 w; w.x = cvt_pk_bf16(v[0], v[1]); w.y = cvt_pk_bf16(v[2], v[3]); *(u32x2*)(xn + off + bj * HALF + n * 16) = w; }
                ss += __shfl_xor(ss, 16); ss += __shfl_xor(ss, 32);
                if (fq == 0) ssp[(size_t)row * 16 + u.pn * 4 + wc] = ss; }
    }
};
struct EpiI8Bf16 {
    static constexpr bool PERM = true, AFTER_DRAIN = false;
    bf16_t* O; int ldc; const float* sa; const float* sb;
    __device__ __forceinline__ void operator()(const f32x4 (&acc)[2][2][4][2], const Unit& u, int wr, int wc, int fr, int fq) const {
        typedef int i32x4 __attribute__((ext_vector_type(4)));
        const int row0 = u.pm * BM + wr * 64 + fr, col0 = u.pn * BM + wc * 32 + 8 * fq;
        f32x4 sbv[2][2];
#pragma unroll
        for (int bj = 0; bj < 2; ++bj)
#pragma unroll
            for (int n = 0; n < 2; ++n) sbv[bj][n] = *(const f32x4*)(sb + col0 + bj * HALF + 4 * n);
#pragma unroll
        for (int ai = 0; ai < 2; ++ai)
#pragma unroll
            for (int m = 0; m < 4; ++m) { const int row = row0 + ai * HALF + m * 16; const float sr = sa[row]; bf16_t* rowp = O + (size_t)row * ldc + col0;
#pragma unroll
                for (int bj = 0; bj < 2; ++bj) {
                    const f32x4 v0 = __builtin_convertvector(__builtin_bit_cast(i32x4, acc[ai][bj][m][0]), f32x4) * sr * sbv[bj][0];
                    const f32x4 v1 = __builtin_convertvector(__builtin_bit_cast(i32x4, acc[ai][bj][m][1]), f32x4) * sr * sbv[bj][1];
                    u32x4 w; w.x = cvt_pk_bf16(v0[0], v0[1]); w.y = cvt_pk_bf16(v0[2], v0[3]); w.z = cvt_pk_bf16(v1[0], v1[1]); w.w = cvt_pk_bf16(v1[2], v1[3]);
                    *(u32x4*)(rowp + bj * HALF) = w; } }
    }
};

template <class Epi, class Sched, bool ALIGN_EPI = false, bool SP2 = false, bool I8 = false>
__device__ __forceinline__ void gemm_phase(PG8_LAS unsigned char* lds, const Gemm g, const Sched& S, const Epi& E) {
    const int tid = threadIdx.x, wid = __builtin_amdgcn_readfirstlane(tid >> 6), lane = tid & 63, wr = wid >> 2, wc = wid & 3, fr = lane & 15, fq = lane >> 4;
    const int K = g.K, nt = K / BK;
    unsigned voffA[2], voffB[2];
#pragma unroll
    for (int i = 0; i < 2; ++i) { int R, C; stage_rc(tid * 16 + i * 8192, R, C); const int Rb = Epi::PERM ? ((R & ~31) + perm32(R & 31)) : R;
        voffA[i] = (unsigned)(R * K + C) * 2u; voffB[i] = (unsigned)(Rb * K + C) * 2u; }
    const size_t kstep = (size_t)(BK * 2);
    const size_t hstep = (size_t)HALF * K * 2;
    const size_t tstep = 2 * hstep;
    const unsigned ldsw = (unsigned)wid * 1024u;
    const int aoff = lds_byte(wr * 64 + fr, fq * 8), boff = lds_byte(wc * 32 + fr, fq * 8);
    typedef int i32x4 __attribute__((ext_vector_type(4)));
    auto mma16 = [](const bf16x8& b, const bf16x8& a, const f32x4& c) __attribute__((always_inline)) -> f32x4 {
        if constexpr (I8) return __builtin_bit_cast(f32x4, __builtin_amdgcn_mfma_i32_16x16x64_i8(__builtin_bit_cast(i32x4, b), __builtin_bit_cast(i32x4, a), __builtin_bit_cast(i32x4, c), 0, 0, 0));
        else return __builtin_amdgcn_mfma_f32_16x16x32_bf16(b, a, c, 0, 0, 0);
    };
#define PG8_SA(b, h) (((b) * 2 + (h)) * HTB)
#define PG8_SB(b, h) ((4 + (b) * 2 + (h)) * HTB)
#define PG8_STAGE(bufoff, gbase, voff) do { _Pragma("unroll") for (int _i = 0; _i < 2; ++_i) \
        __builtin_amdgcn_global_load_lds((const unsigned*)((const char*)(gbase) + (voff)[_i]), (PG8_LAS unsigned*)(lds + (bufoff) + ldsw + _i * 8192), 16, 0, 0); } while (0)
#define PG8_LDA(dst, b, h) do { _Pragma("unroll") for (int m = 0; m < 4; ++m) _Pragma("unroll") for (int k = 0; k < 2; ++k) dst[m][k] = *(const PG8_LAS bf16x8*)(lds + PG8_SA(b, h) + aoff + m * 2048 + k * 1024); } while (0)
#define PG8_LDB(dst, b, h) do { _Pragma("unroll") for (int n = 0; n < 2; ++n) _Pragma("unroll") for (int k = 0; k < 2; ++k) dst[n][k] = *(const PG8_LAS bf16x8*)(lds + PG8_SB(b, h) + boff + n * 2048 + k * 1024); } while (0)
#define PG8_MMA(ai, bj, At, Bt) do { __builtin_amdgcn_s_setprio(1); _Pragma("unroll") for (int m = 0; m < 4; ++m) _Pragma("unroll") for (int n = 0; n < 2; ++n) _Pragma("unroll") for (int k = 0; k < 2; ++k) \
        acc[ai][bj][m][n] = mma16(Bt[n][k], At[m][k], acc[ai][bj][m][n]); __builtin_amdgcn_s_setprio(0); } while (0)
#define PG8_WAIT_V(n) asm volatile("s_waitcnt vmcnt(" #n ")" ::: "memory")
#define PG8_WAIT_L(n) asm volatile("s_waitcnt lgkmcnt(" #n ")" ::: "memory")
#define PG8_BAR __builtin_amdgcn_s_barrier()
#define PG8_SCHED __builtin_amdgcn_sched_barrier(0)
    Unit cur, nxt; int ui = 0;
    if (!S.next(0, cur)) return;
    f32x4 acc[2][2][4][2];
#pragma unroll
    for (int a = 0; a < 2; ++a)
#pragma unroll
        for (int b = 0; b < 2; ++b)
#pragma unroll
            for (int m = 0; m < 4; ++m)
#pragma unroll
                for (int n = 0; n < 2; ++n) acc[a][b][m][n] = (f32x4){0.f, 0.f, 0.f, 0.f};
    bf16x8 At[4][2], B0[2][2], B1[2][2];
    const char* cA = (const char*)g.A + (size_t)cur.pm * tstep; const char* cB = (const char*)g.Bt + (size_t)cur.pn * tstep;
    S.a_ready(cur);
    if constexpr (SP2) {
        PG8_STAGE(PG8_SB(0, 0), cB, voffB); PG8_STAGE(PG8_SB(0, 1), cB + hstep, voffB); PG8_STAGE(PG8_SA(0, 0), cA, voffA); PG8_STAGE(PG8_SA(0, 1), cA + hstep, voffA);
        if (wr == 1) PG8_BAR;
        PG8_WAIT_V(2); PG8_BAR;
        PG8_STAGE(PG8_SB(1, 0), cB + kstep, voffB); PG8_STAGE(PG8_SA(1, 0), cA + kstep, voffA); PG8_STAGE(PG8_SB(1, 1), cB + hstep + kstep, voffB);
        PG8_WAIT_V(6); PG8_BAR;
    } else {
        PG8_STAGE(PG8_SB(0, 0), cB, voffB); PG8_STAGE(PG8_SA(0, 0), cA, voffA); PG8_STAGE(PG8_SB(0, 1), cB + hstep, voffB); PG8_STAGE(PG8_SA(0, 1), cA + hstep, voffA);
        if (wr == 1) PG8_BAR;
        PG8_WAIT_V(4); PG8_BAR;
        PG8_STAGE(PG8_SB(1, 0), cB + kstep, voffB); PG8_STAGE(PG8_SA(1, 0), cA + kstep, voffA); PG8_STAGE(PG8_SB(1, 1), cB + hstep + kstep, voffB);
        PG8_WAIT_V(6); PG8_BAR;
    }
    for (;;) {
        const bool has_next = S.next(ui + 1, nxt);
        const char* nA = has_next ? (const char*)g.A + (size_t)nxt.pm * tstep : cA; const char* nB = has_next ? (const char*)g.Bt + (size_t)nxt.pn * tstep : cB;
        for (int t = 0; t < nt; t += 2) {
            const bool last = (t == nt - 2);
            const char* a1 = cA + (size_t)(t + 1) * kstep;
            const char* a2 = last ? nA : cA + (size_t)(t + 2) * kstep; const char* b2 = last ? nB : cB + (size_t)(t + 2) * kstep;
            const char* a3 = a2 + kstep; const char* b3 = b2 + kstep;
            if (last && has_next) S.a_ready(nxt);
            if constexpr (SP2) {
            PG8_LDB(B0, 0, 0); PG8_LDB(B1, 0, 1); PG8_SCHED; PG8_LDA(At, 0, 0); PG8_STAGE(PG8_SA(1, 1), a1 + hstep, voffA);
            PG8_WAIT_V(8); PG8_WAIT_L(0); PG8_BAR; PG8_MMA(0, 0, At, B0); PG8_MMA(0, 1, At, B1); PG8_BAR; PG8_SCHED;
            PG8_LDA(At, 0, 1); PG8_STAGE(PG8_SB(0, 0), b2, voffB); PG8_STAGE(PG8_SB(0, 1), b2 + hstep, voffB); PG8_STAGE(PG8_SA(0, 0), a2, voffA);
            PG8_WAIT_V(8); PG8_WAIT_L(0); PG8_BAR; PG8_MMA(1, 0, At, B0); PG8_MMA(1, 1, At, B1); PG8_BAR; PG8_SCHED;
            PG8_LDB(B0, 1, 0); PG8_LDB(B1, 1, 1); PG8_SCHED; PG8_LDA(At, 1, 0); PG8_STAGE(PG8_SA(0, 1), a2 + hstep, voffA);
            PG8_WAIT_V(8); PG8_WAIT_L(0); PG8_BAR; PG8_MMA(0, 0, At, B0); PG8_MMA(0, 1, At, B1); PG8_BAR; PG8_SCHED;
            PG8_LDA(At, 1, 1); PG8_STAGE(PG8_SB(1, 0), b3, voffB); PG8_STAGE(PG8_SB(1, 1), b3 + hstep, voffB); PG8_STAGE(PG8_SA(1, 0), a3, voffA);
            PG8_WAIT_V(8); PG8_WAIT_L(0); PG8_BAR; PG8_MMA(1, 0, At, B0); PG8_MMA(1, 1, At, B1); PG8_BAR; PG8_SCHED;
            } else {
            PG8_LDB(B0, 0, 0); PG8_SCHED; PG8_LDA(At, 0, 0); PG8_STAGE(PG8_SA(1, 1), a1 + hstep, voffA);
            PG8_WAIT_L(8); PG8_BAR; PG8_WAIT_L(0); PG8_MMA(0, 0, At, B0); PG8_BAR; PG8_SCHED;
            PG8_LDB(B1, 0, 1); PG8_STAGE(PG8_SB(0, 0), b2, voffB);
            PG8_BAR; PG8_WAIT_L(0); PG8_MMA(0, 1, At, B1); PG8_BAR;
            PG8_LDA(At, 0, 1); PG8_STAGE(PG8_SA(0, 0), a2, voffA);
            PG8_BAR; PG8_WAIT_L(0); PG8_MMA(1, 0, At, B0); PG8_BAR; PG8_SCHED;
            PG8_STAGE(PG8_SB(0, 1), b2 + hstep, voffB);
            PG8_WAIT_V(6); PG8_BAR; PG8_MMA(1, 1, At, B1); PG8_BAR;
            PG8_LDB(B0, 1, 0); PG8_SCHED; PG8_LDA(At, 1, 0); PG8_STAGE(PG8_SA(0, 1), a2 + hstep, voffA);
            PG8_WAIT_L(8); PG8_BAR; PG8_WAIT_L(0); PG8_MMA(0, 0, At, B0); PG8_BAR; PG8_SCHED;
            PG8_LDB(B1, 1, 1); PG8_STAGE(PG8_SB(1, 0), b3, voffB);
            PG8_BAR; PG8_WAIT_L(0); PG8_MMA(0, 1, At, B1); PG8_BAR;
            PG8_LDA(At, 1, 1); PG8_STAGE(PG8_SA(1, 0), a3, voffA);
            PG8_BAR; PG8_WAIT_L(0); PG8_MMA(1, 0, At, B0); PG8_BAR; PG8_SCHED;
            PG8_STAGE(PG8_SB(1, 1), b3 + hstep, voffB);
            PG8_WAIT_V(6); PG8_BAR; PG8_MMA(1, 1, At, B1); PG8_BAR;
            }
        }
        if constexpr (ALIGN_EPI) { if (wr == 0) PG8_BAR; }
        if constexpr (!Epi::AFTER_DRAIN) { E(acc, cur, wr, wc, fr, fq); S.done(cur); }
        if (!has_next) break;
#pragma unroll
        for (int a = 0; a < 2; ++a)
#pragma unroll
            for (int b = 0; b < 2; ++b)
#pragma unroll
                for (int m = 0; m < 4; ++m)
#pragma unroll
                    for (int n = 0; n < 2; ++n) acc[a][b][m][n] = (f32x4){0.f, 0.f, 0.f, 0.f};
        cur = nxt; cA = nA; cB = nB; ++ui;
        if constexpr (ALIGN_EPI) { if (wr == 1) PG8_BAR; }
    }
    PG8_WAIT_V(0);
    if constexpr (!ALIGN_EPI) { if (wr == 0) PG8_BAR; }
    PG8_BAR;
    if constexpr (Epi::AFTER_DRAIN) { E.fused(acc, cur, wr, wc, fr, fq, lds, wid, lane); S.done(cur); }
#undef PG8_SA
#undef PG8_SB
#undef PG8_STAGE
#undef PG8_LDA
#undef PG8_LDB
#undef PG8_MMA
#undef PG8_WAIT_V
#undef PG8_WAIT_L
#undef PG8_BAR
#undef PG8_SCHED
}
}

constexpr int NB = 16, SEQ = 2048, DM = 1024, NTOK = NB * SEQ;
constexpr int INC = 2840, INP = 3072;
constexpr int C_B = 0, C_C = 512, C_H = 1024, C_Q = 1536, C_KC = 2048, C_VC = 2176, C_KS = 2304, C_VS = 2432, C_KW = 2560, C_VW = 2688, C_G = 2816;
constexpr int MEMT = 256, NMEM = NB * MEMT;
constexpr int NEXP = 16384;
constexpr int PEER_ROW_BYTES = 1280;
constexpr float EPS = 1e-6f;
constexpr float LOG2E = 1.4426950408889634f;
constexpr int NWAVES = 8, NTHR = 512;
constexpr int NPHASE = 13;

constexpr size_t MiB = 1u << 20;
constexpr size_t WS_CTL = 0, CTL_ZERO_BYTES = 1 * MiB;
constexpr size_t WS_WIN = 2 * MiB, WS_WOUT = 8 * MiB, WS_XQT = 10 * MiB, WS_XKVT = 12 * MiB, WS_XOT = 16 * MiB, WS_PWQT = 18 * MiB;
constexpr size_t WS_PKEYS = 22 * MiB, WS_B1P = 23 * MiB, WS_KCMP = 24 * MiB, WS_VCMP = 24 * MiB + 512 * 1024;
constexpr size_t WS_MN = 26 * MiB, WS_XKV = 34 * MiB;
constexpr size_t WS_CW1T = 22 * MiB + 512 * 1024;
constexpr size_t WS_SA1 = 23 * MiB + 256 * 1024, WS_SB1 = 23 * MiB + 384 * 1024, WS_CMX = 23 * MiB + 448 * 1024;
constexpr size_t WS_PSC = 23 * MiB + 256 * 1024;
constexpr size_t WS_SH = 54 * MiB, WS_SBQ = 54 * MiB + 128 * 1024, WS_CMXQ = 54 * MiB + 256 * 1024;
constexpr size_t WS_SSP1 = 50 * MiB, WS_SSP2 = 52 * MiB;
constexpr size_t WS_PDOWN = 64 * MiB, WS_PUP = 96 * MiB, WS_HN = 128 * MiB, WS_YMIX = 192 * MiB;
constexpr size_t WS_PROJ = 256 * MiB, WS_XQ = 256 * MiB, WS_PQ = 320 * MiB, WS_PIDX = 448 * MiB, WS_PGATE = 464 * MiB, WS_END = 480 * MiB;
constexpr int CW_BAR = 4096;

constexpr int RING_BYTES = 131072;
constexpr int MISC_OFF = 163584;
constexpr int LDS_BYTES = 163840;

#define GAS __attribute__((address_space(1)))
#define LAS __attribute__((address_space(3)))
#define DI __device__ __forceinline__
typedef unsigned short bf16;
typedef unsigned v4u __attribute__((ext_vector_type(4)));
typedef unsigned v2u __attribute__((ext_vector_type(2)));
typedef float f32x4 __attribute__((ext_vector_type(4)));
typedef float f32x16 __attribute__((ext_vector_type(16)));
typedef short bf16x8 __attribute__((ext_vector_type(8)));
typedef short s16x4 __attribute__((ext_vector_type(4)));
typedef float f32x2_t __attribute__((ext_vector_type(2)));
typedef __bf16 bf16x2_t __attribute__((ext_vector_type(2)));
#define RLX_AGENT __ATOMIC_RELAXED, __HIP_MEMORY_SCOPE_AGENT
#define LDS_WAIT() asm volatile("s_waitcnt lgkmcnt(0)" ::: "memory")
#define MFMA32(a, b, c) __builtin_amdgcn_mfma_f32_32x32x16_bf16((a), (b), (c), 0, 0, 0)

DI unsigned pk2(float lo, float hi) { f32x2_t v = {lo, hi}; bf16x2_t b = __builtin_convertvector(v, bf16x2_t); return __builtin_bit_cast(unsigned, b); }
DI bf16 f2bf(float f) { return (bf16)(pk2(f, 0.f) & 0xffffu); }
DI float bf2f(bf16 b) { return __uint_as_float((unsigned)b << 16); }
DI float bflo(unsigned u) { return __uint_as_float(u << 16); }
DI float bfhi(unsigned u) { return __uint_as_float(u & 0xffff0000u); }
DI float rlane(float v, int l);
DI float wave_sum(float v) {
    v += __uint_as_float((unsigned)__builtin_amdgcn_update_dpp(0, (int)__float_as_uint(v), 0xB1, 0xF, 0xF, true));
    v += __uint_as_float((unsigned)__builtin_amdgcn_update_dpp(0, (int)__float_as_uint(v), 0x4E, 0xF, 0xF, true));
    v += __uint_as_float((unsigned)__builtin_amdgcn_update_dpp(0, (int)__float_as_uint(v), 0x141, 0xF, 0xF, true));
    v += __uint_as_float((unsigned)__builtin_amdgcn_update_dpp(0, (int)__float_as_uint(v), 0x140, 0xF, 0xF, true));
    return (rlane(v, 0) + rlane(v, 16)) + (rlane(v, 32) + rlane(v, 48));
}
DI float rlane(float v, int l)   { return __uint_as_float((unsigned)__builtin_amdgcn_readlane((int)__float_as_uint(v), l)); }
DI int crow(int i, int h) { return (i & 3) + 8 * (i >> 2) + 4 * h; }
DI float gelu_erf(float v) { return 0.5f * v * (1.0f + erff(v * 0.70710678118654752f)); }

#define XB_TMO      128
#define XB_XCNT(j)  (256  + 64 * (j))
#define XB_XSUB(j)  (1280 + 64 * (j))
#define XB_XGEN(j)  (2304 + 64 * (j))
#define XB_TOP      3328
#define XB_TOPGEN   3392
#define XCD_BAR_WORDS 3456
#define XB_SPIN_CAP (1u << 22)

DI unsigned xb_ld(unsigned* p)              { return __hip_atomic_load(p, __ATOMIC_RELAXED, __HIP_MEMORY_SCOPE_AGENT); }
DI unsigned xb_add(unsigned* p, unsigned v) { return __hip_atomic_fetch_add(p, v, __ATOMIC_RELAXED, __HIP_MEMORY_SCOPE_AGENT); }
DI unsigned xb_xcc_id() { return (unsigned)__builtin_amdgcn_s_getreg((3 << 11) | 20) & 0xFu; }
#define XB_SPIN(cond, bar) do { unsigned _sp = 0; while (cond) { __builtin_amdgcn_s_sleep(1); \
    if ((++_sp & 255u) == 0u) { if (xb_ld(&(bar)[XB_TMO])) break; if (_sp > XB_SPIN_CAP) { atomicAdd(&(bar)[XB_TMO], 1u); break; } } } } while (0)

struct XcdBarrier { unsigned* bar; unsigned x; volatile LAS unsigned* st; };

DI XcdBarrier xcd_barrier_post(unsigned* bar, volatile LAS unsigned* st) {
    XcdBarrier b; b.bar = bar; b.x = xb_xcc_id(); b.st = st;
    if (threadIdx.x == 0) (void)xb_add(&bar[XB_XCNT(b.x)], 1u);
    return b;
}
DI void xcd_barrier_complete(unsigned* bar, unsigned x, unsigned& nloc, unsigned& nx) {
    const unsigned G = gridDim.x * gridDim.y * gridDim.z;
    unsigned sum, cnt, mine, sp = 0u;
    for (;;) {
        sum = 0u; cnt = 0u; mine = 0u;
#pragma unroll
        for (unsigned j = 0; j < 16; ++j) { const unsigned c = xb_ld(&bar[XB_XCNT(j)]); sum += c; cnt += (c > 0u) ? 1u : 0u; mine = (j == x) ? c : mine; }
        if (sum == G) break;
        __builtin_amdgcn_s_sleep(1);
        if ((++sp & 255u) == 0u) { if (xb_ld(&bar[XB_TMO])) break; if (sp > XB_SPIN_CAP) { atomicAdd(&bar[XB_TMO], 1u); break; } }
    }
    nloc = mine > 0u ? mine : 1u; nx = cnt > 0u ? cnt : 1u;
}
DI void xcd_barrier(const XcdBarrier& b) {
    asm volatile("s_waitcnt vmcnt(0)" ::: "memory");
    __syncthreads();
    if (threadIdx.x == 0) {
        unsigned* bar = b.bar;
        __builtin_amdgcn_s_waitcnt(0);
        unsigned nloc = b.st[0], nx = b.st[1];
        if (nloc == 0u) { xcd_barrier_complete(bar, b.x, nloc, nx); b.st[0] = nloc; b.st[1] = nx; }
        const unsigned old = xb_add(&bar[XB_XSUB(b.x)], 1u);
        const unsigned gen = old / nloc;
        if (old + 1u == (gen + 1u) * nloc) {
            __builtin_amdgcn_fence(__ATOMIC_RELEASE, "agent");
            asm volatile("s_waitcnt vmcnt(0)" ::: "memory");
            const unsigned og = xb_add(&bar[XB_TOP], 1u);
            const unsigned tg = og / nx;
            if (og + 1u == (tg + 1u) * nx) xb_add(&bar[XB_TOPGEN], 1u);
            else XB_SPIN(xb_ld(&bar[XB_TOPGEN]) == tg, bar);
            __builtin_amdgcn_fence(__ATOMIC_ACQUIRE, "agent");
            xb_add(&bar[XB_XGEN(b.x)], 1u);
            asm volatile("s_waitcnt vmcnt(0)" ::: "memory");
        } else {
            XB_SPIN(xb_ld(&bar[XB_XGEN(b.x)]) == gen, bar);
            __builtin_amdgcn_fence(__ATOMIC_ACQUIRE, "agent");
            asm volatile("s_waitcnt vmcnt(0)" ::: "memory");
        }
    }
    __syncthreads();
}

DI void transpose_item(const float* W, int K, int N, int Npad, bf16* WT, int row_off, LAS float* scr, int item, int lane, const float* ks = nullptr) {
    const int nblk = Npad / 32, kb = item / nblk, nb = item % nblk, k0 = 64 * kb, n0 = 32 * nb;
    {
        const int kr = lane >> 3, nq = n0 + 4 * (lane & 7);
        f32x4 v[8];
#pragma unroll
        for (int i = 0; i < 8; ++i) v[i] = (nq < N) ? *(const f32x4*)(W + (size_t)(k0 + 8 * i + kr) * N + nq) : (f32x4){0.f, 0.f, 0.f, 0.f};
#pragma unroll
        for (int i = 0; i < 8; ++i) { const float sc = ks ? ks[k0 + 8 * i + kr] : 1.0f; LAS float* d = scr + (8 * i + kr) * 33 + 4 * (lane & 7);
            d[0] = v[i].x * sc; d[1] = v[i].y * sc; d[2] = v[i].z * sc; d[3] = v[i].w * sc; }
    }
    LDS_WAIT(); asm volatile("" ::: "memory");
    const int c = lane & 7;
#pragma unroll
    for (int j = 0; j < 4; ++j) { const int n = (lane >> 3) + 8 * j; const LAS float* s = scr + (8 * c) * 33 + n;
        v4u o; o.x = pk2(s[0 * 33], s[1 * 33]); o.y = pk2(s[2 * 33], s[3 * 33]); o.z = pk2(s[4 * 33], s[5 * 33]); o.w = pk2(s[6 * 33], s[7 * 33]);
        *(v4u*)(WT + (size_t)(row_off + n0 + n) * K + k0 + 8 * c) = o; }
    LDS_WAIT(); asm volatile("" ::: "memory");
}
template <int NR>
DI void rms_rows_to_bf16(const float* xrow, const float* w, bf16* orow, int lane) {
    const f32x4* wr = (const f32x4*)w + lane;
    f32x4 v[NR][4]; float s[NR];
#pragma unroll
    for (int q = 0; q < NR; ++q) { const f32x4* xr = (const f32x4*)(xrow + (size_t)q * DM) + lane;
#pragma unroll
        for (int j = 0; j < 4; ++j) v[q][j] = xr[64 * j]; }
#pragma unroll
    for (int q = 0; q < NR; ++q) { s[q] = 0.f;
#pragma unroll
        for (int j = 0; j < 4; ++j) s[q] += (v[q][j].x * v[q][j].x + v[q][j].y * v[q][j].y) + (v[q][j].z * v[q][j].z + v[q][j].w * v[q][j].w); }
#pragma unroll
    for (int q = 0; q < NR; ++q) { const float r = 1.0f / sqrtf(wave_sum(s[q]) * (1.f / DM) + EPS);
        v2u* o8 = (v2u*)(orow + (size_t)q * DM) + lane;
#pragma unroll
        for (int j = 0; j < 4; ++j) { const f32x4 ww = wr[64 * j]; v2u o; o.x = pk2(v[q][j].x * r * ww.x, v[q][j].y * r * ww.y); o.y = pk2(v[q][j].z * r * ww.z, v[q][j].w * r * ww.w); o8[64 * j] = o; } }
}
DI float wave_max_u(float v) {
    v = fmaxf(v, __uint_as_float((unsigned)__builtin_amdgcn_update_dpp(0, (int)__float_as_uint(v), 0xB1, 0xF, 0xF, true)));
    v = fmaxf(v, __uint_as_float((unsigned)__builtin_amdgcn_update_dpp(0, (int)__float_as_uint(v), 0x4E, 0xF, 0xF, true)));
    v = fmaxf(v, __uint_as_float((unsigned)__builtin_amdgcn_update_dpp(0, (int)__float_as_uint(v), 0x141, 0xF, 0xF, true)));
    v = fmaxf(v, __uint_as_float((unsigned)__builtin_amdgcn_update_dpp(0, (int)__float_as_uint(v), 0x140, 0xF, 0xF, true)));
    return fmaxf(fmaxf(rlane(v, 0), rlane(v, 16)), fmaxf(rlane(v, 32), rlane(v, 48)));
}
DI unsigned q8x4(float a, float b, float c, float d, float inv) {
    return ((unsigned)(int)__builtin_rintf(a * inv) & 0xffu) | (((unsigned)(int)__builtin_rintf(b * inv) & 0xffu) << 8) | (((unsigned)(int)__builtin_rintf(c * inv) & 0xffu) << 16) | (((unsigned)(int)__builtin_rintf(d * inv) & 0xffu) << 24);
}
template <int NR>
DI void rms_rows_to_i8(const float* xrow, const float* w, unsigned char* orow, float* srow, int lane) {
    const f32x4* wr = (const f32x4*)w + lane;
    f32x4 v[NR][4]; float s[NR];
#pragma unroll
    for (int q = 0; q < NR; ++q) { const f32x4* xr = (const f32x4*)(xrow + (size_t)q * DM) + lane;
#pragma unroll
        for (int j = 0; j < 4; ++j) v[q][j] = xr[64 * j]; }
#pragma unroll
    for (int q = 0; q < NR; ++q) { s[q] = 0.f;
#pragma unroll
        for (int j = 0; j < 4; ++j) s[q] += (v[q][j].x * v[q][j].x + v[q][j].y * v[q][j].y) + (v[q][j].z * v[q][j].z + v[q][j].w * v[q][j].w); }
#pragma unroll
    for (int q = 0; q < NR; ++q) { const float r = 1.0f / sqrtf(wave_sum(s[q]) * (1.f / DM) + EPS); float mx = 0.f;
#pragma unroll
        for (int j = 0; j < 4; ++j) { v[q][j] = v[q][j] * r * wr[64 * j]; mx = fmaxf(mx, fmaxf(fmaxf(fabsf(v[q][j].x), fabsf(v[q][j].y)), fmaxf(fabsf(v[q][j].z), fabsf(v[q][j].w)))); }
        mx = wave_max_u(mx); const float inv = mx > 0.f ? 127.0f / mx : 0.f;
        unsigned* o4 = (unsigned*)(orow + (size_t)q * DM) + lane;
#pragma unroll
        for (int j = 0; j < 4; ++j) o4[64 * j] = q8x4(v[q][j].x, v[q][j].y, v[q][j].z, v[q][j].w, inv);
        if (lane == 0) srow[q] = mx * (1.0f / 127.0f); }
}
DI void transpose_item_i8(const float* W, int NR, int NP, const float* cmx, unsigned char* WT, float* sb, LAS float* scr, int item, int lane) {
    const int nblk = NP / 32, kb = item / nblk, nb = item % nblk, k0 = 64 * kb, n0 = 32 * nb;
    const int nn = n0 + (lane & 31);
    float cm = 0.f;
#pragma unroll
    for (int kc = 0; kc < 16; ++kc) cm = fmaxf(cm, cmx[kc * NP + nn]);
    const float inv = cm > 0.f ? 127.0f / cm : 0.f;
    if (kb == 0 && lane < 32) sb[nn] = cm * (1.0f / 127.0f);
    {
        const int kr = lane >> 3, nc = lane & 7, nq = n0 + 4 * nc;
        const float i0 = __shfl(inv, 4 * nc), i1 = __shfl(inv, 4 * nc + 1), i2 = __shfl(inv, 4 * nc + 2), i3 = __shfl(inv, 4 * nc + 3);
        f32x4 v[8];
#pragma unroll
        for (int i = 0; i < 8; ++i) v[i] = (nq < NR) ? *(const f32x4*)(W + (size_t)(k0 + 8 * i + kr) * NR + nq) : (f32x4){0.f, 0.f, 0.f, 0.f};
#pragma unroll
        for (int i = 0; i < 8; ++i) { LAS float* d = scr + (8 * i + kr) * 33 + 4 * nc; d[0] = v[i].x * i0; d[1] = v[i].y * i1; d[2] = v[i].z * i2; d[3] = v[i].w * i3; }
    }
    LDS_WAIT(); asm volatile("" ::: "memory");
    const int c = lane & 7;
#pragma unroll
    for (int j = 0; j < 4; ++j) { const int n = (lane >> 3) + 8 * j; const LAS float* s = scr + (8 * c) * 33 + n;
        v2u o; o.x = q8x4(s[0 * 33], s[1 * 33], s[2 * 33], s[3 * 33], 1.0f); o.y = q8x4(s[4 * 33], s[5 * 33], s[6 * 33], s[7 * 33], 1.0f);
        *(v2u*)(WT + (size_t)(n0 + n) * DM + k0 + 8 * c) = o; }
    LDS_WAIT(); asm volatile("" ::: "memory");
}
DI void cvt_stream(const float* src, bf16* dst, size_t n8, int gthread, int nthreads) {
    for (size_t i = gthread; i < n8; i += nthreads) {
        const f32x4 a = ((const f32x4*)src)[2 * i], b = ((const f32x4*)src)[2 * i + 1];
        v4u o; o.x = pk2(a.x, a.y); o.y = pk2(a.z, a.w); o.z = pk2(b.x, b.y); o.w = pk2(b.z, b.w);
        ((v4u*)dst)[i] = o;
    }
}

DI void colmax_item(const float* W, int NR, int NP, float* cmx, int it, int lane) {
    const int kc = it / (NP / 64), n = 64 * (it % (NP / 64)) + 4 * (lane & 15), kr = lane >> 4; f32x4 mx = {0.f, 0.f, 0.f, 0.f};
    if (n < NR) {
#pragma unroll
        for (int i = 0; i < 16; ++i) { const f32x4 v = *(const f32x4*)(W + (size_t)(64 * kc + 4 * i + kr) * NR + n);
            mx.x = fmaxf(mx.x, fabsf(v.x)); mx.y = fmaxf(mx.y, fabsf(v.y)); mx.z = fmaxf(mx.z, fabsf(v.z)); mx.w = fmaxf(mx.w, fabsf(v.w)); } }
    mx.x = fmaxf(mx.x, __shfl_xor(mx.x, 16)); mx.y = fmaxf(mx.y, __shfl_xor(mx.y, 16)); mx.z = fmaxf(mx.z, __shfl_xor(mx.z, 16)); mx.w = fmaxf(mx.w, __shfl_xor(mx.w, 16));
    mx.x = fmaxf(mx.x, __shfl_xor(mx.x, 32)); mx.y = fmaxf(mx.y, __shfl_xor(mx.y, 32)); mx.z = fmaxf(mx.z, __shfl_xor(mx.z, 32)); mx.w = fmaxf(mx.w, __shfl_xor(mx.w, 32));
    if (kr == 0) *(f32x4*)(cmx + kc * NP + n) = mx;
}
struct Ptrs {
    const float *x, *mem, *mix_norm_w, *w_in, *conv_w, *conv_b, *cmp_pe, *cmp_w1, *cmp_w2, *q_norm_w, *k_norm_w, *w_out, *xattn_norm_w, *mem_norm_w,
                *xq, *xk, *xv, *xo, *xq_norm_w, *xk_norm_w, *ffn_norm_w, *peer_wq, *peer_keys, *peer_down, *peer_up;
    float* out;
    bf16 *WIN, *WOUT, *XQT, *XKVT, *XOT, *PWQT, *PKEYS, *KCMP, *VCMP, *MN, *XKV, *HN, *YMIX, *PROJ, *XQ, *PQ;
    unsigned char *PDOWN, *PUP;
    float *B1P, *PGATE, *PSC, *SSP1, *SSP2, *SA1, *SB1, *CMX, *SH, *SBQ, *CMXQ; int* PIDX; bf16* CW1T; unsigned char *HN8, *WIN8, *H8, *PWQ8;
};

DI void p0_prologue(const Ptrs& P, LAS unsigned char* lds, int gw, int NGW, int wave, int lane, int part, int pm = 7) {
    LAS float* scr = (LAS float*)(lds + wave * 16384);
    if (part == 1 && !(pm & 1)) return;
    if (part == 1) {
        for (int it = gw; it < (DM / 64) * (INP / 32) + (DM / 64) * (2048 / 32); it += NGW) {
            if (it < (DM / 64) * (INP / 32)) transpose_item_i8(P.w_in, INC, INP, P.CMX, P.WIN8, P.SB1, scr, it, lane);
            else transpose_item_i8(P.peer_wq, 2048, 2048, P.CMXQ, P.PWQ8, P.SBQ, scr, it - (DM / 64) * (INP / 32), lane); }
        return;
    }
    if (pm & 1) for (int it = gw; it < 16 * (INP / 64) + 16 * (2048 / 64); it += NGW) {
        if (it < 16 * (INP / 64)) colmax_item(P.w_in, INC, INP, P.CMX, it, lane); else colmax_item(P.peer_wq, 2048, 2048, P.CMXQ, it - 16 * (INP / 64), lane); }
    constexpr int I_IN = (DM / 64) * (INP / 32), I_SQ = (DM / 64) * (DM / 32), I_PQ = (DM / 64) * (2048 / 32);
    constexpr int NITEMS = 5 * I_SQ;
    if (pm & 1) for (int it = gw; it < NITEMS; it += NGW) {
        int r = it;
        if (r < I_SQ) { transpose_item(P.w_out, DM, DM, DM, P.WOUT, 0, scr, r, lane); continue; } r -= I_SQ;
        if (r < I_SQ) { transpose_item(P.xq, DM, DM, DM, P.XQT, 0, scr, r, lane, P.xattn_norm_w); continue; } r -= I_SQ;
        if (r < I_SQ) { transpose_item(P.xk, DM, DM, DM, P.XKVT, 0, scr, r, lane); continue; } r -= I_SQ;
        if (r < I_SQ) { transpose_item(P.xv, DM, DM, DM, P.XKVT, DM, scr, r, lane); continue; } r -= I_SQ;
        transpose_item(P.xo, DM, DM, DM, P.XOT, 0, scr, r, lane);
    }
    for (int it = gw; it < 128; it += NGW) {
        const int q = it >> 5, r = it & 31;
        transpose_item(P.cmp_w1 + (size_t)q * 1024 * 64, 1024, 64, 64, P.CW1T + (size_t)(q >> 1) * 128 * 1024, (q & 1) * 64, scr, r, lane);
    }
    for (int it = gw; it < 64; it += NGW) {
        const int kv = it >> 5, l = it & 31;
        const float pv = P.cmp_pe[(kv * 32 + l) * 64 + lane];
        const float* w1 = P.cmp_w1 + ((size_t)kv * 2048 + l * 64) * 64 + lane;
        float acc = 0.f;
#pragma unroll 16
        for (int d = 0; d < 64; ++d) acc += rlane(pv, d) * w1[d * 64];
        P.B1P[it * 64 + lane] = acc;
    }
    if (pm & 2) for (int m = 4 * gw; m < NTOK; m += 4 * NGW) rms_rows_to_i8<4>(P.x + (size_t)m * DM, P.mix_norm_w, P.HN8 + (size_t)m * DM, P.SA1 + m, lane);
    if (pm & 2) for (int m = 2 * gw; m < NMEM; m += 2 * NGW) rms_rows_to_bf16<2>(P.mem + (size_t)m * DM, P.mem_norm_w, P.MN + (size_t)m * DM, lane);
    const int gthread = gw * 64 + lane, nthreads = NGW * 64;
    if (pm & 4) for (int row0 = 2 * gw; row0 < 2 * NEXP; row0 += 2 * NGW) {
        f32x4 v2[2][4];
#pragma unroll
        for (int q = 0; q < 2; ++q) { const int row = row0 + q, tb = row >> 14, e = row & (NEXP - 1);
            const f32x4* src = (const f32x4*)((tb ? P.peer_up : P.peer_down) + (size_t)e * DM) + 4 * lane;
#pragma unroll
            for (int j = 0; j < 4; ++j) v2[q][j] = src[j]; }
#pragma unroll
        for (int q = 0; q < 2; ++q) { const int row = row0 + q, tb = row >> 14, e = row & (NEXP - 1);
        f32x4 v[4]; float mx = 0.f;
#pragma unroll
        for (int j = 0; j < 4; ++j) { v[j] = v2[q][j]; mx = fmaxf(mx, fmaxf(fmaxf(fabsf(v[j].x), fabsf(v[j].y)), fmaxf(fabsf(v[j].z), fabsf(v[j].w)))); }
        const bf16 sc16 = f2bf(mx * (tb ? (1.0f / 6.0f) : (1.0f / 7.0f))); const float sc = bf2f(sc16), inv = sc > 0.f ? 1.0f / sc : 0.f;
        unsigned w[2];
#pragma unroll
        for (int d = 0; d < 2; ++d) { unsigned acc = 0u;
            if (tb) {
#define FP4_PAIR(B) { const int c = 8 * d + 2 * (B); const float x0 = fminf(fmaxf(v[c >> 2][c & 3] * inv, -6.0f), 6.0f), x1 = fminf(fmaxf(v[(c + 1) >> 2][(c + 1) & 3] * inv, -6.0f), 6.0f); \
                    acc = __builtin_amdgcn_cvt_scalef32_pk_fp4_f32(acc, x0, x1, 1.0f, (B)); }
                FP4_PAIR(0) FP4_PAIR(1) FP4_PAIR(2) FP4_PAIR(3)
#undef FP4_PAIR
            } else {
#pragma unroll
                for (int i = 0; i < 8; ++i) { const float x = v[2 * d + (i >> 2)][i & 3]; int q2 = (int)__builtin_rintf(x * inv); q2 = q2 < -7 ? -7 : (q2 > 7 ? 7 : q2); acc |= ((unsigned)q2 & 0xFu) << (4 * i); }
            }
            w[d] = acc; }
        unsigned char* rp = P.PDOWN + (size_t)e * PEER_ROW_BYTES;
        *(v2u*)(rp + 16 * lane + 8 * tb) = (v2u){w[0], w[1]};
        *(bf16*)(rp + 1024 + 4 * lane + 2 * tb) = sc16;
        }
    }
    cvt_stream(P.peer_keys, P.PKEYS, (size_t)8 * 2 * 128 * 128 / 8, gthread, nthreads);
}

template <int CTRL> DI float dppf(float v) { return __uint_as_float((unsigned)__builtin_amdgcn_update_dpp(0, (int)__float_as_uint(v), CTRL, 0xF, 0xF, true)); }
DI float sum8(float v) { v += dppf<0xB1>(v); v += dppf<0x4E>(v); v += dppf<0x141>(v); return v; }
DI float sum32(float v) { v = sum8(v); v += dppf<0x140>(v); v += __shfl_xor(v, 16); return v; }
constexpr int CM_SA_OFF = 0, CM_SB_OFF = 36864, CM_P_OFF = 0, CM_H_OFF = 73728, CM_W2_OFF = CM_H_OFF + 128 * 68 * 4, CM_B_OFF = CM_W2_OFF + 64 * 64 * 4;
DI void compress_unit(const Ptrs& P, LAS unsigned char* lds, int kv, int b, int g, int tid, int wave, int lane) {
    LAS float* Pl = (LAS float*)(lds + CM_P_OFF); LAS float* Hl = (LAS float*)(lds + CM_H_OFF); LAS float* W2l = (LAS float*)(lds + CM_W2_OFF); LAS float* Bl = (LAS float*)(lds + CM_B_OFF);
    const int r = lane & 31, h = lane >> 5, wm = wave >> 1, wn = wave & 1;
    __syncthreads();
    for (int e = tid; e < 64 * 64; e += NTHR) W2l[e] = P.cmp_w2[(size_t)kv * 4096 + e];
    if (tid < 64) { float s = 0.f;
#pragma unroll 8
        for (int l = 0; l < 32; ++l) s += P.B1P[(kv * 32 + l) * 64 + tid];
        Bl[tid] = s; }
    {
        const bf16* abase = P.PROJ + (size_t)b * SEQ * INP + (kv ? C_VC : C_KC) + g * 64;
        const bf16* bbase = P.CW1T + (size_t)kv * 128 * 1024;
        const int srow = tid >> 3, sch = tid & 7;
        v4u ra[2], rb[2];
#define CM_GLOAD(L) { _Pragma("unroll") for (int k2 = 0; k2 < 2; ++k2) { const int row = srow + 64 * k2; \
            ra[k2] = *(const v4u*)(abase + (size_t)(16 * row + (L)) * INP + sch * 8); rb[k2] = *(const v4u*)(bbase + (size_t)row * 1024 + (L) * 64 + sch * 8); } }
#define CM_LSTORE(BUF) { _Pragma("unroll") for (int k2 = 0; k2 < 2; ++k2) { const int row = srow + 64 * k2; \
            *(LAS v4u*)(lds + CM_SA_OFF + (BUF) * 18432 + row * 144 + sch * 16) = ra[k2]; *(LAS v4u*)(lds + CM_SB_OFF + (BUF) * 18432 + row * 144 + sch * 16) = rb[k2]; } }
        CM_GLOAD(0) CM_LSTORE(0) CM_GLOAD(1)
        f32x16 acc[2];
#pragma unroll
        for (int i = 0; i < 16; ++i) { acc[0][i] = 0.f; acc[1][i] = 0.f; }
#pragma unroll 1
        for (int l = 0; l < 16; ++l) {
            __syncthreads();
            if (l + 1 < 16) { CM_LSTORE((l + 1) & 1) if (l + 2 < 16) CM_GLOAD(l + 2) }
            LAS const unsigned char* ap = lds + CM_SA_OFF + (l & 1) * 18432 + (32 * wm + r) * 144 + h * 16;
            LAS const unsigned char* bp = lds + CM_SB_OFF + (l & 1) * 18432 + (64 * wn + r) * 144 + h * 16;
#pragma unroll
            for (int kk = 0; kk < 4; ++kk) { const bf16x8 a = *(LAS const bf16x8*)(ap + kk * 32), b0 = *(LAS const bf16x8*)(bp + kk * 32), b1 = *(LAS const bf16x8*)(bp + 32 * 144 + kk * 32);
                acc[0] = MFMA32(a, b0, acc[0]); acc[1] = MFMA32(a, b1, acc[1]); }
        }
#undef CM_GLOAD
#undef CM_LSTORE
        __syncthreads();
#pragma unroll
        for (int t = 0; t < 2; ++t)
#pragma unroll
            for (int i = 0; i < 16; ++i) Pl[(32 * wm + crow(i, h)) * 132 + 64 * wn + 32 * t + r] = acc[t][i];
    }
    __syncthreads();
    for (int e = tid; e < 128 * 64; e += NTHR) { const int n = e >> 6, j = e & 63;
        Hl[n * 68 + j] = (n < 127) ? gelu_erf(Pl[n * 132 + j] + Pl[(n + 1) * 132 + 64 + j] + Bl[j]) : 0.f; }
    __syncthreads();
    {
        const int n = tid >> 2, jq = tid & 3;
        float o[16];
#pragma unroll
        for (int j = 0; j < 16; ++j) o[j] = 0.f;
#pragma unroll 4
        for (int m = 0; m < 64; ++m) { const float hv = Hl[n * 68 + m];
#pragma unroll
            for (int j4 = 0; j4 < 4; ++j4) { const f32x4 w = *(LAS const f32x4*)(W2l + m * 64 + jq * 16 + 4 * j4); o[4 * j4] += hv * w.x; o[4 * j4 + 1] += hv * w.y; o[4 * j4 + 2] += hv * w.z; o[4 * j4 + 3] += hv * w.w; } }
        if (kv == 0) { float ss = 0.f;
#pragma unroll
            for (int j = 0; j < 16; ++j) ss += o[j] * o[j];
            ss += dppf<0xB1>(ss); ss += dppf<0x4E>(ss);
            const float rr = 1.0f / sqrtf(ss * (1.f / 64.f) + EPS);
#pragma unroll
            for (int j = 0; j < 16; ++j) o[j] = o[j] * rr * P.k_norm_w[jq * 16 + j]; }
        v4u w0, w1; w0.x = pk2(o[0], o[1]); w0.y = pk2(o[2], o[3]); w0.z = pk2(o[4], o[5]); w0.w = pk2(o[6], o[7]); w1.x = pk2(o[8], o[9]); w1.y = pk2(o[10], o[11]); w1.z = pk2(o[12], o[13]); w1.w = pk2(o[14], o[15]);
        bf16* outp = (kv ? P.VCMP : P.KCMP) + ((size_t)((b * 2 + g) * 128 + n)) * 64 + jq * 16;
        *(v4u*)outp = w0; *(v4u*)(outp + 8) = w1;
    }
}
DI void conv_taps(const Ptrs& P, int c8, float (&cw)[3][8], float (&cb)[8]) {
#pragma unroll
    for (int k = 0; k < 3; ++k) { const f32x4 w0 = *(const f32x4*)(P.conv_w + k * 512 + c8), w1 = *(const f32x4*)(P.conv_w + k * 512 + c8 + 4);
        cw[k][0] = w0.x; cw[k][1] = w0.y; cw[k][2] = w0.z; cw[k][3] = w0.w; cw[k][4] = w1.x; cw[k][5] = w1.y; cw[k][6] = w1.z; cw[k][7] = w1.w; }
    const f32x4 w0 = *(const f32x4*)(P.conv_b + c8), w1 = *(const f32x4*)(P.conv_b + c8 + 4);
    cb[0] = w0.x; cb[1] = w0.y; cb[2] = w0.z; cb[3] = w0.w; cb[4] = w1.x; cb[5] = w1.y; cb[6] = w1.z; cb[7] = w1.w;
}
DI void ch_prod(const bf16* row, int c8, float (&u)[8]) {
    const v4u cv = *(const v4u*)(row + C_C + c8), hv = *(const v4u*)(row + C_H + c8);
    u[0] = bflo(cv.x) * bflo(hv.x); u[1] = bfhi(cv.x) * bfhi(hv.x); u[2] = bflo(cv.y) * bflo(hv.y); u[3] = bfhi(cv.y) * bfhi(hv.y);
    u[4] = bflo(cv.z) * bflo(hv.z); u[5] = bfhi(cv.z) * bfhi(hv.z); u[6] = bflo(cv.w) * bflo(hv.w); u[7] = bfhi(cv.w) * bfhi(hv.w);
}
DI void conv_out(const Ptrs& P, int t, int c8, const float (&cw)[3][8], const float (&cb)[8], const float (&u2)[8], const float (&u1)[8], const float (&u0)[8]) {
    const v4u bv = *(const v4u*)(P.PROJ + (size_t)t * INP + C_B + c8);
    const float bg[8] = {bflo(bv.x), bfhi(bv.x), bflo(bv.y), bfhi(bv.y), bflo(bv.z), bfhi(bv.z), bflo(bv.w), bfhi(bv.w)};
    float y[8];
#pragma unroll
    for (int e = 0; e < 8; ++e) y[e] = bg[e] * (cw[0][e] * u2[e] + cw[1][e] * u1[e] + cw[2][e] * u0[e] + cb[e]);
    v4u o; o.x = pk2(y[0], y[1]); o.y = pk2(y[2], y[3]); o.z = pk2(y[4], y[5]); o.w = pk2(y[6], y[7]);
    *(v4u*)(P.YMIX + (size_t)t * DM + c8) = o;
}
DI void proj_post_conv(const Ptrs& P, int mt, int chb, int wave, int lane) {
    const int c8 = chb + (lane & 31) * 8, stream = wave * 2 + (lane >> 5);
    float cw[3][8], cb[8]; conv_taps(P, c8, cw, cb);
    const int t0 = 256 * mt + 16 * stream, first = t0 + (stream == 0 ? 2 : 0);
    float u2[8], u1[8];
    if (stream) { ch_prod(P.PROJ + (size_t)(t0 - 2) * INP, c8, u2); ch_prod(P.PROJ + (size_t)(t0 - 1) * INP, c8, u1); }
    else {
#pragma unroll
        for (int e = 0; e < 8; ++e) { u2[e] = 0.f; u1[e] = 0.f; } }
#pragma unroll 1
    for (int t = t0; t < t0 + 16; t += 8) {
        v4u cv[8], hv[8], bv[8];
#pragma unroll
        for (int j = 0; j < 8; ++j) { const bf16* row = P.PROJ + (size_t)(t + j) * INP + c8; cv[j] = *(const v4u*)(row + C_C); hv[j] = *(const v4u*)(row + C_H); bv[j] = *(const v4u*)(row + C_B); }
#pragma unroll
        for (int j = 0; j < 8; ++j) {
            const float u0[8] = {bflo(cv[j].x) * bflo(hv[j].x), bfhi(cv[j].x) * bfhi(hv[j].x), bflo(cv[j].y) * bflo(hv[j].y), bfhi(cv[j].y) * bfhi(hv[j].y),
                                 bflo(cv[j].z) * bflo(hv[j].z), bfhi(cv[j].z) * bfhi(hv[j].z), bflo(cv[j].w) * bflo(hv[j].w), bfhi(cv[j].w) * bfhi(hv[j].w)};
            const float bg[8] = {bflo(bv[j].x), bfhi(bv[j].x), bflo(bv[j].y), bfhi(bv[j].y), bflo(bv[j].z), bfhi(bv[j].z), bflo(bv[j].w), bfhi(bv[j].w)};
            float y[8];
#pragma unroll
            for (int e = 0; e < 8; ++e) y[e] = bg[e] * (cw[0][e] * u2[e] + cw[1][e] * u1[e] + cw[2][e] * u0[e] + cb[e]);
            v4u o; o.x = pk2(y[0], y[1]); o.y = pk2(y[2], y[3]); o.z = pk2(y[4], y[5]); o.w = pk2(y[6], y[7]);
            if (t + j >= first) *(v4u*)(P.YMIX + (size_t)(t + j) * DM + c8) = o;
#pragma unroll
            for (int e = 0; e < 8; ++e) { u2[e] = u1[e]; u1[e] = u0[e]; }
        }
    }
}
DI void proj_post_knorm(const Ptrs& P, int mt, int wave, int lane) {
    const int grp = (lane >> 3) & 3, ch = lane & 7;
    const f32x4 w0 = *(const f32x4*)(P.k_norm_w + (grp < 2 ? 64 : 128) + ch * 8), w1 = *(const f32x4*)(P.k_norm_w + (grp < 2 ? 64 : 128) + ch * 8 + 4);
#pragma unroll 4
    for (int i = 0; i < 128 / NWAVES; ++i) {
        const int t = 256 * mt + (wave + NWAVES * i) * 2 + (lane >> 5);
        bf16* p = P.PROJ + (size_t)t * INP + (grp < 2 ? C_KS : C_KW) + (grp & 1) * 64 + ch * 8;
        const v4u u = *(const v4u*)p;
        const float a = bflo(u.x), b = bfhi(u.x), c = bflo(u.y), d = bfhi(u.y), e = bflo(u.z), f = bfhi(u.z), g2 = bflo(u.w), k = bfhi(u.w);
        const float ss = sum8(((a * a + b * b) + (c * c + d * d)) + ((e * e + f * f) + (g2 * g2 + k * k)));
        const float rr = 1.0f / sqrtf(ss * (1.f / 64.f) + EPS);
        v4u o; o.x = pk2(a * rr * w0.x, b * rr * w0.y); o.y = pk2(c * rr * w0.z, d * rr * w0.w); o.z = pk2(e * rr * w1.x, f * rr * w1.y); o.w = pk2(g2 * rr * w1.z, k * rr * w1.w);
        *(v4u*)p = o;
    }
}
DI void p2_misc(const Ptrs& P, LAS unsigned char* lds, int vcu, int G, int tid, int wave, int lane, bool do_norm) {
    const int ncw = G >> 2;
    if ((vcu & 3) == 0) {
        for (int u = vcu >> 2; u < 64; u += ncw) compress_unit(P, lds, u >> 5, (u >> 1) & 15, u & 1, tid, wave, lane);
        return;
    }
    const int ov = (vcu >> 2) * 3 + (vcu & 3) - 1, gw = ov * NWAVES + wave, NGW = (G - ncw) * NWAVES;
    if (do_norm) {
        pg8::Gemm g{P.MN, P.XKVT, NMEM, 2048, DM}; pg8::StaticOrder S; S.init(NMEM, 2048, G - ncw, ov);
        pg8::EpiBf16<0> E{P.XKV, 2048, nullptr, 0, 0, 1.f};
        pg8::gemm_phase<pg8::EpiBf16<0>, pg8::StaticOrder, true, true>(lds, g, S, E);
    }
    {
        const int c8 = lane * 8;
        float cw[3][8], cb[8]; conv_taps(P, c8, cw, cb);
        for (int i = gw; i < 2 * (NTOK / 256); i += NGW) {
            const int t = (i >> 1) * 256 + (i & 1), s = t & (SEQ - 1);
            float u[3][8];
#pragma unroll
            for (int k = 0; k < 3; ++k) {
                const int back = 2 - k;
                if (s >= back) ch_prod(P.PROJ + (size_t)(t - back) * INP, c8, u[k]);
                else {
#pragma unroll
                    for (int e = 0; e < 8; ++e) u[k][e] = 0.f; }
            }
            conv_out(P, t, c8, cw, cb, u[0], u[1], u[2]);
        }
    }
}
DI void xk_norm(const Ptrs& P, int gw, int NGW, int lane) {
    for (int it = gw; it < NMEM * 4 / 2; it += NGW) {
        const int rowid = it * 2 + (lane >> 5), m = rowid >> 2, hd = rowid & 3, ch = lane & 31;
        bf16* p = P.XKV + (size_t)m * 2048 + hd * 256 + ch * 8;
        const v4u u = *(const v4u*)p;
        const float a = bflo(u.x), b = bfhi(u.x), c = bflo(u.y), d = bfhi(u.y), e = bflo(u.z), f = bfhi(u.z), g2 = bflo(u.w), k = bfhi(u.w);
        const float ss = sum32(((a * a + b * b) + (c * c + d * d)) + ((e * e + f * f) + (g2 * g2 + k * k)));
        const float rr = 1.0f / sqrtf(ss * (1.f / 256.f) + EPS);
        f32x4 w0 = *(const f32x4*)(P.xk_norm_w + ch * 8), w1 = *(const f32x4*)(P.xk_norm_w + ch * 8 + 4);
        w0 *= *(const f32x4*)(P.xq_norm_w + ch * 8); w1 *= *(const f32x4*)(P.xq_norm_w + ch * 8 + 4);
        v4u o; o.x = pk2(a * rr * w0.x, b * rr * w0.y); o.y = pk2(c * rr * w0.z, d * rr * w0.w); o.z = pk2(e * rr * w1.x, f * rr * w1.y); o.w = pk2(g2 * rr * w1.z, k * rr * w1.w);
        *(v4u*)p = o;
    }
}
DI void p9_quant_h(const Ptrs& P, int gw, int NGW, int lane) {
    const f32x4 w0 = *(const f32x4*)(P.ffn_norm_w + 16 * lane), w1 = *(const f32x4*)(P.ffn_norm_w + 16 * lane + 4), w2 = *(const f32x4*)(P.ffn_norm_w + 16 * lane + 8), w3 = *(const f32x4*)(P.ffn_norm_w + 16 * lane + 12);
    for (int t0 = 4 * gw; t0 < NTOK; t0 += 4 * NGW) {
        v4u ha[4], hb[4];
#pragma unroll
        for (int q = 0; q < 4; ++q) { ha[q] = *(const v4u*)(P.HN + (size_t)(t0 + q) * DM + 16 * lane); hb[q] = *(const v4u*)(P.HN + (size_t)(t0 + q) * DM + 16 * lane + 8); }
#pragma unroll
        for (int q = 0; q < 4; ++q) {
            const float h0 = bflo(ha[q].x) * w0.x, h1 = bfhi(ha[q].x) * w0.y, h2 = bflo(ha[q].y) * w0.z, h3 = bfhi(ha[q].y) * w0.w, h4 = bflo(ha[q].z) * w1.x, h5 = bfhi(ha[q].z) * w1.y, h6 = bflo(ha[q].w) * w1.z, h7 = bfhi(ha[q].w) * w1.w;
            const float h8 = bflo(hb[q].x) * w2.x, h9 = bfhi(hb[q].x) * w2.y, h10 = bflo(hb[q].y) * w2.z, h11 = bfhi(hb[q].y) * w2.w, h12 = bflo(hb[q].z) * w3.x, h13 = bfhi(hb[q].z) * w3.y, h14 = bflo(hb[q].w) * w3.z, h15 = bfhi(hb[q].w) * w3.w;
            float mx = fmaxf(fmaxf(fmaxf(fabsf(h0), fabsf(h1)), fmaxf(fabsf(h2), fabsf(h3))), fmaxf(fmaxf(fabsf(h4), fabsf(h5)), fmaxf(fabsf(h6), fabsf(h7))));
            mx = fmaxf(mx, fmaxf(fmaxf(fmaxf(fabsf(h8), fabsf(h9)), fmaxf(fabsf(h10), fabsf(h11))), fmaxf(fmaxf(fabsf(h12), fabsf(h13)), fmaxf(fabsf(h14), fabsf(h15)))));
            mx = wave_max_u(mx);
            const float inv = mx > 0.f ? 127.0f / mx : 0.f;
            const v4u o = {q8x4(h0, h1, h2, h3, inv), q8x4(h4, h5, h6, h7, inv), q8x4(h8, h9, h10, h11, inv), q8x4(h12, h13, h14, h15, inv)};
            *(v4u*)(P.H8 + (size_t)(t0 + q) * DM + 16 * lane) = o;
            if (lane == 0) P.SH[t0 + q] = mx * (1.0f / 127.0f);
        }
    }
}

DI s16x4 tr_read(LAS const char* p) { return __builtin_bit_cast(s16x4, __builtin_amdgcn_ds_read_tr16_b64_v4i16((LAS s16x4*)p)); }
DI bf16x8 pack8a(const f32x16& x) { v4u p; p.x = pk2(x[0], x[1]); p.y = pk2(x[2], x[3]); p.z = pk2(x[4], x[5]); p.w = pk2(x[6], x[7]); return __builtin_bit_cast(bf16x8, p); }
DI bf16x8 pack8b(const f32x16& x) { v4u p; p.x = pk2(x[8], x[9]); p.y = pk2(x[10], x[11]); p.z = pk2(x[12], x[13]); p.w = pk2(x[14], x[15]); return __builtin_bit_cast(bf16x8, p); }
DI float max16(const f32x16& x) {
    float a = fmaxf(fmaxf(x[0], x[1]), fmaxf(x[2], x[3])), b = fmaxf(fmaxf(x[4], x[5]), fmaxf(x[6], x[7]));
    float c = fmaxf(fmaxf(x[8], x[9]), fmaxf(x[10], x[11])), d = fmaxf(fmaxf(x[12], x[13]), fmaxf(x[14], x[15]));
    return fmaxf(fmaxf(a, b), fmaxf(c, d));
}
DI float sum16(const f32x16& x) {
    return (((x[0] + x[1]) + (x[2] + x[3])) + ((x[4] + x[5]) + (x[6] + x[7]))) + (((x[8] + x[9]) + (x[10] + x[11])) + ((x[12] + x[13]) + (x[14] + x[15])));
}
template <int DH>
DI void qk_tile(LAS const char* ksm, const bf16x8* qf, f32x16& s0, f32x16& s1, int lane) {
    constexpr int KP = (DH + 8) * 2;
    LAS const char* kp = ksm + (lane & 31) * KP + (lane >> 5) * 16;
#pragma unroll
    for (int i = 0; i < 16; ++i) { s0[i] = 0.f; s1[i] = 0.f; }
#pragma unroll
    for (int d0 = 0; d0 < DH / 16; ++d0) {
        const bf16x8 a0 = *(LAS const bf16x8*)(kp + d0 * 32);
        const bf16x8 a1 = *(LAS const bf16x8*)(kp + 32 * KP + d0 * 32);
        s0 = MFMA32(a0, qf[d0], s0); s1 = MFMA32(a1, qf[d0], s1);
        if ((d0 & 3) == 3) __builtin_amdgcn_sched_barrier(0);
    }
}
template <int DH, int ND>
DI void pv_tile(LAS const char* vsm, const f32x16& p0, const f32x16& p1, f32x16* o, int dbase, int lane) {
    constexpr int VP = (DH + 32) * 2;
    const int h = lane >> 5, q4 = (lane & 15) >> 2, p = lane & 3, blk = (lane >> 4) & 1;
    LAS const char* vp = vsm + (4 * h + q4) * VP + (dbase + 16 * blk) * 2 + 8 * p;
    const bf16x8 pb0 = pack8a(p0), pb1 = pack8b(p0), pb2 = pack8a(p1), pb3 = pack8b(p1);
#pragma unroll
    for (int db = 0; db < ND; ++db) {
#define PV_STEP(S4, PB) { const s16x4 lo = tr_read(vp + (16 * (S4)) * VP + db * 64), hi = tr_read(vp + (16 * (S4) + 8) * VP + db * 64); \
        const bf16x8 va = __builtin_shufflevector(lo, hi, 0, 1, 2, 3, 4, 5, 6, 7); o[db] = MFMA32(va, PB, o[db]); }
        PV_STEP(0, pb0) PV_STEP(1, pb1) PV_STEP(2, pb2) PV_STEP(3, pb3)
        __builtin_amdgcn_sched_barrier(0);
#undef PV_STEP
    }
}
template <int DH, int ND>
DI void pv_tile_packed(LAS const char* vsm, const bf16x8& pb0, const bf16x8& pb1, const bf16x8& pb2, const bf16x8& pb3, f32x16* o, int dbase, int lane) {
    constexpr int VP = (DH + 32) * 2;
    const int h = lane >> 5, q4 = (lane & 15) >> 2, p = lane & 3, blk = (lane >> 4) & 1;
    LAS const char* vp = vsm + (4 * h + q4) * VP + (dbase + 16 * blk) * 2 + 8 * p;
#pragma unroll
    for (int db = 0; db < ND; ++db) {
#define PV_STEP(S4, PB) { const s16x4 lo = tr_read(vp + (16 * (S4)) * VP + db * 64), hi = tr_read(vp + (16 * (S4) + 8) * VP + db * 64); \
        const bf16x8 va = __builtin_shufflevector(lo, hi, 0, 1, 2, 3, 4, 5, 6, 7); o[db] = MFMA32(va, PB, o[db]); }
        PV_STEP(0, pb0) PV_STEP(1, pb1) PV_STEP(2, pb2) PV_STEP(3, pb3)
        __builtin_amdgcn_sched_barrier(0);
#undef PV_STEP
    }
}
DI void mask_tile(f32x16& s0, f32x16& s1, int klo, int khi, int h) {
    int hh = 4 * h; asm volatile("" : "+v"(hh));
    const int kl = klo - hh, kh = khi - hh;
#pragma unroll
    for (int i = 0; i < 16; ++i) { const int c0 = (i & 3) + 8 * (i >> 2), c1 = 32 + c0;
        s0[i] = (c0 >= kl && c0 <= kh) ? s0[i] : -INFINITY; s1[i] = (c1 >= kl && c1 <= kh) ? s1[i] : -INFINITY; }
}
DI float fmax3(float a, float b, float c) { float r; asm("v_max3_f32 %0, %1, %2, %3" : "=v"(r) : "v"(a), "v"(b), "v"(c)); return r; }
DI float max32(const f32x16& a, const f32x16& b) {
    float t0 = fmax3(a[0], a[1], a[2]), t1 = fmax3(a[3], a[4], a[5]), t2 = fmax3(a[6], a[7], a[8]), t3 = fmax3(a[9], a[10], a[11]), t4 = fmax3(a[12], a[13], a[14]);
    float u0 = fmax3(b[0], b[1], b[2]), u1 = fmax3(b[3], b[4], b[5]), u2 = fmax3(b[6], b[7], b[8]), u3 = fmax3(b[9], b[10], b[11]), u4 = fmax3(b[12], b[13], b[14]);
    t0 = fmax3(t0, t1, t2); t3 = fmax3(t3, t4, a[15]); u0 = fmax3(u0, u1, u2); u3 = fmax3(u3, u4, b[15]);
    return fmax3(fmax3(t0, t3, u0), u3, u3);
}
DI float max16t(const f32x16& a) {
    const float t0 = fmax3(a[0], a[1], a[2]), t1 = fmax3(a[3], a[4], a[5]), t2 = fmax3(a[6], a[7], a[8]), t3 = fmax3(a[9], a[10], a[11]), t4 = fmax3(a[12], a[13], a[14]);
    return fmax3(fmax3(t0, t1, t2), fmax3(t3, t4, a[15]), t0);
}
template <int ND>
DI void softmax_tile(f32x16& s0, f32x16& s1, f32x16* o, float& m, float& l, float dead) {
    float mx = max32(s0, s1); { const auto rr = __builtin_amdgcn_permlane32_swap(__float_as_uint(mx), __float_as_uint(mx), false, false); mx = fmax3(__uint_as_float(rr[0]), __uint_as_float(rr[1]), mx); }
    const float mn = fmaxf(m, mx), alpha = __builtin_amdgcn_exp2f(m - mn), mnd = mn + dead;
    s0 = s0 - mnd; s1 = s1 - mnd;
#pragma unroll
    for (int i = 0; i < 16; ++i) { s0[i] = __builtin_amdgcn_exp2f(s0[i]); s1[i] = __builtin_amdgcn_exp2f(s1[i]); }
    const f32x16 t = s0 + s1;
    float rs = sum16(t); { const auto rr = __builtin_amdgcn_permlane32_swap(__float_as_uint(rs), __float_as_uint(rs), false, false); rs = __uint_as_float(rr[0]) + __uint_as_float(rr[1]); }
    l = l * alpha + rs; m = mn;
#pragma unroll
    for (int db = 0; db < ND; ++db) o[db] *= alpha;
}
template <int DH>
DI void qk_tile_c(LAS const char* ksm, const bf16x8* qf, const f32x16& cinit, f32x16& s0, f32x16& s1, int lane) {
    constexpr int KP = (DH + 8) * 2;
    LAS const char* kp = ksm + (lane & 31) * KP + (lane >> 5) * 16;
    s0 = MFMA32(*(LAS const bf16x8*)(kp), qf[0], cinit); s1 = MFMA32(*(LAS const bf16x8*)(kp + 32 * KP), qf[0], cinit);
#pragma unroll
    for (int d0 = 1; d0 < DH / 16; ++d0) {
        const bf16x8 a0 = *(LAS const bf16x8*)(kp + d0 * 32);
        const bf16x8 a1 = *(LAS const bf16x8*)(kp + 32 * KP + d0 * 32);
        s0 = MFMA32(a0, qf[d0], s0); s1 = MFMA32(a1, qf[d0], s1);
    }
}
template <int ND>
DI void softmax_tile_ref(f32x16& s0, f32x16& s1, f32x16* o, float& negm, float& l) {
    float mx = max32(s0, s1); { const auto rr = __builtin_amdgcn_permlane32_swap(__float_as_uint(mx), __float_as_uint(mx), false, false); mx = fmax3(__uint_as_float(rr[0]), __uint_as_float(rr[1]), mx); }
    if (__any(mx > 8.0f)) {
        const float delta = mx > 8.0f ? mx : 0.f, f = __builtin_amdgcn_exp2f(-delta);
        s0 = s0 - delta; s1 = s1 - delta; negm = negm - delta; l *= f;
#pragma unroll
        for (int db = 0; db < ND; ++db) o[db] *= f;
    }
#pragma unroll
    for (int i = 0; i < 16; ++i) { s0[i] = __builtin_amdgcn_exp2f(s0[i]); s1[i] = __builtin_amdgcn_exp2f(s1[i]); }
    const f32x16 t = s0 + s1;
    float rs = sum16(t); { const auto rr = __builtin_amdgcn_permlane32_swap(__float_as_uint(rs), __float_as_uint(rs), false, false); rs = __uint_as_float(rr[0]) + __uint_as_float(rr[1]); }
    l += rs;
}
template <int DH>
DI void load_q_frags(const bf16* qrow, const float* w, float scale, bf16x8* qf, int lane) {
    const int h = lane >> 5;
    v4u raw[DH / 16]; float ss = 0.f;
#pragma unroll
    for (int d0 = 0; d0 < DH / 16; ++d0) { raw[d0] = *(const v4u*)(qrow + 16 * d0 + 8 * h);
        const float a = bflo(raw[d0].x), b = bfhi(raw[d0].x), c = bflo(raw[d0].y), d = bfhi(raw[d0].y), e = bflo(raw[d0].z), f = bfhi(raw[d0].z), g = bflo(raw[d0].w), k = bfhi(raw[d0].w);
        ss += ((a * a + b * b) + (c * c + d * d)) + ((e * e + f * f) + (g * g + k * k)); }
    ss += __shfl_xor(ss, 32);
    const float r = scale / sqrtf(ss * (1.f / DH) + EPS);
#pragma unroll
    for (int d0 = 0; d0 < DH / 16; ++d0) { const f32x4 w0 = *(const f32x4*)(w + 16 * d0 + 8 * h), w1 = *(const f32x4*)(w + 16 * d0 + 8 * h + 4);
        v4u o; o.x = pk2(bflo(raw[d0].x) * r * w0.x, bfhi(raw[d0].x) * r * w0.y); o.y = pk2(bflo(raw[d0].y) * r * w0.z, bfhi(raw[d0].y) * r * w0.w);
        o.z = pk2(bflo(raw[d0].z) * r * w1.x, bfhi(raw[d0].z) * r * w1.y); o.w = pk2(bflo(raw[d0].w) * r * w1.z, bfhi(raw[d0].w) * r * w1.w);
        qf[d0] = __builtin_bit_cast(bf16x8, o); }
}
template <int DH>
DI void tile_gload(const bf16* base, size_t pitch, v4u* regs, int tid) {
    constexpr int CPR = DH / 8;
#pragma unroll
    for (int k = 0; k < DH / 64; ++k) { const int id = tid + NTHR * k, row = id / CPR, ch = id % CPR; regs[k] = *(const v4u*)(base + (size_t)row * pitch + ch * 8); }
}
template <int DH, int PADE>
DI void tile_lstore(LAS char* sm, const v4u* regs, int tid) {
    constexpr int CPR = DH / 8, PB = (DH + PADE) * 2;
#pragma unroll
    for (int k = 0; k < DH / 64; ++k) { const int id = tid + NTHR * k, row = id / CPR, ch = id % CPR; *(LAS v4u*)(sm + row * PB + ch * 16) = regs[k]; }
}
DI float sigmoidf_(float x) { return 1.0f / (1.0f + __expf(-x)); }

DI void nsa_tile_fused(LAS const char* ksm, LAS const char* vsm, const bf16x8* qf, const f32x16& c0, f32x16* o, float& nref, float& l, int lane) {
    constexpr int KP = 144, VP = 192;
    LAS const char* kp = ksm + (lane & 31) * KP + (lane >> 5) * 16;
    const int h = lane >> 5, q4 = (lane & 15) >> 2, p = lane & 3, blk = (lane >> 4) & 1;
    LAS const char* vp = vsm + (4 * h + q4) * VP + (16 * blk) * 2 + 8 * p;
    f32x16 s0 = MFMA32(*(LAS const bf16x8*)(kp), qf[0], c0);
#pragma unroll
    for (int d0 = 1; d0 < 4; ++d0) s0 = MFMA32(*(LAS const bf16x8*)(kp + d0 * 32), qf[d0], s0);
    f32x16 s1 = MFMA32(*(LAS const bf16x8*)(kp + 32 * KP), qf[0], c0);
#pragma unroll
    for (int d0 = 1; d0 < 4; ++d0) s1 = MFMA32(*(LAS const bf16x8*)(kp + 32 * KP + d0 * 32), qf[d0], s1);
#define PV_STEP(S4, PB, DB) { const s16x4 lo = tr_read(vp + (16 * (S4)) * VP + (DB) * 64), hi = tr_read(vp + (16 * (S4) + 8) * VP + (DB) * 64); \
        const bf16x8 va = __builtin_shufflevector(lo, hi, 0, 1, 2, 3, 4, 5, 6, 7); o[DB] = MFMA32(va, PB, o[DB]); }
#pragma unroll
    for (int i = 0; i < 16; ++i) s0[i] = __builtin_amdgcn_exp2f(s0[i]);
    float rs = sum16(s0);
    { const bf16x8 pb0 = pack8a(s0), pb1 = pack8b(s0);
      PV_STEP(0, pb0, 0) PV_STEP(1, pb1, 0) PV_STEP(0, pb0, 1) PV_STEP(1, pb1, 1) }
#pragma unroll
    for (int i = 0; i < 16; ++i) s1[i] = __builtin_amdgcn_exp2f(s1[i]);
    rs += sum16(s1);
    { const bf16x8 pb2 = pack8a(s1), pb3 = pack8b(s1);
      PV_STEP(2, pb2, 0) PV_STEP(3, pb3, 0) PV_STEP(2, pb2, 1) PV_STEP(3, pb3, 1) }
#undef PV_STEP
    { const auto rr = __builtin_amdgcn_permlane32_swap(__float_as_uint(rs), __float_as_uint(rs), false, false); rs = __uint_as_float(rr[0]) + __uint_as_float(rr[1]); }
    l += rs;
    if (__any(l > 65536.0f)) {
        const unsigned e = l > 65536.0f ? (__float_as_uint(l) >> 23) - 127u : 0u;
        const float f = __uint_as_float((127u - e) << 23);
        nref -= (float)e; l *= f; o[0] *= f; o[1] *= f;
    }
}
constexpr int NSA_K_OFF = 0, NSA_V_OFF = 18432, NSA_IMP_OFF = 43008, NSA_IMP_PITCH = 36, NSA_SEL_OFF = NSA_IMP_OFF + 4 * 64 * NSA_IMP_PITCH * 4, NSA_TOT_OFF = NSA_SEL_OFF + 256;
template <int NQ>
DI void nsa_cmp_branch(LAS const char* ksm, LAS const char* vsm, LAS float* imph, const bf16x8* qf, int tpos, float gate0, LAS char* totp, int lane) {
    constexpr int KP = 144, VP = 192;
    const int h = lane >> 5;
    f32x16 s[NQ];
    qk_tile<64>(ksm, qf, s[0], s[1], lane);
    if (NQ == 4) qk_tile<64>(ksm + 64 * KP, qf, s[NQ - 2], s[NQ - 1], lane);
    const int nmax = tpos >= 31 ? min(126, (tpos - 31) >> 4) : -1;
    float mx = -INFINITY;
    int hh = 4 * h; asm volatile("" : "+v"(hh));
    const int nm = nmax - hh;
#pragma unroll
    for (int q = 0; q < NQ; ++q)
#pragma unroll
        for (int i = 0; i < 16; ++i) { const int c = 32 * q + (i & 3) + 8 * (i >> 2); s[q][i] = (c <= nm) ? s[q][i] : -INFINITY; mx = fmaxf(mx, s[q][i]); }
    { const auto rr = __builtin_amdgcn_permlane32_swap(__float_as_uint(mx), __float_as_uint(mx), false, false); mx = fmaxf(__uint_as_float(rr[0]), __uint_as_float(rr[1])); }
    const float mm = (mx == -INFINITY) ? 0.f : mx;
    float rs = 0.f;
#pragma unroll
    for (int q = 0; q < NQ; ++q) {
#pragma unroll
        for (int i = 0; i < 16; ++i) s[q][i] = __builtin_amdgcn_exp2f(s[q][i] - mm);
        rs += sum16(s[q]); }
    { const auto rr = __builtin_amdgcn_permlane32_swap(__float_as_uint(rs), __float_as_uint(rs), false, false); rs = __uint_as_float(rr[0]) + __uint_as_float(rr[1]); }
    const float inv = rs > 0.f ? 1.0f / rs : 0.f;
    if (NQ == 4) {
        LAS float* ip = imph + h;
#pragma unroll
        for (int G = 0; G < 16; ++G) { const int q = G >> 2, g4 = G & 3;
            const float sum4 = (s[q][4 * g4] + s[q][4 * g4 + 1]) + (s[q][4 * g4 + 2] + s[q][4 * g4 + 3]);
            const float last = s[q][4 * g4 + 3], prev = G ? s[(G - 1) >> 2][4 * ((G - 1) & 3) + 3] : 0.f;
            const auto rr = __builtin_amdgcn_permlane32_swap(__float_as_uint(prev), __float_as_uint(last), false, false);
            const float extra = h ? __uint_as_float(rr[0]) : __uint_as_float(rr[1]);
            ip[2 * G] = (sum4 + extra) * inv; }
    }
    f32x16 oc[2];
#pragma unroll
    for (int i = 0; i < 16; ++i) { oc[0][i] = 0.f; oc[1][i] = 0.f; }
    pv_tile<64, 2>(vsm, s[0], s[1], oc, 0, lane);
    if (NQ == 4) pv_tile<64, 2>(vsm + 64 * VP, s[NQ - 2], s[NQ - 1], oc, 0, lane);
    const float f = gate0 * inv;
#pragma unroll
    for (int c = 0; c < 8; ++c) { const f32x16& x = oc[c >> 2]; const int e = 4 * (c & 3); *(LAS f32x4*)(totp + c * 1024) = (f32x4){x[e] * f, x[e + 1] * f, x[e + 2] * f, x[e + 3] * f}; }
}
template <int MODE>
DI void nsa_unit(const Ptrs& P, LAS unsigned char* lds, int b, int g, int qi, int tid, int wave, int lane) {
    constexpr int KP = 144, VP = 192;
    const int r = lane & 31, h = lane >> 5;
    const int hd = g * 4 + (wave >> 1), tl = 32 * (wave & 1) + r;
    const size_t tok = (size_t)b * SEQ + 64 * qi + tl;
    const int tpos = 64 * qi + tl;
    LAS char* ksm = (LAS char*)lds + NSA_K_OFF; LAS char* vsm = (LAS char*)lds + NSA_V_OFF;
    LAS float* imp = (LAS float*)(lds + NSA_IMP_OFF); LAS unsigned* selm = (LAS unsigned*)(lds + NSA_SEL_OFF);
    v4u ckr[2], cvr[2];
    { const bf16* kc = P.KCMP + (size_t)(b * 2 + g) * 128 * 64; const bf16* vc = P.VCMP + (size_t)(b * 2 + g) * 128 * 64;
#pragma unroll
      for (int k = 0; k < 2; ++k) { const int id = tid + NTHR * k, row = id >> 3, ch = id & 7; ckr[k] = *(const v4u*)(kc + row * 64 + ch * 8); cvr[k] = *(const v4u*)(vc + row * 64 + ch * 8); } }
    const bf16* kvbase = P.PROJ + (size_t)b * SEQ * INP + g * 64;
    v4u kreg[1], vreg[1];
    tile_gload<64>(kvbase + C_KS, INP, kreg, tid); tile_gload<64>(kvbase + C_VS, INP, vreg, tid);
    bf16x8 qf[4];
    load_q_frags<64>(P.PROJ + tok * INP + C_Q + hd * 64, P.q_norm_w, 0.125f * LOG2E, qf, lane);
    float gate[3];
#pragma unroll
    for (int br = 0; br < 3; ++br) gate[br] = sigmoidf_(bf2f(P.PROJ[tok * INP + C_G + hd * 3 + br]));
    LAS char* totp = (LAS char*)lds + NSA_TOT_OFF + (wave * 512 + lane) * 16;

    __syncthreads();
    {
#pragma unroll
        for (int k = 0; k < 2; ++k) { const int id = tid + NTHR * k, row = id >> 3, ch = id & 7;
            *(LAS v4u*)(ksm + row * KP + ch * 16) = ckr[k]; *(LAS v4u*)(vsm + row * VP + ch * 16) = cvr[k]; }
    }
    __syncthreads();
    if (qi >= 16) nsa_cmp_branch<4>(ksm, vsm, imp + ((wave >> 1) * 64 + tl) * NSA_IMP_PITCH, qf, tpos, gate[0], totp, lane);
    else nsa_cmp_branch<2>(ksm, vsm, imp, qf, tpos, gate[0], totp, lane);
    __syncthreads();
    {
        const int tk = tid >> 3, sub = tid & 7;
        unsigned bits;
        if (qi >= 16) {
            float v[32];
#pragma unroll
            for (int c = 0; c < 8; ++c) { LAS const float* ip = imp + tk * NSA_IMP_PITCH + 4 * c;
                const f32x4 a = *(LAS const f32x4*)ip, b2 = *(LAS const f32x4*)(ip + 64 * NSA_IMP_PITCH), c2 = *(LAS const f32x4*)(ip + 128 * NSA_IMP_PITCH), d2 = *(LAS const f32x4*)(ip + 192 * NSA_IMP_PITCH);
                const f32x4 t = (a + b2) + (c2 + d2);
#pragma unroll
                for (int e = 0; e < 4; ++e) { const int j2 = 4 * c + e; v[j2] = (j2 >= 1 && j2 <= qi - 2) ? t[e] : -1.0f; } }
            bits = 0u;
#pragma unroll
            for (int k = 0; k < 4; ++k) { const int j = sub + 8 * k;
                float vj = v[8 * k];
#pragma unroll
                for (int t = 1; t < 8; ++t) vj = (sub == t) ? v[8 * k + t] : vj;
                int rank = 0;
#pragma unroll
                for (int j2 = 0; j2 < 32; ++j2) {
                    if ((j2 >> 3) < k) rank += (v[j2] >= vj) ? 1 : 0;
                    else if ((j2 >> 3) > k) rank += (v[j2] > vj) ? 1 : 0;
                    else rank += (v[j2] > vj || (v[j2] == vj && (j2 & 7) < sub)) ? 1 : 0; }
                if (j >= 1 && j <= qi - 2 && rank < 13) bits |= 1u << j; }
            bits |= __shfl_xor(bits, 1); bits |= __shfl_xor(bits, 2); bits |= __shfl_xor(bits, 4);
            bits |= 1u | (1u << qi) | (1u << (qi - 1));
        } else bits = (2u << qi) - 1u;
        if (sub == 0) selm[tk] = bits;
    }
    const int nsel = qi + 1, nwin = min(9, qi + 1), ntiles = nsel + nwin;
    f32x16 o[2]; float l = 0.f, nref = 0.f;
#pragma unroll
    for (int i = 0; i < 16; ++i) { o[0][i] = 0.f; o[1][i] = 0.f; }
    unsigned mysel = 0u;
    for (int tt = 0; tt < (MODE >= 5 ? 0 : ntiles); ++tt) {
        if (MODE != 2 || tt == 0) {
        __syncthreads();
        tile_lstore<64, 8>(ksm, kreg, tid); tile_lstore<64, 32>(vsm, vreg, tid);
        __syncthreads(); }
        if (tt == 0) mysel = selm[tl];
        if (MODE != 2 && tt + 1 < ntiles) { const int t2 = tt + 1; const bool w2 = t2 >= nsel; const int j2 = w2 ? qi - (t2 - nsel) : t2;
            tile_gload<64>(kvbase + (size_t)j2 * 64 * INP + (w2 ? C_KW : C_KS), INP, kreg, tid);
            tile_gload<64>(kvbase + (size_t)j2 * 64 * INP + (w2 ? C_VW : C_VS), INP, vreg, tid); }
        const bool win = tt >= nsel; const int j = win ? qi - (tt - nsel) : tt;
        if (tt == nsel) {
            const float f = l > 0.f ? gate[1] / l : 0.f;
#pragma unroll
            for (int c = 0; c < 8; ++c) { const f32x16& x = o[c >> 2]; const int e = 4 * (c & 3); LAS f32x4* tp = (LAS f32x4*)(totp + c * 1024); *tp = *tp + (f32x4){x[e] * f, x[e + 1] * f, x[e + 2] * f, x[e + 3] * f}; }
#pragma unroll
            for (int i = 0; i < 16; ++i) { o[0][i] = 0.f; o[1][i] = 0.f; }
            l = 0.f; nref = 0.f;
        }
        if (MODE == 1) continue;
        const bool dead = !win && !((mysel >> j) & 1u);
        f32x16 c0;
        { const float cv = dead ? -INFINITY : nref;
#pragma unroll
          for (int i = 0; i < 16; ++i) c0[i] = cv; }
        if (j == qi || (win && j == qi - 8)) {
            f32x16 s0, s1;
            qk_tile_c<64>(ksm, qf, c0, s0, s1, lane);
            int klo = 0, khi = 63;
            if (j == qi) khi = tl; else klo = tl + 1;
            mask_tile(s0, s1, klo, khi, h);
            softmax_tile_ref<2>(s0, s1, o, nref, l);
            pv_tile<64, 2>(vsm, s0, s1, o, 0, lane);
        } else nsa_tile_fused(ksm, vsm, qf, c0, o, nref, l, lane);
    }
    { const float f = l > 0.f ? gate[2] / l : 0.f;
      bf16* op = P.YMIX + tok * DM + 512 + hd * 64 + 4 * h;
#pragma unroll
      for (int c = 0; c < 8; ++c) { const f32x16& x = o[c >> 2]; const int e = 4 * (c & 3); const f32x4 t = *(LAS const f32x4*)(totp + c * 1024) + (f32x4){x[e] * f, x[e + 1] * f, x[e + 2] * f, x[e + 3] * f};
          v2u w; w.x = pk2(t[0], t[1]); w.y = pk2(t[2], t[3]);
          *(v2u*)(op + 32 * (c >> 2) + 8 * (c & 3)) = w; } }
}
template <int MODE>
DI void p3_nsa(const Ptrs& P, LAS unsigned char* lds, int vcu, int G, int tid, int wave, int lane) {
    for (int v = vcu; v < 256; v += G) {
        const int bg = v >> 3, s = v & 7;
#pragma unroll 1
        for (int k = 0; k < 4; ++k) { const int qi = (k == 0) ? 31 - s : (k == 1) ? 16 + s : (k == 2) ? 15 - s : s;
            nsa_unit<MODE>(P, lds, bg >> 1, bg & 1, qi, tid, wave, lane); }
    }
}

constexpr int XA_Q_OFF = 0, XA_K_OFF = 67584, XA_V_OFF = 101376, XA_XP_OFF = 138240, XA_XR_OFF = XA_XP_OFF + 16384;
DI void xattn_unit(const Ptrs& P, LAS unsigned char* lds, int b, int hd, int qt, int tid, int wave, int lane) {
    constexpr int KP = 528, VP = 576;
    const int r = lane & 31, h = lane >> 5, rb = wave >> 1, kh = wave & 1;
    const size_t tok0 = (size_t)b * SEQ + 128 * qt;
    LAS char* qsm = (LAS char*)lds + XA_Q_OFF; LAS char* ksm = (LAS char*)lds + XA_K_OFF; LAS char* vsm = (LAS char*)lds + XA_V_OFF;
    LAS const char* qrow = qsm + (32 * rb + r) * KP + h * 16;
    LAS char* xw = (LAS char*)lds + XA_XP_OFF + (wave * 64 + lane) * 16;
    LAS const char* xr0 = (LAS const char*)lds + XA_XP_OFF + (rb * 128 + lane) * 16;
    LAS float* xs = (LAS float*)(lds + XA_XR_OFF);
    const bf16* kb = P.XKV + (size_t)b * MEMT * 2048 + hd * 256; const bf16* vb = kb + 1024;
    v4u kreg[4], vreg[4];
    tile_gload<256>(kb, 2048, kreg, tid); tile_gload<256>(vb, 2048, vreg, tid);
    f32x4 sp0, sp1, sp2, sp3;
    { const float* sp = P.SSP1 + (tok0 + 32 * rb + r) * 16; sp0 = *(const f32x4*)sp; sp1 = *(const f32x4*)(sp + 4); sp2 = *(const f32x4*)(sp + 8); sp3 = *(const f32x4*)(sp + 12); }
    {
        const bf16* qb = P.XQ + tok0 * DM + hd * 256;
        v4u qreg[8];
#pragma unroll
        for (int k = 0; k < 8; ++k) { const int id = tid + NTHR * k, row = id >> 5, ch = id & 31; qreg[k] = *(const v4u*)(qb + (size_t)row * DM + ch * 8); }
        __syncthreads();
#pragma unroll
        for (int k = 0; k < 8; ++k) { const int id = tid + NTHR * k, row = id >> 5, ch = id & 31; *(LAS v4u*)(qsm + row * KP + ch * 16) = qreg[k]; }
    }
    f32x16 o[4]; float nref = 0.f, l = 0.f, cq = 0.f;
#pragma unroll
    for (int db = 0; db < 4; ++db)
#pragma unroll
        for (int i = 0; i < 16; ++i) o[db][i] = 0.f;
#pragma unroll 1
    for (int tt = 0; tt < 4; ++tt) {
        if (tt > 0) __syncthreads();
        tile_lstore<256, 8>(ksm, kreg, tid); tile_lstore<256, 32>(vsm, vreg, tid);
        __syncthreads();
        if (tt + 1 < 4) { tile_gload<256>(kb + (size_t)(tt + 1) * 64 * 2048, 2048, kreg, tid); tile_gload<256>(vb + (size_t)(tt + 1) * 64 * 2048, 2048, vreg, tid); }
        if (tt == 0) {
            float ss = 0.f;
#pragma unroll
            for (int d0 = 0; d0 < 16; ++d0) { const v4u u = *(LAS const v4u*)(qrow + d0 * 32);
                const float a = bflo(u.x), b2 = bfhi(u.x), c = bflo(u.y), d = bfhi(u.y), e = bflo(u.z), f = bfhi(u.z), g = bflo(u.w), k = bfhi(u.w);
                ss += ((a * a + b2 * b2) + (c * c + d * d)) + ((e * e + f * f) + (g * g + k * k)); }
            ss += __shfl_xor(ss, 32);
            const f32x4 p0 = sp0, p1 = sp1, p2 = sp2, p3 = sp3;
            const float rt = 1.0f / sqrtf((((p0.x + p0.y) + (p0.z + p0.w)) + ((p1.x + p1.y) + (p1.z + p1.w)) + ((p2.x + p2.y) + (p2.z + p2.w)) + ((p3.x + p3.y) + (p3.z + p3.w))) * (1.f / DM) + EPS);
            cq = 0.0625f * LOG2E * rt / sqrtf(rt * rt * ss * (1.f / 256.f) + EPS);
        }
        f32x16 s;
        {
            LAS const char* kp = ksm + (32 * kh + r) * KP + h * 16;
#pragma unroll
            for (int i = 0; i < 16; ++i) s[i] = 0.f;
#pragma unroll
            for (int d0 = 0; d0 < 16; ++d0) {
                const bf16x8 a0 = *(LAS const bf16x8*)(kp + d0 * 32), bq = *(LAS const bf16x8*)(qrow + d0 * 32);
                s = MFMA32(a0, bq, s);
                if ((d0 & 3) == 3) __builtin_amdgcn_sched_barrier(0);
            }
        }
        s = s * cq + nref;
#pragma unroll
        for (int i = 0; i < 16; ++i) s[i] = __builtin_amdgcn_exp2f(s[i]);
        { float rs = sum16(s); { const auto rr = __builtin_amdgcn_permlane32_swap(__float_as_uint(rs), __float_as_uint(rs), false, false); rs = __uint_as_float(rr[0]) + __uint_as_float(rr[1]); }
          *(LAS bf16x8*)xw = pack8a(s); *(LAS bf16x8*)(xw + 8192) = pack8b(s); xs[wave * 64 + lane] = rs; }
        __syncthreads();
        {
            const bf16x8 pb0 = *(LAS const bf16x8*)xr0, pb1 = *(LAS const bf16x8*)(xr0 + 8192), pb2 = *(LAS const bf16x8*)(xr0 + 1024), pb3 = *(LAS const bf16x8*)(xr0 + 1024 + 8192);
            l += xs[rb * 128 + lane] + xs[rb * 128 + 64 + lane];
            pv_tile_packed<256, 4>(vsm, pb0, pb1, pb2, pb3, o, 128 * kh, lane);
        }
        if (__any(l > 65536.0f)) {
            const unsigned e = l > 65536.0f ? (__float_as_uint(l) >> 23) - 127u : 0u;
            const float f2 = __uint_as_float((127u - e) << 23);
            nref -= (float)e; l *= f2;
#pragma unroll
            for (int db = 0; db < 4; ++db) o[db] *= f2;
        }
    }
    const float f = 1.0f / l;
    bf16* op = P.YMIX + (tok0 + 32 * rb + r) * DM + hd * 256 + 128 * kh + 4 * h;
#pragma unroll
    for (int db = 0; db < 4; ++db)
#pragma unroll
        for (int g4 = 0; g4 < 4; ++g4) { v2u w; w.x = pk2(o[db][4 * g4] * f, o[db][4 * g4 + 1] * f); w.y = pk2(o[db][4 * g4 + 2] * f, o[db][4 * g4 + 3] * f);
            *(v2u*)(op + 32 * db + 8 * g4) = w; }
}
DI void p7_xattn(const Ptrs& P, LAS unsigned char* lds, int bx, int G, int tid, int wave, int lane) {
    pg8::StaticOrder SO; SO.init(NTOK, DM, G, bx); pg8::Unit un;
    for (int ui = 0; SO.next(ui, un); ++ui) {
        const int b = un.pm >> 3, qt0 = (un.pm & 7) * 2;
        xattn_unit(P, lds, b, un.pn, qt0, tid, wave, lane); xattn_unit(P, lds, b, un.pn, qt0 + 1, tid, wave, lane);
    }
}

DI unsigned umax3(unsigned a, unsigned b, unsigned c) { return max(max(a, b), c); }
DI unsigned umax16(const unsigned* k) {
    return umax3(umax3(umax3(k[0], k[1], k[2]), umax3(k[3], k[4], k[5]), umax3(k[6], k[7], k[8])), umax3(umax3(k[9], k[10], k[11]), umax3(k[12], k[13], k[14]), k[15]), 0u);
}
DI unsigned pair_umax(unsigned m) { const auto rr = __builtin_amdgcn_permlane32_swap(m, m, false, false); return max((unsigned)rr[0], (unsigned)rr[1]); }
DI void ce_desc(unsigned& a, unsigned& b) { const unsigned hi = max(a, b), lo = min(a, b); a = hi; b = lo; }
DI void bitonic_sort16_desc(unsigned* k) {
#pragma unroll
    for (int kk = 2; kk <= 16; kk <<= 1)
#pragma unroll
        for (int j = kk >> 1; j > 0; j >>= 1)
#pragma unroll
            for (int i = 0; i < 16; ++i) { const int l = i ^ j; if (l > i) { if ((i & kk) == 0) ce_desc(k[i], k[l]); else ce_desc(k[l], k[i]); } }
}
DI void bitonic_merge16_desc(unsigned* k) {
#pragma unroll
    for (int j = 8; j > 0; j >>= 1)
#pragma unroll
        for (int i = 0; i < 16; ++i) { const int l = i ^ j; if (l > i) ce_desc(k[i], k[l]); }
}
DI void top16_of_two_desc(unsigned* x, const unsigned* y) {
#pragma unroll
    for (int i = 0; i < 16; ++i) x[i] = max(x[i], y[15 - i]);
    bitonic_merge16_desc(x);
}
constexpr int PK_PITCH = 272;
constexpr int PK_SCR_OFF = 2 * 128 * PK_PITCH;
DI void p11_peer_topk(const Ptrs& P, LAS unsigned char* lds, int bx, int G, int tid, int wave, int lane) {
    const int r = lane & 31, h = lane >> 5;
    LAS char* ksm = (LAS char*)lds;
    LAS unsigned* tvl = (LAS unsigned*)(lds + PK_SCR_OFF + wave * 8192);
    LAS float* bsl = (LAS float*)(tvl + 1024); LAS int* bel = (LAS int*)(tvl + 1536);
    pg8::StaticOrder SO; SO.init(NTOK, 2048, G, bx); pg8::Unit un;
    for (int ui = 0; SO.next(ui, un); ++ui) {
        const int hd = un.pn;
        __syncthreads();
        {
            const bf16* kb = P.PKEYS + (size_t)hd * 2 * 128 * 128;
#pragma unroll
            for (int k = 0; k < 8; ++k) { const int id = tid + NTHR * k, row = id >> 4, ch = id & 15; *(LAS v4u*)(ksm + row * PK_PITCH + ch * 16) = *(const v4u*)(kb + row * 128 + ch * 8); }
        }
        __syncthreads();
        {
        const size_t tok = (size_t)un.pm * 256 + 32 * wave + r;
#pragma unroll 1
        for (int c = 0; c < 2; ++c) {
            bf16x8 qf[8];
#pragma unroll
            for (int d0 = 0; d0 < 8; ++d0) qf[d0] = *(const bf16x8*)(P.PQ + tok * 2048 + hd * 256 + c * 128 + 16 * d0 + 8 * h);
            unsigned key[64];
            unsigned h4 = 4u * (unsigned)h; asm volatile("" : "+v"(h4));
#pragma unroll
            for (int nb = 0; nb < 4; ++nb) {
                f32x16 sc;
#pragma unroll
                for (int i = 0; i < 16; ++i) sc[i] = 64.f;
                LAS const char* kp = ksm + (c * 128 + 32 * nb + r) * PK_PITCH + h * 16;
#pragma unroll
                for (int d0 = 0; d0 < 8; ++d0) sc = MFMA32(*(LAS const bf16x8*)(kp + d0 * 32), qf[d0], sc);
#pragma unroll
                for (int i = 0; i < 16; ++i) key[16 * nb + i] = ((__float_as_uint(sc[i]) & ~0x7Fu) | h4) | (unsigned)(32 * nb + (i & 3) + 8 * (i >> 2));
            }
            bitonic_sort16_desc(key); bitonic_sort16_desc(key + 16); bitonic_sort16_desc(key + 32); bitonic_sort16_desc(key + 48);
            top16_of_two_desc(key, key + 16); top16_of_two_desc(key + 32, key + 48); top16_of_two_desc(key, key + 32);
            unsigned pk[16];
#pragma unroll
            for (int i = 0; i < 16; ++i) { const auto rr = __builtin_amdgcn_permlane32_swap(key[i], key[i], false, false); pk[i] = h ? (unsigned)rr[0] : (unsigned)rr[1]; }
            top16_of_two_desc(key, pk);
            if (h == 0) {
#pragma unroll
                for (int k = 0; k < 16; ++k) tvl[(c * 16 + k) * 32 + r] = key[k]; }
        }
        LDS_WAIT(); asm volatile("" ::: "memory");
        float t0[16], t1[16];
#pragma unroll
        for (int k = 0; k < 16; ++k) { t0[k] = __uint_as_float(tvl[k * 32 + r] & ~0x7Fu); t1[k] = __uint_as_float(tvl[(16 + k) * 32 + r] & ~0x7Fu); }
        unsigned cand[32];
        {
            int n = 0;
#pragma unroll
            for (int a = 0; a < 16; ++a)
#pragma unroll
                for (int b = 0; b < 16; ++b)
                    if ((a + 1) * (b + 1) <= 16) {
                        const unsigned key = (__float_as_uint(t0[a] + t1[b]) & ~0xFFu) | (unsigned)(a * 16 + b);
                        if ((n & 1) == 0) cand[n >> 1] = key; else cand[n >> 1] = h ? key : cand[n >> 1];
                        ++n;
                    }
#pragma unroll
            for (int q = 25; q < 32; ++q) cand[q] = 0u;
        }
        bitonic_sort16_desc(cand); bitonic_sort16_desc(cand + 16); top16_of_two_desc(cand, cand + 16);
        { unsigned pk[16];
#pragma unroll
          for (int i = 0; i < 16; ++i) { const auto rr = __builtin_amdgcn_permlane32_swap(cand[i], cand[i], false, false); pk[i] = h ? (unsigned)rr[0] : (unsigned)rr[1]; }
          top16_of_two_desc(cand, pk); }
        if (h == 0) {
            float bs[16]; int be[16];
#pragma unroll
            for (int k = 0; k < 16; ++k) { const unsigned w = cand[k]; const int ia = (int)((w >> 4) & 15u), ib = (int)(w & 15u);
                const int e0 = (int)(tvl[ia * 32 + r] & 0x7Fu), e1 = (int)(tvl[(16 + ib) * 32 + r] & 0x7Fu);
                bs[k] = __uint_as_float(w & ~0xFFu); be[k] = e0 * 128 + e1; }
            const float* sp = P.SSP2 + tok * 16; const f32x4 p0 = *(const f32x4*)sp, p1 = *(const f32x4*)(sp + 4), p2 = *(const f32x4*)(sp + 8), p3 = *(const f32x4*)(sp + 12);
            const float rt = 1.0f / sqrtf((((p0.x + p0.y) + (p0.z + p0.w)) + ((p1.x + p1.y) + (p1.z + p1.w)) + ((p2.x + p2.y) + (p2.z + p2.w)) + ((p3.x + p3.y) + (p3.z + p3.w))) * (1.f / DM) + EPS);
            const float mx = bs[0]; float sum = 0.f;
#pragma unroll
            for (int k = 0; k < 16; ++k) { bs[k] = __expf((bs[k] - mx) * rt); sum += bs[k]; }
            const float inv = 1.0f / sum;
            int* ip = P.PIDX + tok * 128 + hd * 16; float* gp = P.PGATE + tok * 128 + hd * 16;
#pragma unroll
            for (int k4 = 0; k4 < 4; ++k4) {
                *(v4u*)(ip + 4 * k4) = (v4u){(unsigned)be[4 * k4], (unsigned)be[4 * k4 + 1], (unsigned)be[4 * k4 + 2], (unsigned)be[4 * k4 + 3]};
                *(f32x4*)(gp + 4 * k4) = (f32x4){bs[4 * k4] * inv, bs[4 * k4 + 1] * inv, bs[4 * k4 + 2] * inv, bs[4 * k4 + 3] * inv};
            }
        }
        LDS_WAIT(); asm volatile("" ::: "memory");
        }
    }
}

template <int CTRL> DI float dpp_mov(float v) { return __uint_as_float((unsigned)__builtin_amdgcn_update_dpp(0, (int)__float_as_uint(v), CTRL, 0xF, 0xF, true)); }
template <int CTRL> DI int dpp_movi(int v) { return __builtin_amdgcn_update_dpp(0, v, CTRL, 0xF, 0xF, true); }
DI int wave_sum_i(int v) {
    v += dpp_movi<0xB1>(v); v += dpp_movi<0x4E>(v); v += dpp_movi<0x141>(v); v += dpp_movi<0x140>(v);
    return (__builtin_amdgcn_readlane(v, 0) + __builtin_amdgcn_readlane(v, 16)) + (__builtin_amdgcn_readlane(v, 32) + __builtin_amdgcn_readlane(v, 48));
}
DI float wave_max_f(float v) {
    v = fmaxf(v, dpp_mov<0xB1>(v)); v = fmaxf(v, dpp_mov<0x4E>(v)); v = fmaxf(v, dpp_mov<0x141>(v)); v = fmaxf(v, dpp_mov<0x140>(v));
    return fmaxf(fmaxf(rlane(v, 0), rlane(v, 16)), fmaxf(rlane(v, 32), rlane(v, 48)));
}
DI float gelu_as(float v) {
    const float av = fabsf(v), t = __builtin_amdgcn_rcpf(av * 0.2316418882f + 1.0f);
    float q = t * 0.5307027145f + (-0.7265760135f); q = q * t + 0.7107068705f; q = q * t + (-0.142248368f); q = q * t + 0.127414796f; q = q * t;
    const float e = __builtin_amdgcn_exp2f((v * v) * (-0.72134752044f)), m = v * (q * e);
    return v < 0.f ? m : v - m;
}
DI int dot16_i8(const v4u& a, const v4u& b) {
    int c = __builtin_amdgcn_sdot4((int)a.x, (int)b.x, 0, false);
    c = __builtin_amdgcn_sdot4((int)a.y, (int)b.y, c, false); c = __builtin_amdgcn_sdot4((int)a.z, (int)b.z, c, false); c = __builtin_amdgcn_sdot4((int)a.w, (int)b.w, c, false);
    return c;
}
DI void axpy4_u8(float* acc, float a, unsigned u) {
    acc[0] += a * (float)(u & 0xffu); acc[1] += a * (float)((u >> 8) & 0xffu); acc[2] += a * (float)((u >> 16) & 0xffu); acc[3] += a * (float)(u >> 24);
}
DI unsigned quant4(float a, float b, float c, float d, float inv) {
    return ((unsigned)(int)__builtin_rintf(a * inv) & 0xffu) | (((unsigned)(int)__builtin_rintf(b * inv) & 0xffu) << 8) | (((unsigned)(int)__builtin_rintf(c * inv) & 0xffu) << 16) | (((unsigned)(int)__builtin_rintf(d * inv) & 0xffu) << 24);
}
typedef float f32x2 __attribute__((ext_vector_type(2)));
constexpr int PEER_SLICE_SHIFT = 7, PEER_NSLICE = NEXP >> PEER_SLICE_SHIFT;
constexpr int P12_WAVE_LDS = 8192 + 512;
DI void axpy16_fp4(f32x2* acc, float a, const v4u& rw) {
    const v2u uq = {rw.z, rw.w};
    const f32x2 aa = {a, a};
    f32x2 t[4];
    t[0] = __builtin_amdgcn_cvt_scalef32_pk_f32_fp4(uq.x, 1.0f, 0); t[1] = __builtin_amdgcn_cvt_scalef32_pk_f32_fp4(uq.x, 1.0f, 1); t[2] = __builtin_amdgcn_cvt_scalef32_pk_f32_fp4(uq.x, 1.0f, 2); t[3] = __builtin_amdgcn_cvt_scalef32_pk_f32_fp4(uq.x, 1.0f, 3);
    asm volatile("" : "+v"(t[0]), "+v"(t[1]), "+v"(t[2]), "+v"(t[3]));
#pragma unroll
    for (int j = 0; j < 4; ++j) acc[j] = __builtin_elementwise_fma(aa, t[j], acc[j]);
    t[0] = __builtin_amdgcn_cvt_scalef32_pk_f32_fp4(uq.y, 1.0f, 0); t[1] = __builtin_amdgcn_cvt_scalef32_pk_f32_fp4(uq.y, 1.0f, 1); t[2] = __builtin_amdgcn_cvt_scalef32_pk_f32_fp4(uq.y, 1.0f, 2); t[3] = __builtin_amdgcn_cvt_scalef32_pk_f32_fp4(uq.y, 1.0f, 3);
    asm volatile("" : "+v"(t[0]), "+v"(t[1]), "+v"(t[2]), "+v"(t[3]));
#pragma unroll
    for (int j = 0; j < 4; ++j) acc[4 + j] = __builtin_elementwise_fma(aa, t[j], acc[4 + j]);
}
DI int dot16_n4(const v4u& hq, const v4u& dq) {
    int c = __builtin_amdgcn_sdot4((int)hq.x, (int)((dq.x << 4) & 0xF0F0F0F0u), 0, false);
    c = __builtin_amdgcn_sdot4((int)hq.y, (int)(dq.x & 0xF0F0F0F0u), c, false);
    c = __builtin_amdgcn_sdot4((int)hq.z, (int)((dq.y << 4) & 0xF0F0F0F0u), c, false);
    c = __builtin_amdgcn_sdot4((int)hq.w, (int)(dq.y & 0xF0F0F0F0u), c, false);
    return c;
}
DI float reduce4_classes_f(float p0, float p1, float p2, float p3, bool b0, bool b1) {
    float x01 = b0 ? p1 : p0; const float y01 = b0 ? p0 : p1; x01 += dpp_mov<0xB1>(y01);
    float x23 = b0 ? p3 : p2; const float y23 = b0 ? p2 : p3; x23 += dpp_mov<0xB1>(y23);
    float w = b1 ? x23 : x01; const float w2 = b1 ? x01 : x23; w += dpp_mov<0x4E>(w2);
    w += dpp_mov<0x124>(w); w += dpp_mov<0x128>(w);
    { const auto r = __builtin_amdgcn_permlane16_swap(__float_as_uint(w), __float_as_uint(w), false, false); w = __uint_as_float(r[0]) + __uint_as_float(r[1]); }
    { const auto r = __builtin_amdgcn_permlane32_swap(__float_as_uint(w), __float_as_uint(w), false, false); w = __uint_as_float(r[0]) + __uint_as_float(r[1]); }
    return w;
}
template <int MODE>
DI void p12_peer_gather(const Ptrs& P, LAS unsigned char* lds, const float* obase, float* odst, int gw, int NGW, int wave, int lane) {
    LAS v4u* sorted = (LAS v4u*)(lds + wave * P12_WAVE_LDS); LAS unsigned* hist = (LAS unsigned*)(lds + wave * P12_WAVE_LDS + 8192);
    const bool b0 = (lane & 1) != 0, b1 = (lane & 2) != 0; const int cls = lane & 3;
    const int l16 = 16 * lane, l4 = 1024 + 4 * lane;
    const __amdgpu_buffer_rsrc_t rtab = __builtin_amdgcn_make_buffer_rsrc((void*)P.PDOWN, 0, NEXP * PEER_ROW_BYTES, 0x00020000);
    for (int tg = gw; tg < NTOK / 4; tg += NGW) {
        v4u hq[4]; f32x2 acc[4][8]; float asl[4]; float shv = 0.f;
#pragma unroll 1
        for (int u = 0; u < 4; ++u) {
            const size_t o = ((size_t)tg * 4 + u) * 128 + lane;
            const int i0 = P.PIDX[o], i1 = P.PIDX[o + 64];
            const float ga = P.PGATE[o], gb = P.PGATE[o + 64];
            hist[lane] = 0u; hist[64 + lane] = 0u;
            LDS_WAIT(); asm volatile("" ::: "memory");
            const unsigned r0 = __hip_atomic_fetch_add(&hist[i0 >> PEER_SLICE_SHIFT], 1u, __ATOMIC_RELAXED, __HIP_MEMORY_SCOPE_WORKGROUP);
            const unsigned r1 = __hip_atomic_fetch_add(&hist[i1 >> PEER_SLICE_SHIFT], 1u, __ATOMIC_RELAXED, __HIP_MEMORY_SCOPE_WORKGROUP);
            LDS_WAIT(); asm volatile("" ::: "memory");
            const unsigned c0 = hist[2 * lane], c1 = hist[2 * lane + 1]; unsigned incl = c0 + c1;
#pragma unroll
            for (int s2 = 1; s2 < 64; s2 <<= 1) { const unsigned t = __shfl_up(incl, s2); if (lane >= s2) incl += t; }
            const unsigned excl = incl - (c0 + c1);
            LDS_WAIT(); asm volatile("" ::: "memory");
            hist[2 * lane] = excl; hist[2 * lane + 1] = excl + c0;
            LDS_WAIT(); asm volatile("" ::: "memory");
            const unsigned p0 = hist[i0 >> PEER_SLICE_SHIFT] + r0, p1 = hist[i1 >> PEER_SLICE_SHIFT] + r1;
            sorted[u * 128 + p0] = (v4u){__float_as_uint(ga), 0u, (unsigned)i0, 0u};
            sorted[u * 128 + p1] = (v4u){__float_as_uint(gb), 0u, (unsigned)i1, 0u};
            LDS_WAIT(); asm volatile("" ::: "memory");
        }
#pragma unroll
        for (int u = 0; u < 4; ++u) { const size_t t = (size_t)tg * 4 + u;
            const v4u hb8 = *(const v4u*)(P.H8 + t * DM + 16 * lane);
            const float* sp = P.SSP2 + t * 16; const f32x4 p0 = *(const f32x4*)sp, p1 = *(const f32x4*)(sp + 4), p2 = *(const f32x4*)(sp + 8), p3 = *(const f32x4*)(sp + 12);
            const float rt = 1.0f / sqrtf((((p0.x + p0.y) + (p0.z + p0.w)) + ((p1.x + p1.y) + (p1.z + p1.w)) + ((p2.x + p2.y) + (p2.z + p2.w)) + ((p3.x + p3.y) + (p3.z + p3.w))) * (1.f / DM) + EPS);
            shv = (cls == u) ? P.SH[t] * (1.0f / 16.0f) * rt : shv;
            hq[u].x = __builtin_amdgcn_perm(hb8.y, hb8.x, 0x06040200u); hq[u].y = __builtin_amdgcn_perm(hb8.y, hb8.x, 0x07050301u);
            hq[u].z = __builtin_amdgcn_perm(hb8.w, hb8.z, 0x06040200u); hq[u].w = __builtin_amdgcn_perm(hb8.w, hb8.z, 0x07050301u);
            asl[u] = 0.f;
#pragma unroll
            for (int j = 0; j < 8; ++j) acc[u][j] = (f32x2){0.f, 0.f}; }
        v4u rwA[4], rwB[4]; unsigned scA[4], scB[4]; float gtA, gtB;
#define P12_FETCH(BI, RW, SC, GT) { GT = *(LAS const float*)((LAS const char*)sorted + (cls * 128 + (BI)) * 16); \
        _Pragma("unroll") for (int k = 0; k < 4; ++k) { const unsigned w0 = (unsigned)__builtin_amdgcn_readfirstlane((int)sorted[k * 128 + (BI)].z) & (MODE == 1 ? 63u : 0xffffffffu); \
        const int ro = (int)(w0 * (unsigned)PEER_ROW_BYTES);               \
        RW[k] = __builtin_bit_cast(v4u, __builtin_amdgcn_raw_buffer_load_b128(rtab, l16, ro, 0)); SC[k] = (unsigned)__builtin_amdgcn_raw_buffer_load_b32(rtab, l4, ro, 0); } }
#define P12_COMPUTE(RW, SC, GT) if (MODE == 2) { _Pragma("unroll") for (int k = 0; k < 4; ++k) { asl[k] += __uint_as_float((RW[k].x ^ RW[k].y) ^ (RW[k].z ^ RW[k].w) ^ SC[k]); } } else { \
        const float w_ = reduce4_classes_f((float)dot16_n4(hq[0], RW[0]) * bflo(SC[0]), (float)dot16_n4(hq[1], RW[1]) * bflo(SC[1]), \
                                           (float)dot16_n4(hq[2], RW[2]) * bflo(SC[2]), (float)dot16_n4(hq[3], RW[3]) * bflo(SC[3]), b0, b1); \
        const float a_ = gelu_as(w_ * shv) * GT; \
        axpy16_fp4(acc[0], dpp_mov<0x00>(a_) * bfhi(SC[0]), RW[0]); axpy16_fp4(acc[1], dpp_mov<0x55>(a_) * bfhi(SC[1]), RW[1]); \
        axpy16_fp4(acc[2], dpp_mov<0xAA>(a_) * bfhi(SC[2]), RW[2]); axpy16_fp4(acc[3], dpp_mov<0xFF>(a_) * bfhi(SC[3]), RW[3]); }
        P12_FETCH(0, rwA, scA, gtA)
#pragma unroll 1
        for (int bi = 0; bi < 128; bi += 2) {
            P12_FETCH(bi + 1, rwB, scB, gtB)
            P12_COMPUTE(rwA, scA, gtA)
            if (bi + 2 < 128) P12_FETCH(bi + 2, rwA, scA, gtA)
            P12_COMPUTE(rwB, scB, gtB)
        }
#undef P12_FETCH
#undef P12_COMPUTE
#pragma unroll
        for (int u = 0; u < 4; ++u) { const size_t t = (size_t)tg * 4 + u;
            float* op = odst + t * DM + 16 * lane;
            const v4u xa = *(const v4u*)(P.HN + t * DM + 16 * lane), xb = *(const v4u*)(P.HN + t * DM + 16 * lane + 8);
            const float pz = (MODE == 2) ? asl[u] * 1e-30f : 0.f;
            *(f32x4*)(op) = (f32x4){bflo(xa.x) + acc[u][0].x + pz, bfhi(xa.x) + acc[u][0].y, bflo(xa.y) + acc[u][1].x, bfhi(xa.y) + acc[u][1].y};
            *(f32x4*)(op + 4) = (f32x4){bflo(xa.z) + acc[u][2].x, bfhi(xa.z) + acc[u][2].y, bflo(xa.w) + acc[u][3].x, bfhi(xa.w) + acc[u][3].y};
            *(f32x4*)(op + 8) = (f32x4){bflo(xb.x) + acc[u][4].x, bfhi(xb.x) + acc[u][4].y, bflo(xb.y) + acc[u][5].x, bfhi(xb.y) + acc[u][5].y};
            *(f32x4*)(op + 12) = (f32x4){bflo(xb.z) + acc[u][6].x, bfhi(xb.z) + acc[u][6].y, bflo(xb.w) + acc[u][7].x, bfhi(xb.w) + acc[u][7].y}; }
    }
}

struct Args { const float* in[25]; float* out; unsigned char* ws; int ph_lo, ph_hi; };
__global__ void __launch_bounds__(NTHR, 2) layer_fwd(Args args) {
    extern __shared__ __attribute__((aligned(16))) unsigned char lds_raw[];
    LAS unsigned char* lds = (LAS unsigned char*)lds_raw;
    const int tid = threadIdx.x, lane = tid & 63, wave = __builtin_amdgcn_readfirstlane(tid >> 6);
    const int G = gridDim.x; const int bx = blockIdx.x;
    const int vcu = (G % 8 == 0) ? (bx % 8) * (G / 8) + bx / 8 : bx;
    const int gw = vcu * NWAVES + wave, NGW = G * NWAVES;
    unsigned char* ws = args.ws;
    Ptrs P;
    P.x = args.in[0]; P.mem = args.in[1]; P.mix_norm_w = args.in[2]; P.w_in = args.in[3]; P.conv_w = args.in[4]; P.conv_b = args.in[5]; P.cmp_pe = args.in[6];
    P.cmp_w1 = args.in[7]; P.cmp_w2 = args.in[8]; P.q_norm_w = args.in[9]; P.k_norm_w = args.in[10]; P.w_out = args.in[11]; P.xattn_norm_w = args.in[12];
    P.mem_norm_w = args.in[13]; P.xq = args.in[14]; P.xk = args.in[15]; P.xv = args.in[16]; P.xo = args.in[17]; P.xq_norm_w = args.in[18]; P.xk_norm_w = args.in[19];
    P.ffn_norm_w = args.in[20]; P.peer_wq = args.in[21]; P.peer_keys = args.in[22]; P.peer_down = args.in[23]; P.peer_up = args.in[24];
    P.out = args.out;
    P.WIN = (bf16*)(ws + WS_WIN); P.WOUT = (bf16*)(ws + WS_WOUT); P.XQT = (bf16*)(ws + WS_XQT); P.XKVT = (bf16*)(ws + WS_XKVT); P.XOT = (bf16*)(ws + WS_XOT);
    P.PWQT = (bf16*)(ws + WS_PWQT); P.PKEYS = (bf16*)(ws + WS_PKEYS); P.KCMP = (bf16*)(ws + WS_KCMP); P.VCMP = (bf16*)(ws + WS_VCMP); P.MN = (bf16*)(ws + WS_MN);
    P.XKV = (bf16*)(ws + WS_XKV); P.PDOWN = ws + WS_PDOWN; P.PUP = ws + WS_PUP; P.PSC = (float*)(ws + WS_PSC); P.CW1T = (bf16*)(ws + WS_CW1T); P.SSP1 = (float*)(ws + WS_SSP1); P.SSP2 = (float*)(ws + WS_SSP2); P.SA1 = (float*)(ws + WS_SA1); P.SB1 = (float*)(ws + WS_SB1); P.CMX = (float*)(ws + WS_CMX); P.HN8 = ws + WS_HN; P.WIN8 = ws + WS_WIN; P.H8 = ws + WS_PUP; P.PWQ8 = ws + WS_PWQT; P.SH = (float*)(ws + WS_SH); P.SBQ = (float*)(ws + WS_SBQ); P.CMXQ = (float*)(ws + WS_CMXQ); P.HN = (bf16*)(ws + WS_HN); P.YMIX = (bf16*)(ws + WS_YMIX);
    P.PROJ = (bf16*)(ws + WS_PROJ); P.XQ = (bf16*)(ws + WS_XQ); P.PQ = (bf16*)(ws + WS_PQ); P.B1P = (float*)(ws + WS_B1P); P.PGATE = (float*)(ws + WS_PGATE); P.PIDX = (int*)(ws + WS_PIDX);

    volatile LAS unsigned* MISC = (volatile LAS unsigned*)(lds + MISC_OFF);
    if (tid < 64) MISC[tid] = 0u;
    __syncthreads();
    const int lo = args.ph_lo, hi = args.ph_hi;
    const bool multi = (hi - lo) > 1;
    XcdBarrier bar; bar.bar = (unsigned*)(ws + WS_CTL) + CW_BAR; bar.x = 0; bar.st = MISC + 8;
    if (multi) bar = xcd_barrier_post((unsigned*)(ws + WS_CTL) + CW_BAR, MISC + 8);
#ifndef ONLY_PHASE
#define ONLY_PHASE -1
#endif
#define IN(k) ((ONLY_PHASE < 0 || (k) == ONLY_PHASE) && lo <= (k) && (k) < hi)
#define SEAM(k) do { if (IN(k) && IN((k) + 1)) xcd_barrier(bar); } while (0)

#ifndef REPMASK
#define REPMASK 0
#endif
#ifndef P12_PROBE_MODE
#define P12_PROBE_MODE 0
#endif
#ifndef P3_PROBE_MODE
#define P3_PROBE_MODE 0
#endif
#ifndef P0_PROBE_MASK
#define P0_PROBE_MASK 7
#endif
#define NREP(k) (((REPMASK) >> (k)) & 1 ? 2 : 1)
    float* const dummy = (float*)(ws + WS_PROJ);
    if (IN(0)) { for (int rep = 0; rep < NREP(0); ++rep) { const int pm = (rep + 1 < NREP(0)) ? P0_PROBE_MASK : 7; p0_prologue(P, lds, gw, NGW, wave, lane, 0, pm); if (multi && pm == 7) xcd_barrier(bar); p0_prologue(P, lds, gw, NGW, wave, lane, 1, pm); } } SEAM(0);
    if (IN(1)) { for (int rep = 0; rep < NREP(1); ++rep) {
        { pg8::Gemm g{(const bf16*)P.HN8, (const bf16*)P.WIN8, NTOK, INP, DM / 2}; pg8::ProjOrder S; S.init(NTOK, G, vcu);
          pg8::EpiI8Bf16 E{P.PROJ, INP, P.SA1, P.SB1};
          pg8::gemm_phase<pg8::EpiI8Bf16, pg8::ProjOrder, true, true, true>(lds, g, S, E); }
 }
        asm volatile("s_waitcnt vmcnt(0)" ::: "memory"); __syncthreads();
        for (int mt = vcu >> 1; mt < NTOK / 256; mt += G >> 1) { proj_post_conv(P, mt, (vcu & 1) * 256, wave, lane); if (vcu & 1) proj_post_knorm(P, mt, wave, lane); }
    } SEAM(1);
    if (IN(2)) { for (int rep = 0; rep < NREP(2); ++rep) p2_misc(P, lds, vcu, G, tid, wave, lane, rep == 0); } SEAM(2);
    if (IN(3)) { xk_norm(P, gw, NGW, lane); for (int rep = 0; rep < NREP(3); ++rep) { if (rep + 1 < NREP(3)) p3_nsa<P3_PROBE_MODE>(P, lds, vcu, G, tid, wave, lane); else p3_nsa<0>(P, lds, vcu, G, tid, wave, lane); } } SEAM(3);
    if (IN(4)) { for (int rep = 0; rep < NREP(4); ++rep) { pg8::Gemm g{P.YMIX, P.WOUT, NTOK, DM, DM}; pg8::StaticOrder S; S.init(NTOK, DM, G, bx);
        pg8::EpiResBf16N<false> E{P.x, P.HN, P.SSP1, DM};
        pg8::gemm_phase<pg8::EpiResBf16N<false>, pg8::StaticOrder, true, true>(lds, g, S, E); } } SEAM(4);
    if (IN(6)) { for (int rep = 0; rep < NREP(6); ++rep) { pg8::Gemm g{P.HN, P.XQT, NTOK, DM, DM}; pg8::StaticOrder S; S.init(NTOK, DM, G, bx);
        pg8::EpiBf16<0> E{P.XQ, DM, nullptr, 0, 0, 1.f};
        pg8::gemm_phase<pg8::EpiBf16<0>, pg8::StaticOrder, true, true>(lds, g, S, E); }
        asm volatile("s_waitcnt vmcnt(0)" ::: "memory"); __syncthreads();
        for (int rep = 0; rep < NREP(7); ++rep) p7_xattn(P, lds, bx, G, tid, wave, lane); } SEAM(7);
    if (IN(8)) { for (int rep = 0; rep < NREP(8); ++rep) { pg8::Gemm g{P.YMIX, P.XOT, NTOK, DM, DM}; pg8::StaticOrder S; S.init(NTOK, DM, G, bx);
        pg8::EpiResBf16N<true> E{P.HN, (rep + 1 < NREP(8)) ? (bf16*)dummy : P.HN, P.SSP2, DM};
        pg8::gemm_phase<pg8::EpiResBf16N<true>, pg8::StaticOrder, true, true>(lds, g, S, E); } } SEAM(8);
    if (IN(9)) { for (int rep = 0; rep < NREP(9); ++rep) p9_quant_h(P, gw, NGW, lane); } SEAM(9);
    if (IN(10)) { for (int rep = 0; rep < NREP(10); ++rep) { pg8::Gemm g{(const bf16*)P.H8, (const bf16*)P.PWQ8, NTOK, 2048, DM / 2}; pg8::StaticOrder S; S.init(NTOK, 2048, G, bx);
        pg8::EpiI8Bf16 E{P.PQ, 2048, P.SH, P.SBQ};
        pg8::gemm_phase<pg8::EpiI8Bf16, pg8::StaticOrder, true, true, true>(lds, g, S, E); }
        asm volatile("s_waitcnt vmcnt(0)" ::: "memory"); __syncthreads();
        for (int rep = 0; rep < NREP(11); ++rep) p11_peer_topk(P, lds, bx, G, tid, wave, lane); } SEAM(11);
    if (IN(12)) { for (int rep = 0; rep < NREP(12); ++rep) if (rep + 1 < NREP(12)) p12_peer_gather<P12_PROBE_MODE>(P, lds, P.out, dummy, gw, NGW, wave, lane); else p12_peer_gather<0>(P, lds, P.out, P.out, gw, NGW, wave, lane); }
#undef IN
#undef SEAM
}

#ifndef MK_PER_PHASE
#define MK_PER_PHASE 0
#endif
extern "C" void kernel_launch(void* const* d_in, const int* in_sizes, int n_in, void* d_out, int out_size, void* d_ws, size_t ws_size, hipStream_t stream) {
    static int grid = 0;
    if (grid == 0) {
        if (n_in != 25 || in_sizes[0] != NTOK * DM || out_size != NTOK * DM || ws_size < WS_END) {
            fprintf(stderr, "kernel_launch: unexpected shapes (n_in %d, in0 %d, out %d, ws %zu); nothing launched\n", n_in, n_in > 0 ? in_sizes[0] : -1, out_size, ws_size); grid = -1; return; }
        int dev = 0, cus = 0, per_cu = 0;
        if (hipGetDevice(&dev) != hipSuccess || hipDeviceGetAttribute(&cus, hipDeviceAttributeMultiprocessorCount, dev) != hipSuccess) { grid = -1; return; }
        if (hipFuncSetAttribute((const void*)layer_fwd, hipFuncAttributeMaxDynamicSharedMemorySize, LDS_BYTES) != hipSuccess) { fprintf(stderr, "kernel_launch: hipFuncSetAttribute failed\n"); grid = -1; return; }
        if (hipOccupancyMaxActiveBlocksPerMultiprocessor(&per_cu, (const void*)layer_fwd, NTHR, LDS_BYTES) != hipSuccess || per_cu < 1)
            fprintf(stderr, "kernel_launch: note: occupancy query reports %d workgroups per CU\n", per_cu);
        (void)hipGetLastError();
        grid = cus;
        if (grid != 256) fprintf(stderr, "kernel_launch: note: %d CUs\n", grid);
    }
    if (grid < 0) return;
    if (hipMemsetAsync((char*)d_ws + WS_CTL, 0, CTL_ZERO_BYTES, stream) != hipSuccess) return;
    Args a{};
    for (int i = 0; i < 25; ++i) a.in[i] = (const float*)d_in[i];
    a.out = (float*)d_out; a.ws = (unsigned char*)d_ws;
#if MK_PER_PHASE
    for (int p = 0; p < NPHASE; ++p) { a.ph_lo = p; a.ph_hi = p + 1; hipLaunchKernelGGL(layer_fwd, dim3(grid), dim3(NTHR), LDS_BYTES, stream, a); }
#else
    a.ph_lo = 0; a.ph_hi = NPHASE; hipLaunchKernelGGL(layer_fwd, dim3(grid), dim3(NTHR), LDS_BYTES, stream, a);
#endif
}
```

```cpp
#include <hip/hip_runtime.h>
#include <cstdio>
#include <cstdint>
#include <cmath>
namespace pg8 {
#define PG8_LAS __attribute__((address_space(3)))
typedef unsigned short bf16_t;
typedef short bf16x8 __attribute__((ext_vector_type(8)));
typedef float f32x4 __attribute__((ext_vector_type(4)));
typedef unsigned u32x4 __attribute__((ext_vector_type(4)));
constexpr int BM = 256, BK = 64, HALF = 128, HTB = HALF * BK * 2  , STAGE_BYTES = 8 * HTB, NXCD = 8, WGM = 8;

__host__ __device__ __forceinline__ int lds_byte(int r, int c) { const int st = (r >> 4) * 2 + (c >> 5), rr = r & 15, cc = c & 31, ob = rr * 64 + cc * 2; return st * 1024 + (ob ^ (((ob >> 9) & 1) << 5)); }
__host__ __device__ __forceinline__ void stage_rc(int b, int& R, int& C) { const int st = b / 1024, sb = b % 1024, swz = sb ^ (((sb >> 9) & 1) << 5); R = (st >> 1) * 16 + swz / 64; C = (st & 1) * 32 + (swz % 64) / 2; }
__host__ __device__ __forceinline__ int perm32(int rho) { const int n = rho >> 4, i = rho & 15; return 8 * (i >> 2) + 4 * n + (i & 3); }

struct Unit { int pm, pn; };
struct Gemm { const bf16_t* A; const bf16_t* Bt; int M, N, K; };

struct StaticOrder {
    int nM, nN, nwg, G, c;
    __host__ __device__ void init(int M, int N, int G_, int c_) { nM = M / BM; nN = N / BM; nwg = nM * nN; G = G_; c = c_; }
    __host__ __device__ bool next(int i, Unit& u) const {
        const long L = (long)i * G + c; if (L >= nwg) return false;
        int wgid = (int)L; { const int q = nwg / NXCD, r = nwg % NXCD, xcd = wgid % NXCD, off = wgid / NXCD; wgid = (xcd < r ? xcd * (q + 1) : r * (q + 1) + (xcd - r) * q) + off; }
        const int nig = WGM * nN, gid = wgid / nig, fm = gid * WGM, gsz = (nM - fm) < WGM ? (nM - fm) : WGM;
        u.pm = fm + ((wgid % nig) % gsz); u.pn = (wgid % nig) / gsz; return true;
    }
    __device__ __forceinline__ void a_ready(const Unit&) const {}
    __device__ __forceinline__ void done(const Unit&) const {}
};

struct ProjOrder {
    int nM, G, v;
    __host__ __device__ void init(int M, int G_, int v_) { nM = M / BM; G = G_; v = v_; }
    __host__ __device__ bool next(int i, Unit& u) const {
        const int round = i / 6, k = i - 6 * round, mt = (v >> 1) + round * (G >> 1);
        if (mt >= nM) return false;
        u.pm = mt; u.pn = k < 3 ? 2 * k + (v & 1) : (v & 1) * 3 + 3 + k; return true;
    }
    __device__ __forceinline__ void a_ready(const Unit&) const {}
    __device__ __forceinline__ void done(const Unit&) const {}
};

__device__ __forceinline__ unsigned cvt_pk_bf16(float lo, float hi) { unsigned r; asm volatile("v_cvt_pk_bf16_f32 %0, %1, %2" : "=v"(r) : "v"(lo), "v"(hi)); return r; }
typedef float f32x2 __attribute__((ext_vector_type(2)));
__device__ __forceinline__ f32x2 gelu_pk(f32x2 v) {
    const f32x2 av = __builtin_elementwise_abs(v), d = av * 0.2316418882f + 1.0f;
    f32x2 t; t.x = __builtin_amdgcn_rcpf(d.x); t.y = __builtin_amdgcn_rcpf(d.y);
    f32x2 q = t * 0.5307027145f + (-0.7265760135f); q = q * t + 0.7107068705f; q = q * t + (-0.142248368f); q = q * t + 0.127414796f; q = q * t;
    const f32x2 s = (v * v) * (-0.72134752044f);
    f32x2 e; e.x = __builtin_amdgcn_exp2f(s.x); e.y = __builtin_amdgcn_exp2f(s.y);
    const f32x2 m = v * (q * e), r = v - m;
    f32x2 o; o.x = v.x < 0.f ? m.x : r.x; o.y = v.y < 0.f ? m.y : r.y; return o;
}

template <int ACT  > struct EpiBf16 {
    static constexpr bool PERM = true, AFTER_DRAIN = false; static_assert(ACT == 0 || ACT == 1, "EpiBf16: ACT is 0 (none) or 1 (gelu_pk)");
    bf16_t* O; int ldc; const float* bias; int split_cols; size_t split_stride; float scale0;
    __device__ __forceinline__ void operator()(const f32x4 (&acc)[2][2][4][2], const Unit& u, int wr, int wc, int fr, int fq) const {
        const int row0 = u.pm * BM + wr * 64 + fr; int colt = u.pn * BM; bf16_t* base = O;
        float sc = 1.f; if (split_cols) { const int t = colt / split_cols; base += (size_t)t * split_stride; colt -= t * split_cols; if (t == 0) sc = scale0; }
        const int col0 = colt + wc * 32 + 8 * fq, bcol0 = u.pn * BM + wc * 32 + 8 * fq;
        f32x4 bv[2][2];
#pragma unroll
        for (int bj = 0; bj < 2; ++bj)
#pragma unroll
            for (int n = 0; n < 2; ++n) bv[bj][n] = bias ? *(const f32x4*)(bias + bcol0 + bj * HALF + 4 * n) : (f32x4){0.f, 0.f, 0.f, 0.f};
#pragma unroll
        for (int ai = 0; ai < 2; ++ai)
#pragma unroll
            for (int m = 0; m < 4; ++m) { bf16_t* rowp = base + (size_t)(row0 + ai * HALF + m * 16) * ldc + col0;
#pragma unroll
                for (int bj = 0; bj < 2; ++bj) { f32x4 v0 = acc[ai][bj][m][0] + bv[bj][0], v1 = acc[ai][bj][m][1] + bv[bj][1];
                    if (ACT == 1) { f32x2 a = gelu_pk((f32x2){v0[0], v0[1]}), b = gelu_pk((f32x2){v0[2], v0[3]}), c = gelu_pk((f32x2){v1[0], v1[1]}), d = gelu_pk((f32x2){v1[2], v1[3]});
                        v0 = (f32x4){a.x, a.y, b.x, b.y}; v1 = (f32x4){c.x, c.y, d.x, d.y}; }
                    v0 = v0 * sc; v1 = v1 * sc; u32x4 w; w.x = cvt_pk_bf16(v0[0], v0[1]); w.y = cvt_pk_bf16(v0[2], v0[3]); w.z = cvt_pk_bf16(v1[0], v1[1]); w.w = cvt_pk_bf16(v1[2], v1[3]);
                    *(u32x4*)(rowp + bj * HALF) = w; } }
    }
};

struct EpiResF32 {
    static constexpr bool PERM = false, AFTER_DRAIN = false;
    const float* base; float* out; int ldc;
    __device__ __forceinline__ void operator()(const f32x4 (&acc)[2][2][4][2], const Unit& u, int wr, int wc, int fr, int fq) const {
        const int row0 = u.pm * BM + wr * 64 + fr, col0 = u.pn * BM + wc * 32 + 4 * fq;
#pragma unroll
        for (int ai = 0; ai < 2; ++ai)
#pragma unroll
            for (int m = 0; m < 4; ++m) { const size_t off = (size_t)(row0 + ai * HALF + m * 16) * ldc + col0;
#pragma unroll
                for (int bj = 0; bj < 2; ++bj)
#pragma unroll
                    for (int n = 0; n < 2; ++n) { const f32x4 b = *(const f32x4*)(base + off + bj * HALF + n * 16); *(f32x4*)(out + off + bj * HALF + n * 16) = b + acc[ai][bj][m][n]; } }
    }
};
template <bool BASE_BF16> struct EpiResBf16N {
    static constexpr bool PERM = true, AFTER_DRAIN = false;
    const void* base; bf16_t* xn; float* ssp; int ldc;
    __device__ __forceinline__ void operator()(const f32x4 (&acc)[2][2][4][2], const Unit& u, int wr, int wc, int fr, int fq) const {
        typedef unsigned u32x4 __attribute__((ext_vector_type(4)));
        const int row0 = u.pm * BM + wr * 64 + fr, col0 = u.pn * BM + wc * 32 + 8 * fq;
#pragma unroll
        for (int ai = 0; ai < 2; ++ai)
#pragma unroll
            for (int m = 0; m < 4; ++m) { const int row = row0 + ai * HALF + m * 16; const size_t off = (size_t)row * ldc + col0; float ss = 0.f;
#pragma unroll
                for (int bj = 0; bj < 2; ++bj) { f32x4 b0, b1;
                    if (BASE_BF16) { const u32x4 r = *(const u32x4*)((const bf16_t*)base + off + bj * HALF);
                        b0 = (f32x4){__uint_as_float(r.x << 16), __uint_as_float(r.x & 0xffff0000u), __uint_as_float(r.y << 16), __uint_as_float(r.y & 0xffff0000u)};
                        b1 = (f32x4){__uint_as_float(r.z << 16), __uint_as_float(r.z & 0xffff0000u), __uint_as_float(r.w << 16), __uint_as_float(r.w & 0xffff0000u)}; }
                    else { b0 = *(const f32x4*)((const float*)base + off + bj * HALF); b1 = *(const f32x4*)((const float*)base + off + bj * HALF + 4); }
                    const f32x4 v0 = b0 + acc[ai][bj][m][0], v1 = b1 + acc[ai][bj][m][1];
                    ss += ((v0[0] * v0[0] + v0[1] * v0[1]) + (v0[2] * v0[2] + v0[3] * v0[3])) + ((v1[0] * v1[0] + v1[1] * v1[1]) + (v1[2] * v1[2] + v1[3] * v1[3]));
                    u32x4 w; w.x = cvt_pk_bf16(v0[0], v0[1]); w.y = cvt_pk_bf16(v0[2], v0[3]); w.z = cvt_pk_bf16(v1[0], v1[1]); w.w = cvt_pk_bf16(v1[2], v1[3]);
                    *(u32x4*)(xn + off + bj * HALF) = w; }
                ss += __shfl_xor(ss, 16); ss += __shfl_xor(ss, 32);
                if (fq == 0) ssp[(size_t)row * 16 + u.pn * 4 + wc] = ss; }
    }
};
struct EpiI8Bf16 {
    static constexpr bool PERM = true, AFTER_DRAIN = false;
    bf16_t* O; int ldc; const float* sa; const float* sb;
    __device__ __forceinline__ void operator()(const f32x4 (&acc)[2][2][4][2], const Unit& u, int wr, int wc, int fr, int fq) const {
        typedef int i32x4 __attribute__((ext_vector_type(4)));
        const int row0 = u.pm * BM + wr * 64 + fr, col0 = u.pn * BM + wc * 32 + 8 * fq;
        f32x4 sbv[2][2];
#pragma unroll
        for (int bj = 0; bj < 2; ++bj)
#pragma unroll
            for (int n = 0; n < 2; ++n) sbv[bj][n] = *(const f32x4*)(sb + col0 + bj * HALF + 4 * n);
#pragma unroll
        for (int ai = 0; ai < 2; ++ai)
#pragma unroll
            for (int m = 0; m < 4; ++m) { const int row = row0 + ai * HALF + m * 16; const float sr = sa[row]; bf16_t* rowp = O + (size_t)row * ldc + col0;
#pragma unroll
                for (int bj = 0; bj < 2; ++bj) {
                    const f32x4 v0 = __builtin_convertvector(__builtin_bit_cast(i32x4, acc[ai][bj][m][0]), f32x4) * (sbv[bj][0] * sr);
                    const f32x4 v1 = __builtin_convertvector(__builtin_bit_cast(i32x4, acc[ai][bj][m][1]), f32x4) * (sbv[bj][1] * sr);
                    u32x4 w; w.x = cvt_pk_bf16(v0[0], v0[1]); w.y = cvt_pk_bf16(v0[2], v0[3]); w.z = cvt_pk_bf16(v1[0], v1[1]); w.w = cvt_pk_bf16(v1[2], v1[3]);
                    *(u32x4*)(rowp + bj * HALF) = w; } }
    }
};

template <class Epi, class Sched, bool ALIGN_EPI = false, bool SP2 = false, bool I8 = false>
__device__ __forceinline__ void gemm_phase(PG8_LAS unsigned char* lds, const Gemm g, const Sched& S, const Epi& E) {
    const int tid = threadIdx.x, wid = __builtin_amdgcn_readfirstlane(tid >> 6), lane = tid & 63, wr = wid >> 2, wc = wid & 3, fr = lane & 15, fq = lane >> 4;
    const int K = g.K, nt = K / BK;
    unsigned voffA[2], voffB[2];
#pragma unroll
    for (int i = 0; i < 2; ++i) { int R, C; stage_rc(tid * 16 + i * 8192, R, C); const int Rb = Epi::PERM ? ((R & ~31) + perm32(R & 31)) : R;
        voffA[i] = (unsigned)(R * K + C) * 2u; voffB[i] = (unsigned)(Rb * K + C) * 2u; }
    const size_t kstep = (size_t)(BK * 2);
    const size_t hstep = (size_t)HALF * K * 2;
    const size_t tstep = 2 * hstep;
    const unsigned ldsw = (unsigned)wid * 1024u;
    const int aoff = lds_byte(wr * 64 + fr, fq * 8), boff = lds_byte(wc * 32 + fr, fq * 8);
    typedef int i32x4 __attribute__((ext_vector_type(4)));
    auto mma16 = [](const bf16x8& b, const bf16x8& a, const f32x4& c) __attribute__((always_inline)) -> f32x4 {
        if constexpr (I8) return __builtin_bit_cast(f32x4, __builtin_amdgcn_mfma_i32_16x16x64_i8(__builtin_bit_cast(i32x4, b), __builtin_bit_cast(i32x4, a), __builtin_bit_cast(i32x4, c), 0, 0, 0));
        else return __builtin_amdgcn_mfma_f32_16x16x32_bf16(b, a, c, 0, 0, 0);
    };
#define PG8_SA(b, h) (((b) * 2 + (h)) * HTB)
#define PG8_SB(b, h) ((4 + (b) * 2 + (h)) * HTB)
#define PG8_STAGE(bufoff, gbase, voff) do { _Pragma("unroll") for (int _i = 0; _i < 2; ++_i) \
        __builtin_amdgcn_global_load_lds((const unsigned*)((const char*)(gbase) + (voff)[_i]), (PG8_LAS unsigned*)(lds + (bufoff) + ldsw + _i * 8192), 16, 0, 0); } while (0)
#define PG8_LDA(dst, b, h) do { _Pragma("unroll") for (int m = 0; m < 4; ++m) _Pragma("unroll") for (int k = 0; k < 2; ++k) dst[m][k] = *(const PG8_LAS bf16x8*)(lds + PG8_SA(b, h) + aoff + m * 2048 + k * 1024); } while (0)
#define PG8_LDB(dst, b, h) do { _Pragma("unroll") for (int n = 0; n < 2; ++n) _Pragma("unroll") for (int k = 0; k < 2; ++k) dst[n][k] = *(const PG8_LAS bf16x8*)(lds + PG8_SB(b, h) + boff + n * 2048 + k * 1024); } while (0)
#define PG8_MMA(ai, bj, At, Bt) do { __builtin_amdgcn_s_setprio(1); _Pragma("unroll") for (int m = 0; m < 4; ++m) _Pragma("unroll") for (int n = 0; n < 2; ++n) _Pragma("unroll") for (int k = 0; k < 2; ++k) \
        acc[ai][bj][m][n] = mma16(Bt[n][k], At[m][k], acc[ai][bj][m][n]); __builtin_amdgcn_s_setprio(0); } while (0)
#define PG8_WAIT_V(n) asm volatile("s_waitcnt vmcnt(" #n ")" ::: "memory")
#define PG8_WAIT_L(n) asm volatile("s_waitcnt lgkmcnt(" #n ")" ::: "memory")
#define PG8_BAR __builtin_amdgcn_s_barrier()
#define PG8_SCHED __builtin_amdgcn_sched_barrier(0)
    Unit cur, nxt; int ui = 0;
    if (!S.next(0, cur)) return;
    f32x4 acc[2][2][4][2];
#pragma unroll
    for (int a = 0; a < 2; ++a)
#pragma unroll
        for (int b = 0; b < 2; ++b)
#pragma unroll
            for (int m = 0; m < 4; ++m)
#pragma unroll
                for (int n = 0; n < 2; ++n) acc[a][b][m][n] = (f32x4){0.f, 0.f, 0.f, 0.f};
    bf16x8 At[4][2], B0[2][2], B1[2][2];
    const char* cA = (const char*)g.A + (size_t)cur.pm * tstep; const char* cB = (const char*)g.Bt + (size_t)cur.pn * tstep;
    S.a_ready(cur);
    if constexpr (SP2) {
        PG8_STAGE(PG8_SB(0, 0), cB, voffB); PG8_STAGE(PG8_SB(0, 1), cB + hstep, voffB); PG8_STAGE(PG8_SA(0, 0), cA, voffA); PG8_STAGE(PG8_SA(0, 1), cA + hstep, voffA);
        if (wr == 1) PG8_BAR;
        PG8_WAIT_V(2); PG8_BAR;
        PG8_STAGE(PG8_SB(1, 0), cB + kstep, voffB); PG8_STAGE(PG8_SA(1, 0), cA + kstep, voffA); PG8_STAGE(PG8_SB(1, 1), cB + hstep + kstep, voffB);
        PG8_WAIT_V(6); PG8_BAR;
    } else {
        PG8_STAGE(PG8_SB(0, 0), cB, voffB); PG8_STAGE(PG8_SA(0, 0), cA, voffA); PG8_STAGE(PG8_SB(0, 1), cB + hstep, voffB); PG8_STAGE(PG8_SA(0, 1), cA + hstep, voffA);
        if (wr == 1) PG8_BAR;
        PG8_WAIT_V(4); PG8_BAR;
        PG8_STAGE(PG8_SB(1, 0), cB + kstep, voffB); PG8_STAGE(PG8_SA(1, 0), cA + kstep, voffA); PG8_STAGE(PG8_SB(1, 1), cB + hstep + kstep, voffB);
        PG8_WAIT_V(6); PG8_BAR;
    }
    for (;;) {
        const bool has_next = S.next(ui + 1, nxt);
        const char* nA = has_next ? (const char*)g.A + (size_t)nxt.pm * tstep : cA; const char* nB = has_next ? (const char*)g.Bt + (size_t)nxt.pn * tstep : cB;
        for (int t = 0; t < nt; t += 2) {
            const bool last = (t == nt - 2);
            const char* a1 = cA + (size_t)(t + 1) * kstep;
            const char* a2 = last ? nA : cA + (size_t)(t + 2) * kstep; const char* b2 = last ? nB : cB + (size_t)(t + 2) * kstep;
            const char* a3 = a2 + kstep; const char* b3 = b2 + kstep;
            if (last && has_next) S.a_ready(nxt);
            if constexpr (SP2) {
            PG8_LDB(B0, 0, 0); PG8_LDB(B1, 0, 1); PG8_SCHED; PG8_LDA(At, 0, 0); PG8_STAGE(PG8_SA(1, 1), a1 + hstep, voffA);
            PG8_WAIT_V(8); PG8_WAIT_L(0); PG8_BAR; PG8_MMA(0, 0, At, B0); PG8_MMA(0, 1, At, B1); PG8_BAR; PG8_SCHED;
            PG8_LDA(At, 0, 1); PG8_STAGE(PG8_SB(0, 0), b2, voffB); PG8_STAGE(PG8_SB(0, 1), b2 + hstep, voffB); PG8_STAGE(PG8_SA(0, 0), a2, voffA);
            PG8_WAIT_V(8); PG8_WAIT_L(0); PG8_BAR; PG8_MMA(1, 0, At, B0); PG8_MMA(1, 1, At, B1); PG8_BAR; PG8_SCHED;
            PG8_LDB(B0, 1, 0); PG8_LDB(B1, 1, 1); PG8_SCHED; PG8_LDA(At, 1, 0); PG8_STAGE(PG8_SA(0, 1), a2 + hstep, voffA);
            PG8_WAIT_V(8); PG8_WAIT_L(0); PG8_BAR; PG8_MMA(0, 0, At, B0); PG8_MMA(0, 1, At, B1); PG8_BAR; PG8_SCHED;
            PG8_LDA(At, 1, 1); PG8_STAGE(PG8_SB(1, 0), b3, voffB); PG8_STAGE(PG8_SB(1, 1), b3 + hstep, voffB); PG8_STAGE(PG8_SA(1, 0), a3, voffA);
            PG8_WAIT_V(8); PG8_WAIT_L(0); PG8_BAR; PG8_MMA(1, 0, At, B0); PG8_MMA(1, 1, At, B1); PG8_BAR; PG8_SCHED;
            } else {
            PG8_LDB(B0, 0, 0); PG8_SCHED; PG8_LDA(At, 0, 0); PG8_STAGE(PG8_SA(1, 1), a1 + hstep, voffA);
            PG8_WAIT_L(8); PG8_BAR; PG8_WAIT_L(0); PG8_MMA(0, 0, At, B0); PG8_BAR; PG8_SCHED;
            PG8_LDB(B1, 0, 1); PG8_STAGE(PG8_SB(0, 0), b2, voffB);
            PG8_BAR; PG8_WAIT_L(0); PG8_MMA(0, 1, At, B1); PG8_BAR;
            PG8_LDA(At, 0, 1); PG8_STAGE(PG8_SA(0, 0), a2, voffA);
            PG8_BAR; PG8_WAIT_L(0); PG8_MMA(1, 0, At, B0); PG8_BAR; PG8_SCHED;
            PG8_STAGE(PG8_SB(0, 1), b2 + hstep, voffB);
            PG8_WAIT_V(6); PG8_BAR; PG8_MMA(1, 1, At, B1); PG8_BAR;
            PG8_LDB(B0, 1, 0); PG8_SCHED; PG8_LDA(At, 1, 0); PG8_STAGE(PG8_SA(0, 1), a2 + hstep, voffA);
            PG8_WAIT_L(8); PG8_BAR; PG8_WAIT_L(0); PG8_MMA(0, 0, At, B0); PG8_BAR; PG8_SCHED;
            PG8_LDB(B1, 1, 1); PG8_STAGE(PG8_SB(1, 0), b3, voffB);
            PG8_BAR; PG8_WAIT_L(0); PG8_MMA(0, 1, At, B1); PG8_BAR;
            PG8_LDA(At, 1, 1); PG8_STAGE(PG8_SA(1, 0), a3, voffA);
            PG8_BAR; PG8_WAIT_L(0); PG8_MMA(1, 0, At, B0); PG8_BAR; PG8_SCHED;
            PG8_STAGE(PG8_SB(1, 1), b3 + hstep, voffB);
            PG8_WAIT_V(6); PG8_BAR; PG8_MMA(1, 1, At, B1); PG8_BAR;
            }
        }
        if constexpr (ALIGN_EPI) { if (wr == 0) PG8_BAR; }
        if constexpr (!Epi::AFTER_DRAIN) { E(acc, cur, wr, wc, fr, fq); S.done(cur); }
        if (!has_next) break;
#pragma unroll
        for (int a = 0; a < 2; ++a)
#pragma unroll
            for (int b = 0; b < 2; ++b)
#pragma unroll
                for (int m = 0; m < 4; ++m)
#pragma unroll
                    for (int n = 0; n < 2; ++n) acc[a][b][m][n] = (f32x4){0.f, 0.f, 0.f, 0.f};
        cur = nxt; cA = nA; cB = nB; ++ui;
        if constexpr (ALIGN_EPI) { if (wr == 1) PG8_BAR; }
    }
    PG8_WAIT_V(0);
    if constexpr (!ALIGN_EPI) { if (wr == 0) PG8_BAR; }
    PG8_BAR;
    if constexpr (Epi::AFTER_DRAIN) { E.fused(acc, cur, wr, wc, fr, fq, lds, wid, lane); S.done(cur); }
#undef PG8_SA
#undef PG8_SB
#undef PG8_STAGE
#undef PG8_LDA
#undef PG8_LDB
#undef PG8_MMA
#undef PG8_WAIT_V
#undef PG8_WAIT_L
#undef PG8_BAR
#undef PG8_SCHED
}
}

constexpr int NB = 16, SEQ = 2048, DM = 1024, NTOK = NB * SEQ;
constexpr int INC = 2840, INP = 3072;
constexpr int C_B = 0, C_C = 512, C_H = 1024, C_Q = 1536, C_KC = 2048, C_VC = 2176, C_KS = 2304, C_VS = 2432, C_KW = 2560, C_VW = 2688, C_G = 2816;
constexpr int MEMT = 256, NMEM = NB * MEMT;
constexpr int NEXP = 16384;
constexpr int PEER_ROW_BYTES = 1280;
constexpr float EPS = 1e-6f;
constexpr float LOG2E = 1.4426950408889634f;
constexpr int NWAVES = 8, NTHR = 512;
constexpr int NPHASE = 13;

constexpr size_t MiB = 1u << 20;
constexpr size_t WS_CTL = 0, CTL_ZERO_BYTES = 32 * 1024;
constexpr size_t WS_WIN = 2 * MiB, WS_WOUT = 8 * MiB, WS_XQT = 10 * MiB, WS_XKVT = 12 * MiB, WS_XOT = 16 * MiB, WS_PWQT = 18 * MiB;
constexpr size_t WS_PKEYS = 22 * MiB, WS_B1P = 23 * MiB, WS_KCMP = 24 * MiB, WS_VCMP = 24 * MiB + 512 * 1024;
constexpr size_t WS_MN = 26 * MiB, WS_XKV = 34 * MiB;
constexpr size_t WS_CW1T = 22 * MiB + 512 * 1024;
constexpr size_t WS_SA1 = 23 * MiB + 256 * 1024, WS_SB1 = 23 * MiB + 384 * 1024, WS_CMX = 23 * MiB + 448 * 1024;
constexpr size_t WS_PSC = 23 * MiB + 256 * 1024;
constexpr size_t WS_SH = 54 * MiB, WS_SBQ = 54 * MiB + 128 * 1024, WS_CMXQ = 54 * MiB + 256 * 1024;
constexpr size_t WS_SSP1 = 50 * MiB, WS_SSP2 = 52 * MiB;
constexpr size_t WS_PDOWN = 64 * MiB, WS_PUP = 96 * MiB, WS_HN = 128 * MiB, WS_YMIX = 192 * MiB;
constexpr size_t WS_PROJ = 256 * MiB, WS_XQ = 256 * MiB, WS_PQ = 320 * MiB, WS_PIDX = 448 * MiB, WS_PGATE = 464 * MiB, WS_END = 480 * MiB;
constexpr size_t WS_SHV = 56 * MiB;
constexpr size_t WS_SAM = 55 * MiB, WS_SBKV = 55 * MiB + 64 * 1024, WS_CMXK = 55 * MiB + 128 * 1024, WS_CMXV = 55 * MiB + 192 * 1024;
constexpr int CW_BAR = 4096;

constexpr int RING_BYTES = 131072;
constexpr int MISC_OFF = 163584;
constexpr int LDS_BYTES = 163840;

#define GAS __attribute__((address_space(1)))
#define LAS __attribute__((address_space(3)))
#define DI __device__ __forceinline__
typedef unsigned short bf16;
typedef unsigned v4u __attribute__((ext_vector_type(4)));
typedef unsigned v2u __attribute__((ext_vector_type(2)));
typedef float f32x4 __attribute__((ext_vector_type(4)));
typedef float f32x16 __attribute__((ext_vector_type(16)));
typedef short bf16x8 __attribute__((ext_vector_type(8)));
typedef short s16x4 __attribute__((ext_vector_type(4)));
typedef float f32x2_t __attribute__((ext_vector_type(2)));
typedef __bf16 bf16x2_t __attribute__((ext_vector_type(2)));
#define RLX_AGENT __ATOMIC_RELAXED, __HIP_MEMORY_SCOPE_AGENT
#define LDS_WAIT() asm volatile("s_waitcnt lgkmcnt(0)" ::: "memory")
#define MFMA32(a, b, c) __builtin_amdgcn_mfma_f32_32x32x16_bf16((a), (b), (c), 0, 0, 0)

DI unsigned pk2(float lo, float hi) { f32x2_t v = {lo, hi}; bf16x2_t b = __builtin_convertvector(v, bf16x2_t); return __builtin_bit_cast(unsigned, b); }
DI bf16 f2bf(float f) { return (bf16)(pk2(f, 0.f) & 0xffffu); }
DI float bf2f(bf16 b) { return __uint_as_float((unsigned)b << 16); }
DI float bflo(unsigned u) { return __uint_as_float(u << 16); }
DI float bfhi(unsigned u) { return __uint_as_float(u & 0xffff0000u); }
DI float rlane(float v, int l);
DI float wave_sum(float v) {
    v += __uint_as_float((unsigned)__builtin_amdgcn_update_dpp(0, (int)__float_as_uint(v), 0xB1, 0xF, 0xF, true));
    v += __uint_as_float((unsigned)__builtin_amdgcn_update_dpp(0, (int)__float_as_uint(v), 0x4E, 0xF, 0xF, true));
    v += __uint_as_float((unsigned)__builtin_amdgcn_update_dpp(0, (int)__float_as_uint(v), 0x141, 0xF, 0xF, true));
    v += __uint_as_float((unsigned)__builtin_amdgcn_update_dpp(0, (int)__float_as_uint(v), 0x140, 0xF, 0xF, true));
    return (rlane(v, 0) + rlane(v, 16)) + (rlane(v, 32) + rlane(v, 48));
}
DI float rlane(float v, int l)   { return __uint_as_float((unsigned)__builtin_amdgcn_readlane((int)__float_as_uint(v), l)); }
DI int crow(int i, int h) { return (i & 3) + 8 * (i >> 2) + 4 * h; }
DI float gelu_erf(float v) { return 0.5f * v * (1.0f + erff(v * 0.70710678118654752f)); }

#define XB_TMO      128
#define XB_XCNT(j)  (256  + 64 * (j))
#define XB_XSUB(j)  (1280 + 64 * (j))
#define XB_XGEN(j)  (2304 + 64 * (j))
#define XB_TOP      3328
#define XB_TOPGEN   3392
#define XCD_BAR_WORDS 3456
#define XB_SPIN_CAP (1u << 22)

DI unsigned xb_ld(unsigned* p)              { return __hip_atomic_load(p, __ATOMIC_RELAXED, __HIP_MEMORY_SCOPE_AGENT); }
DI unsigned xb_add(unsigned* p, unsigned v) { return __hip_atomic_fetch_add(p, v, __ATOMIC_RELAXED, __HIP_MEMORY_SCOPE_AGENT); }
DI unsigned xb_xcc_id() { return (unsigned)__builtin_amdgcn_s_getreg((3 << 11) | 20) & 0xFu; }
#define XB_SPIN(cond, bar) do { unsigned _sp = 0; while (cond) { __builtin_amdgcn_s_sleep(1); \
    if ((++_sp & 255u) == 0u) { if (xb_ld(&(bar)[XB_TMO])) break; if (_sp > XB_SPIN_CAP) { atomicAdd(&(bar)[XB_TMO], 1u); break; } } } } while (0)

struct XcdBarrier { unsigned* bar; unsigned x; volatile LAS unsigned* st; };

DI XcdBarrier xcd_barrier_post(unsigned* bar, volatile LAS unsigned* st) {
    XcdBarrier b; b.bar = bar; b.x = xb_xcc_id(); b.st = st;
    if (threadIdx.x == 0) (void)xb_add(&bar[XB_XCNT(b.x)], 1u);
    return b;
}
DI void xcd_barrier_complete(unsigned* bar, unsigned x, unsigned& nloc, unsigned& mask) {
    const unsigned G = gridDim.x * gridDim.y * gridDim.z;
    unsigned sum, mine, m, sp = 0u;
    for (;;) {
        sum = 0u; mine = 0u; m = 0u;
#pragma unroll
        for (unsigned j = 0; j < 16; ++j) { const unsigned c = xb_ld(&bar[XB_XCNT(j)]); sum += c; m |= (c > 0u) ? (1u << j) : 0u; mine = (j == x) ? c : mine; }
        if (sum == G) break;
        __builtin_amdgcn_s_sleep(1);
        if ((++sp & 255u) == 0u) { if (xb_ld(&bar[XB_TMO])) break; if (sp > XB_SPIN_CAP) { atomicAdd(&bar[XB_TMO], 1u); break; } }
    }
    nloc = mine > 0u ? mine : 1u; mask = m ? m : 1u;
}
DI void xcd_barrier(const XcdBarrier& b) {
    asm volatile("s_waitcnt vmcnt(0)" ::: "memory");
    __syncthreads();
    if (threadIdx.x < 64) {
        unsigned* bar = b.bar;
        const unsigned lane = threadIdx.x;
        unsigned gen = 0u, mask = 0u;
        if (lane == 0) {
            __builtin_amdgcn_s_waitcnt(0);
            unsigned nloc = b.st[0]; mask = b.st[1];
            if (nloc == 0u) { xcd_barrier_complete(bar, b.x, nloc, mask); b.st[0] = nloc; b.st[1] = mask; }
            const unsigned old = xb_add(&bar[XB_XSUB(b.x)], 1u);
            gen = old / nloc;
            if (old + 1u == (gen + 1u) * nloc) {
                __builtin_amdgcn_fence(__ATOMIC_RELEASE, "agent");
                asm volatile("s_waitcnt vmcnt(0)" ::: "memory");
                xb_add(&bar[XB_XGEN(b.x)], 1u);
            }
        }
        gen = (unsigned)__builtin_amdgcn_readfirstlane((int)gen); mask = (unsigned)__builtin_amdgcn_readfirstlane((int)mask);
        asm volatile("buffer_inv sc1" ::: "memory");
        const bool mine = lane < 16u && ((mask >> lane) & 1u);
        unsigned sp = 0u;
        for (;;) {
            const unsigned v = mine ? xb_ld(&bar[XB_XGEN(lane & 15u)]) : 0xffffffffu;
            if (!__any(v <= gen)) break;
            if ((++sp & 255u) == 0u) { const unsigned t = xb_ld(&bar[XB_TMO]); if (t) break; if (sp > XB_SPIN_CAP) { if (lane == 0) atomicAdd(&bar[XB_TMO], 1u); break; } }
        }
        asm volatile("s_waitcnt vmcnt(0)" ::: "memory");
    }
    __syncthreads();
}

DI void transpose_item(const float* W, int K, int N, int Npad, bf16* WT, int row_off, LAS float* scr, int item, int lane, const float* ks = nullptr) {
    const int nblk = Npad / 32, kb = item / nblk, nb = item % nblk, k0 = 64 * kb, n0 = 32 * nb;
    {
        const int kr = lane >> 3, nq = n0 + 4 * (lane & 7);
        f32x4 v[8];
#pragma unroll
        for (int i = 0; i < 8; ++i) v[i] = (nq < N) ? *(const f32x4*)(W + (size_t)(k0 + 8 * i + kr) * N + nq) : (f32x4){0.f, 0.f, 0.f, 0.f};
#pragma unroll
        for (int i = 0; i < 8; ++i) { const float sc = ks ? ks[k0 + 8 * i + kr] : 1.0f; LAS float* d = scr + (8 * i + kr) * 33 + 4 * (lane & 7);
            d[0] = v[i].x * sc; d[1] = v[i].y * sc; d[2] = v[i].z * sc; d[3] = v[i].w * sc; }
    }
    LDS_WAIT(); asm volatile("" ::: "memory");
    const int c = lane & 7;
#pragma unroll
    for (int j = 0; j < 4; ++j) { const int n = (lane >> 3) + 8 * j; const LAS float* s = scr + (8 * c) * 33 + n;
        v4u o; o.x = pk2(s[0 * 33], s[1 * 33]); o.y = pk2(s[2 * 33], s[3 * 33]); o.z = pk2(s[4 * 33], s[5 * 33]); o.w = pk2(s[6 * 33], s[7 * 33]);
        *(v4u*)(WT + (size_t)(row_off + n0 + n) * K + k0 + 8 * c) = o; }
    LDS_WAIT(); asm volatile("" ::: "memory");
}
template <int NR>
DI void rms_rows_to_bf16(const float* xrow, const float* w, bf16* orow, int lane) {
    const f32x4* wr = (const f32x4*)w + lane;
    f32x4 v[NR][4]; float s[NR];
#pragma unroll
    for (int q = 0; q < NR; ++q) { const f32x4* xr = (const f32x4*)(xrow + (size_t)q * DM) + lane;
#pragma unroll
        for (int j = 0; j < 4; ++j) v[q][j] = xr[64 * j]; }
#pragma unroll
    for (int q = 0; q < NR; ++q) { s[q] = 0.f;
#pragma unroll
        for (int j = 0; j < 4; ++j) s[q] += (v[q][j].x * v[q][j].x + v[q][j].y * v[q][j].y) + (v[q][j].z * v[q][j].z + v[q][j].w * v[q][j].w); }
#pragma unroll
    for (int q = 0; q < NR; ++q) { const float r = 1.0f / sqrtf(wave_sum(s[q]) * (1.f / DM) + EPS);
        v2u* o8 = (v2u*)(orow + (size_t)q * DM) + lane;
#pragma unroll
        for (int j = 0; j < 4; ++j) { const f32x4 ww = wr[64 * j]; v2u o; o.x = pk2(v[q][j].x * r * ww.x, v[q][j].y * r * ww.y); o.y = pk2(v[q][j].z * r * ww.z, v[q][j].w * r * ww.w); o8[64 * j] = o; } }
}
DI float wave_max_u(float v) {
    v = fmaxf(v, __uint_as_float((unsigned)__builtin_amdgcn_update_dpp(0, (int)__float_as_uint(v), 0xB1, 0xF, 0xF, true)));
    v = fmaxf(v, __uint_as_float((unsigned)__builtin_amdgcn_update_dpp(0, (int)__float_as_uint(v), 0x4E, 0xF, 0xF, true)));
    v = fmaxf(v, __uint_as_float((unsigned)__builtin_amdgcn_update_dpp(0, (int)__float_as_uint(v), 0x141, 0xF, 0xF, true)));
    v = fmaxf(v, __uint_as_float((unsigned)__builtin_amdgcn_update_dpp(0, (int)__float_as_uint(v), 0x140, 0xF, 0xF, true)));
    return fmaxf(fmaxf(rlane(v, 0), rlane(v, 16)), fmaxf(rlane(v, 32), rlane(v, 48)));
}
DI unsigned q8x4(float a, float b, float c, float d, float inv) {
    return ((unsigned)(int)__builtin_rintf(a * inv) & 0xffu) | (((unsigned)(int)__builtin_rintf(b * inv) & 0xffu) << 8) | (((unsigned)(int)__builtin_rintf(c * inv) & 0xffu) << 16) | (((unsigned)(int)__builtin_rintf(d * inv) & 0xffu) << 24);
}
template <int NR>
DI void rms_rows_to_i8(const float* xrow, const float* w, unsigned char* orow, float* srow, int lane) {
    const f32x4* wr = (const f32x4*)w + lane;
    f32x4 v[NR][4]; float s[NR];
#pragma unroll
    for (int q = 0; q < NR; ++q) { const f32x4* xr = (const f32x4*)(xrow + (size_t)q * DM) + lane;
#pragma unroll
        for (int j = 0; j < 4; ++j) v[q][j] = xr[64 * j]; }
#pragma unroll
    for (int q = 0; q < NR; ++q) { s[q] = 0.f;
#pragma unroll
        for (int j = 0; j < 4; ++j) s[q] += (v[q][j].x * v[q][j].x + v[q][j].y * v[q][j].y) + (v[q][j].z * v[q][j].z + v[q][j].w * v[q][j].w); }
#pragma unroll
    for (int q = 0; q < NR; ++q) { const float r = 1.0f / sqrtf(wave_sum(s[q]) * (1.f / DM) + EPS); float mx = 0.f;
#pragma unroll
        for (int j = 0; j < 4; ++j) { v[q][j] = v[q][j] * r * wr[64 * j]; mx = fmaxf(mx, fmaxf(fmaxf(fabsf(v[q][j].x), fabsf(v[q][j].y)), fmaxf(fabsf(v[q][j].z), fabsf(v[q][j].w)))); }
        mx = wave_max_u(mx); const float inv = mx > 0.f ? 127.0f / mx : 0.f;
        unsigned* o4 = (unsigned*)(orow + (size_t)q * DM) + lane;
#pragma unroll
        for (int j = 0; j < 4; ++j) o4[64 * j] = q8x4(v[q][j].x, v[q][j].y, v[q][j].z, v[q][j].w, inv);
        if (lane == 0) srow[q] = mx * (1.0f / 127.0f); }
}
DI void transpose_item_i8(const float* W, int NR, int NP, const float* cmx, unsigned char* WT, float* sb, LAS float* scr, int item, int lane) {
    const int nblk = NP / 32, kb = item / nblk, nb = item % nblk, k0 = 64 * kb, n0 = 32 * nb;
    const int nn = n0 + (lane & 31);
    float cm = 0.f;
#pragma unroll
    for (int kc = 0; kc < 16; ++kc) cm = fmaxf(cm, cmx[kc * NP + nn]);
    const float inv = cm > 0.f ? 127.0f / cm : 0.f;
    if (kb == 0 && lane < 32) sb[nn] = cm * (1.0f / 127.0f);
    {
        const int kr = lane >> 3, nc = lane & 7, nq = n0 + 4 * nc;
        const float i0 = __shfl(inv, 4 * nc), i1 = __shfl(inv, 4 * nc + 1), i2 = __shfl(inv, 4 * nc + 2), i3 = __shfl(inv, 4 * nc + 3);
        f32x4 v[8];
#pragma unroll
        for (int i = 0; i < 8; ++i) v[i] = (nq < NR) ? *(const f32x4*)(W + (size_t)(k0 + 8 * i + kr) * NR + nq) : (f32x4){0.f, 0.f, 0.f, 0.f};
#pragma unroll
        for (int i = 0; i < 8; ++i) { LAS float* d = scr + (8 * i + kr) * 33 + 4 * nc; d[0] = v[i].x * i0; d[1] = v[i].y * i1; d[2] = v[i].z * i2; d[3] = v[i].w * i3; }
    }
    LDS_WAIT(); asm volatile("" ::: "memory");
    const int c = lane & 7;
#pragma unroll
    for (int j = 0; j < 4; ++j) { const int n = (lane >> 3) + 8 * j; const LAS float* s = scr + (8 * c) * 33 + n;
        v2u o; o.x = q8x4(s[0 * 33], s[1 * 33], s[2 * 33], s[3 * 33], 1.0f); o.y = q8x4(s[4 * 33], s[5 * 33], s[6 * 33], s[7 * 33], 1.0f);
        *(v2u*)(WT + (size_t)(n0 + n) * DM + k0 + 8 * c) = o; }
    LDS_WAIT(); asm volatile("" ::: "memory");
}
DI void cvt_stream(const float* src, bf16* dst, size_t n8, int gthread, int nthreads) {
    for (size_t i = gthread; i < n8; i += nthreads) {
        const f32x4 a = ((const f32x4*)src)[2 * i], b = ((const f32x4*)src)[2 * i + 1];
        v4u o; o.x = pk2(a.x, a.y); o.y = pk2(a.z, a.w); o.z = pk2(b.x, b.y); o.w = pk2(b.z, b.w);
        ((v4u*)dst)[i] = o;
    }
}

DI void colmax_item(const float* W, int NR, int NP, float* cmx, int it, int lane) {
    const int kc = it / (NP / 64), n = 64 * (it % (NP / 64)) + 4 * (lane & 15), kr = lane >> 4; f32x4 mx = {0.f, 0.f, 0.f, 0.f};
    if (n < NR) {
#pragma unroll
        for (int i = 0; i < 16; ++i) { const f32x4 v = *(const f32x4*)(W + (size_t)(64 * kc + 4 * i + kr) * NR + n);
            mx.x = fmaxf(mx.x, fabsf(v.x)); mx.y = fmaxf(mx.y, fabsf(v.y)); mx.z = fmaxf(mx.z, fabsf(v.z)); mx.w = fmaxf(mx.w, fabsf(v.w)); } }
    mx.x = fmaxf(mx.x, __shfl_xor(mx.x, 16)); mx.y = fmaxf(mx.y, __shfl_xor(mx.y, 16)); mx.z = fmaxf(mx.z, __shfl_xor(mx.z, 16)); mx.w = fmaxf(mx.w, __shfl_xor(mx.w, 16));
    mx.x = fmaxf(mx.x, __shfl_xor(mx.x, 32)); mx.y = fmaxf(mx.y, __shfl_xor(mx.y, 32)); mx.z = fmaxf(mx.z, __shfl_xor(mx.z, 32)); mx.w = fmaxf(mx.w, __shfl_xor(mx.w, 32));
    if (kr == 0) *(f32x4*)(cmx + kc * NP + n) = mx;
}
struct Ptrs {
    const float *x, *mem, *mix_norm_w, *w_in, *conv_w, *conv_b, *cmp_pe, *cmp_w1, *cmp_w2, *q_norm_w, *k_norm_w, *w_out, *xattn_norm_w, *mem_norm_w,
                *xq, *xk, *xv, *xo, *xq_norm_w, *xk_norm_w, *ffn_norm_w, *peer_wq, *peer_keys, *peer_down, *peer_up;
    float* out;
    bf16 *WIN, *WOUT, *XQT, *XKVT, *XOT, *PWQT, *PKEYS, *KCMP, *VCMP, *MN, *XKV, *HN, *YMIX, *PROJ, *XQ, *PQ;
    unsigned char *PDOWN, *PUP;
    float *B1P, *PGATE, *PSC, *SSP1, *SSP2, *SA1, *SB1, *CMX, *SH, *SBQ, *CMXQ, *SAM, *SBKV, *CMXK, *CMXV, *SHV; int* PIDX; bf16* CW1T; unsigned char *HN8, *WIN8, *H8, *PWQ8;
};

DI void p0_prologue(const Ptrs& P, LAS unsigned char* lds, int gw, int NGW, int wave, int lane, int part, int pm = 7) {
    LAS float* scr = (LAS float*)(lds + wave * 16384);
    if (part == 1 && !(pm & 1)) return;
    if (part == 1) {
        constexpr int J_IN = (DM / 64) * (INP / 32), J_PQ = (DM / 64) * (2048 / 32), J_SQ = (DM / 64) * (DM / 32);
        for (int it = gw; it < J_IN + J_PQ + 2 * J_SQ; it += NGW) {
            if (it < J_IN) transpose_item_i8(P.w_in, INC, INP, P.CMX, P.WIN8, P.SB1, scr, it, lane);
            else if (it < J_IN + J_PQ) transpose_item_i8(P.peer_wq, 2048, 2048, P.CMXQ, P.PWQ8, P.SBQ, scr, it - J_IN, lane);
            else if (it < J_IN + J_PQ + J_SQ) transpose_item_i8(P.xk, DM, DM, P.CMXK, (unsigned char*)P.XKVT, P.SBKV, scr, it - J_IN - J_PQ, lane);
            else transpose_item_i8(P.xv, DM, DM, P.CMXV, (unsigned char*)P.XKVT + (size_t)DM * DM, P.SBKV + DM, scr, it - J_IN - J_PQ - J_SQ, lane); }
        return;
    }
    if (pm & 1) for (int it = gw; it < 16 * (INP / 64) + 16 * (2048 / 64) + 2 * 16 * (DM / 64); it += NGW) {
        if (it < 16 * (INP / 64)) colmax_item(P.w_in, INC, INP, P.CMX, it, lane);
        else if (it < 16 * (INP / 64) + 16 * (2048 / 64)) colmax_item(P.peer_wq, 2048, 2048, P.CMXQ, it - 16 * (INP / 64), lane);
        else if (it < 16 * (INP / 64) + 16 * (2048 / 64) + 16 * (DM / 64)) colmax_item(P.xk, DM, DM, P.CMXK, it - 16 * (INP / 64) - 16 * (2048 / 64), lane);
        else colmax_item(P.xv, DM, DM, P.CMXV, it - 16 * (INP / 64) - 16 * (2048 / 64) - 16 * (DM / 64), lane); }
    constexpr int I_IN = (DM / 64) * (INP / 32), I_SQ = (DM / 64) * (DM / 32), I_PQ = (DM / 64) * (2048 / 32);
    constexpr int NITEMS = 3 * I_SQ;
    if (pm & 1) for (int it = gw; it < NITEMS; it += NGW) {
        int r = it;
        if (r < I_SQ) { transpose_item(P.w_out, DM, DM, DM, P.WOUT, 0, scr, r, lane); continue; } r -= I_SQ;
        if (r < I_SQ) { transpose_item(P.xq, DM, DM, DM, P.XQT, 0, scr, r, lane, P.xattn_norm_w); continue; } r -= I_SQ;
        transpose_item(P.xo, DM, DM, DM, P.XOT, 0, scr, r, lane);
    }
    for (int it = gw; it < 128; it += NGW) {
        const int q = it >> 5, r = it & 31;
        transpose_item(P.cmp_w1 + (size_t)q * 1024 * 64, 1024, 64, 64, P.CW1T + (size_t)(q >> 1) * 128 * 1024, (q & 1) * 64, scr, r, lane);
    }
    for (int it = gw; it < 64; it += NGW) {
        const int kv = it >> 5, l = it & 31;
        const float pv = P.cmp_pe[(kv * 32 + l) * 64 + lane];
        const float* w1 = P.cmp_w1 + ((size_t)kv * 2048 + l * 64) * 64 + lane;
        float acc = 0.f;
#pragma unroll 16
        for (int d = 0; d < 64; ++d) acc += rlane(pv, d) * w1[d * 64];
        P.B1P[it * 64 + lane] = acc;
    }
    if (pm & 2) for (int m = 4 * gw; m < NTOK; m += 4 * NGW) rms_rows_to_i8<4>(P.x + (size_t)m * DM, P.mix_norm_w, P.HN8 + (size_t)m * DM, P.SA1 + m, lane);
    if (pm & 2) for (int m = 2 * gw; m < NMEM; m += 2 * NGW) rms_rows_to_i8<2>(P.mem + (size_t)m * DM, P.mem_norm_w, (unsigned char*)P.MN + (size_t)m * DM, P.SAM + m, lane);
    const int gthread = gw * 64 + lane, nthreads = NGW * 64;
    if (pm & 4) for (int e = gw; e < NEXP; e += NGW) {
        f32x4 v2[2][4];
#pragma unroll
        for (int tb = 0; tb < 2; ++tb) { const f32x4* src = (const f32x4*)((tb ? P.peer_up : P.peer_down) + (size_t)e * DM) + (tb ? lane : 4 * lane);
#pragma unroll
            for (int j = 0; j < 4; ++j) v2[tb][j] = src[tb ? 64 * j : j]; }
        unsigned wq[2][2];
        float mxs[2];
#pragma unroll
        for (int tb = 0; tb < 2; ++tb) { float mx = 0.f;
#pragma unroll
            for (int j = 0; j < 4; ++j) mx = fmaxf(mx, fmaxf(fmaxf(fabsf(v2[tb][j].x), fabsf(v2[tb][j].y)), fmaxf(fabsf(v2[tb][j].z), fabsf(v2[tb][j].w))));
            mxs[tb] = mx; }
        const bf16 sd16 = f2bf(mxs[0] * (1.0f / 7.0f));
        const _Float16 suh = (_Float16)(mxs[1] * (1.0f / 6.0f)); const unsigned short su16 = __builtin_bit_cast(unsigned short, suh);
        const unsigned scw = ((unsigned)sd16 << 16) | (unsigned)su16;
#pragma unroll
        for (int tb = 0; tb < 2; ++tb) {
        f32x4 v[4];
#pragma unroll
        for (int j = 0; j < 4; ++j) v[j] = v2[tb][j];
        const float sc = tb ? (float)suh : __uint_as_float(scw), inv = (tb ? su16 : sd16) ? 1.0f / sc : 0.f;
#pragma unroll
        for (int d = 0; d < 2; ++d) { unsigned acc = 0u;
            if (tb) {
#define FP4_PAIR(B) { const int c = 8 * d + 2 * (B); const float x0 = fminf(fmaxf(v[c >> 2][c & 3] * inv, -6.0f), 6.0f), x1 = fminf(fmaxf(v[(c + 1) >> 2][(c + 1) & 3] * inv, -6.0f), 6.0f); \
                    acc = __builtin_amdgcn_cvt_scalef32_pk_fp4_f32(acc, x0, x1, 1.0f, (B)); }
                FP4_PAIR(0) FP4_PAIR(1) FP4_PAIR(2) FP4_PAIR(3)
#undef FP4_PAIR
            } else {
#pragma unroll
                for (int i = 0; i < 8; ++i) { const float x = v[2 * d + (i >> 2)][i & 3]; int q2 = (int)__builtin_rintf(x * inv); q2 = q2 < -7 ? -7 : (q2 > 7 ? 7 : q2); acc |= ((unsigned)q2 & 0xFu) << (4 * i); }
            }
            wq[tb][d] = acc; }
        }
        unsigned char* rp = P.PDOWN + (size_t)e * PEER_ROW_BYTES;
        *(v4u*)(rp + 16 * lane) = (v4u){wq[0][0], wq[0][1], wq[1][0], wq[1][1]};
        *(unsigned*)(rp + 1024 + 4 * lane) = scw;
    }
    cvt_stream(P.peer_keys, P.PKEYS, (size_t)8 * 2 * 128 * 128 / 8, gthread, nthreads);
}

template <int CTRL> DI float dppf(float v) { return __uint_as_float((unsigned)__builtin_amdgcn_update_dpp(0, (int)__float_as_uint(v), CTRL, 0xF, 0xF, true)); }
DI float sum8(float v) { v += dppf<0xB1>(v); v += dppf<0x4E>(v); v += dppf<0x141>(v); return v; }
DI float sum32(float v) { v = sum8(v); v += dppf<0x140>(v); v += __shfl_xor(v, 16); return v; }
constexpr int CM_SA_OFF = 0, CM_SB_OFF = 36864, CM_P_OFF = 0, CM_H_OFF = 73728, CM_W2_OFF = CM_H_OFF + 128 * 68 * 4, CM_B_OFF = CM_W2_OFF + 64 * 64 * 4;
DI void compress_unit(const Ptrs& P, LAS unsigned char* lds, int kv, int b, int g, int tid, int wave, int lane) {
    LAS float* Pl = (LAS float*)(lds + CM_P_OFF); LAS float* Hl = (LAS float*)(lds + CM_H_OFF); LAS float* W2l = (LAS float*)(lds + CM_W2_OFF); LAS float* Bl = (LAS float*)(lds + CM_B_OFF);
    const int r = lane & 31, h = lane >> 5, wm = wave >> 1, wn = wave & 1;
    __syncthreads();
    for (int e = tid; e < 64 * 64; e += NTHR) W2l[e] = P.cmp_w2[(size_t)kv * 4096 + e];
    if (tid < 64) { float s = 0.f;
#pragma unroll 8
        for (int l = 0; l < 32; ++l) s += P.B1P[(kv * 32 + l) * 64 + tid];
        Bl[tid] = s; }
    {
        const bf16* abase = P.PROJ + (size_t)b * SEQ * INP + (kv ? C_VC : C_KC) + g * 64;
        const bf16* bbase = P.CW1T + (size_t)kv * 128 * 1024;
        const int srow = tid >> 3, sch = tid & 7;
        v4u ra[2], rb[2];
#define CM_GLOAD(L) { _Pragma("unroll") for (int k2 = 0; k2 < 2; ++k2) { const int row = srow + 64 * k2; \
            ra[k2] = *(const v4u*)(abase + (size_t)(16 * row + (L)) * INP + sch * 8); rb[k2] = *(const v4u*)(bbase + (size_t)row * 1024 + (L) * 64 + sch * 8); } }
#define CM_LSTORE(BUF) { _Pragma("unroll") for (int k2 = 0; k2 < 2; ++k2) { const int row = srow + 64 * k2; \
            *(LAS v4u*)(lds + CM_SA_OFF + (BUF) * 18432 + row * 144 + sch * 16) = ra[k2]; *(LAS v4u*)(lds + CM_SB_OFF + (BUF) * 18432 + row * 144 + sch * 16) = rb[k2]; } }
        CM_GLOAD(0) CM_LSTORE(0) CM_GLOAD(1)
        f32x16 acc[2];
#pragma unroll
        for (int i = 0; i < 16; ++i) { acc[0][i] = 0.f; acc[1][i] = 0.f; }
#pragma unroll 1
        for (int l = 0; l < 16; ++l) {
            __syncthreads();
            if (l + 1 < 16) { CM_LSTORE((l + 1) & 1) if (l + 2 < 16) CM_GLOAD(l + 2) }
            LAS const unsigned char* ap = lds + CM_SA_OFF + (l & 1) * 18432 + (32 * wm + r) * 144 + h * 16;
            LAS const unsigned char* bp = lds + CM_SB_OFF + (l & 1) * 18432 + (64 * wn + r) * 144 + h * 16;
#pragma unroll
            for (int kk = 0; kk < 4; ++kk) { const bf16x8 a = *(LAS const bf16x8*)(ap + kk * 32), b0 = *(LAS const bf16x8*)(bp + kk * 32), b1 = *(LAS const bf16x8*)(bp + 32 * 144 + kk * 32);
                acc[0] = MFMA32(a, b0, acc[0]); acc[1] = MFMA32(a, b1, acc[1]); }
        }
#undef CM_GLOAD
#undef CM_LSTORE
        __syncthreads();
#pragma unroll
        for (int t = 0; t < 2; ++t)
#pragma unroll
            for (int i = 0; i < 16; ++i) Pl[(32 * wm + crow(i, h)) * 132 + 64 * wn + 32 * t + r] = acc[t][i];
    }
    __syncthreads();
    for (int e = tid; e < 128 * 64; e += NTHR) { const int n = e >> 6, j = e & 63;
        Hl[n * 68 + j] = (n < 127) ? gelu_erf(Pl[n * 132 + j] + Pl[(n + 1) * 132 + 64 + j] + Bl[j]) : 0.f; }
    __syncthreads();
    {
        const int n = tid >> 2, jq = tid & 3;
        float o[16];
#pragma unroll
        for (int j = 0; j < 16; ++j) o[j] = 0.f;
#pragma unroll 4
        for (int m = 0; m < 64; ++m) { const float hv = Hl[n * 68 + m];
#pragma unroll
            for (int j4 = 0; j4 < 4; ++j4) { const f32x4 w = *(LAS const f32x4*)(W2l + m * 64 + jq * 16 + 4 * j4); o[4 * j4] += hv * w.x; o[4 * j4 + 1] += hv * w.y; o[4 * j4 + 2] += hv * w.z; o[4 * j4 + 3] += hv * w.w; } }
        if (kv == 0) { float ss = 0.f;
#pragma unroll
            for (int j = 0; j < 16; ++j) ss += o[j] * o[j];
            ss += dppf<0xB1>(ss); ss += dppf<0x4E>(ss);
            const float rr = 1.0f / sqrtf(ss * (1.f / 64.f) + EPS);
#pragma unroll
            for (int j = 0; j < 16; ++j) o[j] = o[j] * rr * P.k_norm_w[jq * 16 + j]; }
        v4u w0, w1; w0.x = pk2(o[0], o[1]); w0.y = pk2(o[2], o[3]); w0.z = pk2(o[4], o[5]); w0.w = pk2(o[6], o[7]); w1.x = pk2(o[8], o[9]); w1.y = pk2(o[10], o[11]); w1.z = pk2(o[12], o[13]); w1.w = pk2(o[14], o[15]);
        bf16* outp = (kv ? P.VCMP : P.KCMP) + ((size_t)((b * 2 + g) * 128 + n)) * 64 + jq * 16;
        *(v4u*)outp = w0; *(v4u*)(outp + 8) = w1;
    }
}
DI void conv_taps(const Ptrs& P, int c8, float (&cw)[3][8], float (&cb)[8]) {
#pragma unroll
    for (int k = 0; k < 3; ++k) { const f32x4 w0 = *(const f32x4*)(P.conv_w + k * 512 + c8), w1 = *(const f32x4*)(P.conv_w + k * 512 + c8 + 4);
        cw[k][0] = w0.x; cw[k][1] = w0.y; cw[k][2] = w0.z; cw[k][3] = w0.w; cw[k][4] = w1.x; cw[k][5] = w1.y; cw[k][6] = w1.z; cw[k][7] = w1.w; }
    const f32x4 w0 = *(const f32x4*)(P.conv_b + c8), w1 = *(const f32x4*)(P.conv_b + c8 + 4);
    cb[0] = w0.x; cb[1] = w0.y; cb[2] = w0.z; cb[3] = w0.w; cb[4] = w1.x; cb[5] = w1.y; cb[6] = w1.z; cb[7] = w1.w;
}
DI void ch_prod(const bf16* row, int c8, float (&u)[8]) {
    const v4u cv = *(const v4u*)(row + C_C + c8), hv = *(const v4u*)(row + C_H + c8);
    u[0] = bflo(cv.x) * bflo(hv.x); u[1] = bfhi(cv.x) * bfhi(hv.x); u[2] = bflo(cv.y) * bflo(hv.y); u[3] = bfhi(cv.y) * bfhi(hv.y);
    u[4] = bflo(cv.z) * bflo(hv.z); u[5] = bfhi(cv.z) * bfhi(hv.z); u[6] = bflo(cv.w) * bflo(hv.w); u[7] = bfhi(cv.w) * bfhi(hv.w);
}
DI void conv_out(const Ptrs& P, int t, int c8, const float (&cw)[3][8], const float (&cb)[8], const float (&u2)[8], const float (&u1)[8], const float (&u0)[8]) {
    const v4u bv = *(const v4u*)(P.PROJ + (size_t)t * INP + C_B + c8);
    const float bg[8] = {bflo(bv.x), bfhi(bv.x), bflo(bv.y), bfhi(bv.y), bflo(bv.z), bfhi(bv.z), bflo(bv.w), bfhi(bv.w)};
    float y[8];
#pragma unroll
    for (int e = 0; e < 8; ++e) y[e] = bg[e] * (cw[0][e] * u2[e] + cw[1][e] * u1[e] + cw[2][e] * u0[e] + cb[e]);
    v4u o; o.x = pk2(y[0], y[1]); o.y = pk2(y[2], y[3]); o.z = pk2(y[4], y[5]); o.w = pk2(y[6], y[7]);
    *(v4u*)(P.YMIX + (size_t)t * DM + c8) = o;
}
DI void proj_post_conv(const Ptrs& P, int mt, int chb, int wave, int lane) {
    const int c8 = chb + (lane & 31) * 8, stream = wave * 2 + (lane >> 5);
    float cw[3][8], cb[8]; conv_taps(P, c8, cw, cb);
    const int t0 = 256 * mt + 16 * stream, first = t0 + (stream == 0 ? 2 : 0);
    float u2[8], u1[8];
    if (stream) { ch_prod(P.PROJ + (size_t)(t0 - 2) * INP, c8, u2); ch_prod(P.PROJ + (size_t)(t0 - 1) * INP, c8, u1); }
    else {
#pragma unroll
        for (int e = 0; e < 8; ++e) { u2[e] = 0.f; u1[e] = 0.f; } }
#pragma unroll 1
    for (int t = t0; t < t0 + 16; t += 8) {
        v4u cv[8], hv[8], bv[8];
#pragma unroll
        for (int j = 0; j < 8; ++j) { const bf16* row = P.PROJ + (size_t)(t + j) * INP + c8; cv[j] = *(const v4u*)(row + C_C); hv[j] = *(const v4u*)(row + C_H); bv[j] = *(const v4u*)(row + C_B); }
#pragma unroll
        for (int j = 0; j < 8; ++j) {
            const float u0[8] = {bflo(cv[j].x) * bflo(hv[j].x), bfhi(cv[j].x) * bfhi(hv[j].x), bflo(cv[j].y) * bflo(hv[j].y), bfhi(cv[j].y) * bfhi(hv[j].y),
                                 bflo(cv[j].z) * bflo(hv[j].z), bfhi(cv[j].z) * bfhi(hv[j].z), bflo(cv[j].w) * bflo(hv[j].w), bfhi(cv[j].w) * bfhi(hv[j].w)};
            const float bg[8] = {bflo(bv[j].x), bfhi(bv[j].x), bflo(bv[j].y), bfhi(bv[j].y), bflo(bv[j].z), bfhi(bv[j].z), bflo(bv[j].w), bfhi(bv[j].w)};
            float y[8];
#pragma unroll
            for (int e = 0; e < 8; ++e) y[e] = bg[e] * (cw[0][e] * u2[e] + cw[1][e] * u1[e] + cw[2][e] * u0[e] + cb[e]);
            v4u o; o.x = pk2(y[0], y[1]); o.y = pk2(y[2], y[3]); o.z = pk2(y[4], y[5]); o.w = pk2(y[6], y[7]);
            if (t + j >= first) *(v4u*)(P.YMIX + (size_t)(t + j) * DM + c8) = o;
#pragma unroll
            for (int e = 0; e < 8; ++e) { u2[e] = u1[e]; u1[e] = u0[e]; }
        }
    }
}
DI void proj_post_knorm(const Ptrs& P, int mt, int wave, int lane) {
    const int grp = (lane >> 3) & 3, ch = lane & 7;
    const f32x4 w0 = *(const f32x4*)(P.k_norm_w + (grp < 2 ? 64 : 128) + ch * 8), w1 = *(const f32x4*)(P.k_norm_w + (grp < 2 ? 64 : 128) + ch * 8 + 4);
#pragma unroll 4
    for (int i = 0; i < 128 / NWAVES; ++i) {
        const int t = 256 * mt + (wave + NWAVES * i) * 2 + (lane >> 5);
        bf16* p = P.PROJ + (size_t)t * INP + (grp < 2 ? C_KS : C_KW) + (grp & 1) * 64 + ch * 8;
        const v4u u = *(const v4u*)p;
        const float a = bflo(u.x), b = bfhi(u.x), c = bflo(u.y), d = bfhi(u.y), e = bflo(u.z), f = bfhi(u.z), g2 = bflo(u.w), k = bfhi(u.w);
        const float ss = sum8(((a * a + b * b) + (c * c + d * d)) + ((e * e + f * f) + (g2 * g2 + k * k)));
        const float rr = 1.0f / sqrtf(ss * (1.f / 64.f) + EPS);
        v4u o; o.x = pk2(a * rr * w0.x, b * rr * w0.y); o.y = pk2(c * rr * w0.z, d * rr * w0.w); o.z = pk2(e * rr * w1.x, f * rr * w1.y); o.w = pk2(g2 * rr * w1.z, k * rr * w1.w);
        *(v4u*)p = o;
    }
}
DI void p2_misc(const Ptrs& P, LAS unsigned char* lds, int vcu, int G, int tid, int wave, int lane, bool do_norm) {
    const int ncw = G >> 2;
    if ((vcu & 3) == 0) {
        for (int u = vcu >> 2; u < 64; u += ncw) compress_unit(P, lds, u >> 5, (u >> 1) & 15, u & 1, tid, wave, lane);
        return;
    }
    const int ov = (vcu >> 2) * 3 + (vcu & 3) - 1, gw = ov * NWAVES + wave, NGW = (G - ncw) * NWAVES;
    if (do_norm) {
        pg8::Gemm g{P.MN, P.XKVT, NMEM, 2048, DM / 2}; pg8::StaticOrder S; S.init(NMEM, 2048, G - ncw, ov);
        pg8::EpiI8Bf16 E{P.XKV, 2048, P.SAM, P.SBKV};
        pg8::gemm_phase<pg8::EpiI8Bf16, pg8::StaticOrder, true, true, true>(lds, g, S, E);
        asm volatile("s_waitcnt vmcnt(0)" ::: "memory"); __syncthreads();
        pg8::Unit un;
        for (int ui = 0; S.next(ui, un); ++ui) if (un.pn < 4) {
            const int ch = lane & 31;
            f32x4 w0 = *(const f32x4*)(P.xk_norm_w + ch * 8), w1 = *(const f32x4*)(P.xk_norm_w + ch * 8 + 4);
            w0 *= *(const f32x4*)(P.xq_norm_w + ch * 8); w1 *= *(const f32x4*)(P.xq_norm_w + ch * 8 + 4);
#pragma unroll 4
            for (int i = 0; i < 256 / (2 * NWAVES); ++i) { const int m = un.pm * 256 + 2 * (wave + NWAVES * i) + (lane >> 5);
                bf16* p = P.XKV + (size_t)m * 2048 + un.pn * 256 + ch * 8;
                const v4u u = *(const v4u*)p;
                const float a = bflo(u.x), b = bfhi(u.x), c = bflo(u.y), d = bfhi(u.y), e = bflo(u.z), f = bfhi(u.z), g2 = bflo(u.w), k = bfhi(u.w);
                const float ss = sum32(((a * a + b * b) + (c * c + d * d)) + ((e * e + f * f) + (g2 * g2 + k * k)));
                const float rr = 1.0f / sqrtf(ss * (1.f / 256.f) + EPS);
                v4u o; o.x = pk2(a * rr * w0.x, b * rr * w0.y); o.y = pk2(c * rr * w0.z, d * rr * w0.w); o.z = pk2(e * rr * w1.x, f * rr * w1.y); o.w = pk2(g2 * rr * w1.z, k * rr * w1.w);
                *(v4u*)p = o; }
        }
    }
    {
        const int c8 = lane * 8;
        float cw[3][8], cb[8]; conv_taps(P, c8, cw, cb);
        for (int i = gw; i < 2 * (NTOK / 256); i += NGW) {
            const int t = (i >> 1) * 256 + (i & 1), s = t & (SEQ - 1);
            float u[3][8];
#pragma unroll
            for (int k = 0; k < 3; ++k) {
                const int back = 2 - k;
                if (s >= back) ch_prod(P.PROJ + (size_t)(t - back) * INP, c8, u[k]);
                else {
#pragma unroll
                    for (int e = 0; e < 8; ++e) u[k][e] = 0.f; }
            }
            conv_out(P, t, c8, cw, cb, u[0], u[1], u[2]);
        }
    }
}
DI void xk_norm(const Ptrs& P, int gw, int NGW, int lane) {
    for (int it = gw; it < NMEM * 4 / 2; it += NGW) {
        const int rowid = it * 2 + (lane >> 5), m = rowid >> 2, hd = rowid & 3, ch = lane & 31;
        bf16* p = P.XKV + (size_t)m * 2048 + hd * 256 + ch * 8;
        const v4u u = *(const v4u*)p;
        const float a = bflo(u.x), b = bfhi(u.x), c = bflo(u.y), d = bfhi(u.y), e = bflo(u.z), f = bfhi(u.z), g2 = bflo(u.w), k = bfhi(u.w);
        const float ss = sum32(((a * a + b * b) + (c * c + d * d)) + ((e * e + f * f) + (g2 * g2 + k * k)));
        const float rr = 1.0f / sqrtf(ss * (1.f / 256.f) + EPS);
        f32x4 w0 = *(const f32x4*)(P.xk_norm_w + ch * 8), w1 = *(const f32x4*)(P.xk_norm_w + ch * 8 + 4);
        w0 *= *(const f32x4*)(P.xq_norm_w + ch * 8); w1 *= *(const f32x4*)(P.xq_norm_w + ch * 8 + 4);
        v4u o; o.x = pk2(a * rr * w0.x, b * rr * w0.y); o.y = pk2(c * rr * w0.z, d * rr * w0.w); o.z = pk2(e * rr * w1.x, f * rr * w1.y); o.w = pk2(g2 * rr * w1.z, k * rr * w1.w);
        *(v4u*)p = o;
    }
}
DI void p9_quant_h(const Ptrs& P, int gw, int NGW, int lane) {
    const f32x4 w0 = *(const f32x4*)(P.ffn_norm_w + 16 * lane), w1 = *(const f32x4*)(P.ffn_norm_w + 16 * lane + 4), w2 = *(const f32x4*)(P.ffn_norm_w + 16 * lane + 8), w3 = *(const f32x4*)(P.ffn_norm_w + 16 * lane + 12);
    for (int t0 = 4 * gw; t0 < NTOK; t0 += 4 * NGW) {
        v4u ha[4], hb[4];
#pragma unroll
        for (int q = 0; q < 4; ++q) { ha[q] = *(const v4u*)(P.HN + (size_t)(t0 + q) * DM + 16 * lane); hb[q] = *(const v4u*)(P.HN + (size_t)(t0 + q) * DM + 16 * lane + 8); }
#pragma unroll
        for (int q = 0; q < 4; ++q) {
            const float h0 = bflo(ha[q].x) * w0.x, h1 = bfhi(ha[q].x) * w0.y, h2 = bflo(ha[q].y) * w0.z, h3 = bfhi(ha[q].y) * w0.w, h4 = bflo(ha[q].z) * w1.x, h5 = bfhi(ha[q].z) * w1.y, h6 = bflo(ha[q].w) * w1.z, h7 = bfhi(ha[q].w) * w1.w;
            const float h8 = bflo(hb[q].x) * w2.x, h9 = bfhi(hb[q].x) * w2.y, h10 = bflo(hb[q].y) * w2.z, h11 = bfhi(hb[q].y) * w2.w, h12 = bflo(hb[q].z) * w3.x, h13 = bfhi(hb[q].z) * w3.y, h14 = bflo(hb[q].w) * w3.z, h15 = bfhi(hb[q].w) * w3.w;
            float mx = fmaxf(fmaxf(fmaxf(fabsf(h0), fabsf(h1)), fmaxf(fabsf(h2), fabsf(h3))), fmaxf(fmaxf(fabsf(h4), fabsf(h5)), fmaxf(fabsf(h6), fabsf(h7))));
            mx = fmaxf(mx, fmaxf(fmaxf(fmaxf(fabsf(h8), fabsf(h9)), fmaxf(fabsf(h10), fabsf(h11))), fmaxf(fmaxf(fabsf(h12), fabsf(h13)), fmaxf(fabsf(h14), fabsf(h15)))));
            mx = wave_max_u(mx);
            const float inv = mx > 0.f ? 119.0f / mx : 0.f;
            const v4u o = {q8x4(h0, h1, h2, h3, inv), q8x4(h4, h5, h6, h7, inv), q8x4(h8, h9, h10, h11, inv), q8x4(h12, h13, h14, h15, inv)};
            *(v4u*)(P.H8 + (size_t)(t0 + q) * DM + 16 * lane) = o;
            if (lane == 0) { P.SH[t0 + q] = mx * (1.0f / 119.0f);
                const float* sp = P.SSP2 + (size_t)(t0 + q) * 16; const f32x4 p0 = *(const f32x4*)sp, p1 = *(const f32x4*)(sp + 4), p2 = *(const f32x4*)(sp + 8), p3 = *(const f32x4*)(sp + 12);
                const float rt = 1.0f / sqrtf((((p0.x + p0.y) + (p0.z + p0.w)) + ((p1.x + p1.y) + (p1.z + p1.w)) + ((p2.x + p2.y) + (p2.z + p2.w)) + ((p3.x + p3.y) + (p3.z + p3.w))) * (1.f / DM) + EPS);
                P.SHV[t0 + q] = mx * (1.0f / 119.0f) * rt; }
        }
    }
}

DI s16x4 tr_read(LAS const char* p) { return __builtin_bit_cast(s16x4, __builtin_amdgcn_ds_read_tr16_b64_v4i16((LAS s16x4*)p)); }
DI bf16x8 pack8a(const f32x16& x) { v4u p; p.x = pk2(x[0], x[1]); p.y = pk2(x[2], x[3]); p.z = pk2(x[4], x[5]); p.w = pk2(x[6], x[7]); return __builtin_bit_cast(bf16x8, p); }
DI bf16x8 pack8b(const f32x16& x) { v4u p; p.x = pk2(x[8], x[9]); p.y = pk2(x[10], x[11]); p.z = pk2(x[12], x[13]); p.w = pk2(x[14], x[15]); return __builtin_bit_cast(bf16x8, p); }
DI float max16(const f32x16& x) {
    float a = fmaxf(fmaxf(x[0], x[1]), fmaxf(x[2], x[3])), b = fmaxf(fmaxf(x[4], x[5]), fmaxf(x[6], x[7]));
    float c = fmaxf(fmaxf(x[8], x[9]), fmaxf(x[10], x[11])), d = fmaxf(fmaxf(x[12], x[13]), fmaxf(x[14], x[15]));
    return fmaxf(fmaxf(a, b), fmaxf(c, d));
}
DI float sum16(const f32x16& x) {
    return (((x[0] + x[1]) + (x[2] + x[3])) + ((x[4] + x[5]) + (x[6] + x[7]))) + (((x[8] + x[9]) + (x[10] + x[11])) + ((x[12] + x[13]) + (x[14] + x[15])));
}
template <int DH>
DI void qk_tile(LAS const char* ksm, const bf16x8* qf, f32x16& s0, f32x16& s1, int lane) {
    constexpr int KP = (DH + 8) * 2;
    LAS const char* kp = ksm + (lane & 31) * KP + (lane >> 5) * 16;
#pragma unroll
    for (int i = 0; i < 16; ++i) { s0[i] = 0.f; s1[i] = 0.f; }
#pragma unroll
    for (int d0 = 0; d0 < DH / 16; ++d0) {
        const bf16x8 a0 = *(LAS const bf16x8*)(kp + d0 * 32);
        const bf16x8 a1 = *(LAS const bf16x8*)(kp + 32 * KP + d0 * 32);
        s0 = MFMA32(a0, qf[d0], s0); s1 = MFMA32(a1, qf[d0], s1);
        if ((d0 & 3) == 3) __builtin_amdgcn_sched_barrier(0);
    }
}
template <int DH, int ND>
DI void pv_tile(LAS const char* vsm, const f32x16& p0, const f32x16& p1, f32x16* o, int dbase, int lane) {
    constexpr int VP = (DH + 32) * 2;
    const int h = lane >> 5, q4 = (lane & 15) >> 2, p = lane & 3, blk = (lane >> 4) & 1;
    LAS const char* vp = vsm + (4 * h + q4) * VP + (dbase + 16 * blk) * 2 + 8 * p;
    const bf16x8 pb0 = pack8a(p0), pb1 = pack8b(p0), pb2 = pack8a(p1), pb3 = pack8b(p1);
#pragma unroll
    for (int db = 0; db < ND; ++db) {
#define PV_STEP(S4, PB) { const s16x4 lo = tr_read(vp + (16 * (S4)) * VP + db * 64), hi = tr_read(vp + (16 * (S4) + 8) * VP + db * 64); \
        const bf16x8 va = __builtin_shufflevector(lo, hi, 0, 1, 2, 3, 4, 5, 6, 7); o[db] = MFMA32(va, PB, o[db]); }
        PV_STEP(0, pb0) PV_STEP(1, pb1) PV_STEP(2, pb2) PV_STEP(3, pb3)
        __builtin_amdgcn_sched_barrier(0);
#undef PV_STEP
    }
}
template <int DH, int ND>
DI void pv_tile_packed(LAS const char* vsm, const bf16x8& pb0, const bf16x8& pb1, const bf16x8& pb2, const bf16x8& pb3, f32x16* o, int dbase, int lane) {
    constexpr int VP = (DH + 32) * 2;
    const int h = lane >> 5, q4 = (lane & 15) >> 2, p = lane & 3, blk = (lane >> 4) & 1;
    LAS const char* vp = vsm + (4 * h + q4) * VP + (dbase + 16 * blk) * 2 + 8 * p;
#pragma unroll
    for (int db = 0; db < ND; ++db) {
#define PV_STEP(S4, PB) { const s16x4 lo = tr_read(vp + (16 * (S4)) * VP + db * 64), hi = tr_read(vp + (16 * (S4) + 8) * VP + db * 64); \
        const bf16x8 va = __builtin_shufflevector(lo, hi, 0, 1, 2, 3, 4, 5, 6, 7); o[db] = MFMA32(va, PB, o[db]); }
        PV_STEP(0, pb0) PV_STEP(1, pb1) PV_STEP(2, pb2) PV_STEP(3, pb3)
        __builtin_amdgcn_sched_barrier(0);
#undef PV_STEP
    }
}
DI void mask_tile(f32x16& s0, f32x16& s1, int klo, int khi, int h) {
    int hh = 4 * h; asm volatile("" : "+v"(hh));
    const int kl = klo - hh, kh = khi - hh;
#pragma unroll
    for (int i = 0; i < 16; ++i) { const int c0 = (i & 3) + 8 * (i >> 2), c1 = 32 + c0;
        s0[i] = (c0 >= kl && c0 <= kh) ? s0[i] : -INFINITY; s1[i] = (c1 >= kl && c1 <= kh) ? s1[i] : -INFINITY; }
}
DI float fmax3(float a, float b, float c) { float r; asm("v_max3_f32 %0, %1, %2, %3" : "=v"(r) : "v"(a), "v"(b), "v"(c)); return r; }
DI float max32(const f32x16& a, const f32x16& b) {
    float t0 = fmax3(a[0], a[1], a[2]), t1 = fmax3(a[3], a[4], a[5]), t2 = fmax3(a[6], a[7], a[8]), t3 = fmax3(a[9], a[10], a[11]), t4 = fmax3(a[12], a[13], a[14]);
    float u0 = fmax3(b[0], b[1], b[2]), u1 = fmax3(b[3], b[4], b[5]), u2 = fmax3(b[6], b[7], b[8]), u3 = fmax3(b[9], b[10], b[11]), u4 = fmax3(b[12], b[13], b[14]);
    t0 = fmax3(t0, t1, t2); t3 = fmax3(t3, t4, a[15]); u0 = fmax3(u0, u1, u2); u3 = fmax3(u3, u4, b[15]);
    return fmax3(fmax3(t0, t3, u0), u3, u3);
}
DI float max16t(const f32x16& a) {
    const float t0 = fmax3(a[0], a[1], a[2]), t1 = fmax3(a[3], a[4], a[5]), t2 = fmax3(a[6], a[7], a[8]), t3 = fmax3(a[9], a[10], a[11]), t4 = fmax3(a[12], a[13], a[14]);
    return fmax3(fmax3(t0, t1, t2), fmax3(t3, t4, a[15]), t0);
}
template <int ND>
DI void softmax_tile(f32x16& s0, f32x16& s1, f32x16* o, float& m, float& l, float dead) {
    float mx = max32(s0, s1); { const auto rr = __builtin_amdgcn_permlane32_swap(__float_as_uint(mx), __float_as_uint(mx), false, false); mx = fmax3(__uint_as_float(rr[0]), __uint_as_float(rr[1]), mx); }
    const float mn = fmaxf(m, mx), alpha = __builtin_amdgcn_exp2f(m - mn), mnd = mn + dead;
    s0 = s0 - mnd; s1 = s1 - mnd;
#pragma unroll
    for (int i = 0; i < 16; ++i) { s0[i] = __builtin_amdgcn_exp2f(s0[i]); s1[i] = __builtin_amdgcn_exp2f(s1[i]); }
    const f32x16 t = s0 + s1;
    float rs = sum16(t); { const auto rr = __builtin_amdgcn_permlane32_swap(__float_as_uint(rs), __float_as_uint(rs), false, false); rs = __uint_as_float(rr[0]) + __uint_as_float(rr[1]); }
    l = l * alpha + rs; m = mn;
#pragma unroll
    for (int db = 0; db < ND; ++db) o[db] *= alpha;
}
template <int DH>
DI void qk_tile_c(LAS const char* ksm, const bf16x8* qf, const f32x16& cinit, f32x16& s0, f32x16& s1, int lane) {
    constexpr int KP = (DH + 8) * 2;
    LAS const char* kp = ksm + (lane & 31) * KP + (lane >> 5) * 16;
    s0 = MFMA32(*(LAS const bf16x8*)(kp), qf[0], cinit); s1 = MFMA32(*(LAS const bf16x8*)(kp + 32 * KP), qf[0], cinit);
#pragma unroll
    for (int d0 = 1; d0 < DH / 16; ++d0) {
        const bf16x8 a0 = *(LAS const bf16x8*)(kp + d0 * 32);
        const bf16x8 a1 = *(LAS const bf16x8*)(kp + 32 * KP + d0 * 32);
        s0 = MFMA32(a0, qf[d0], s0); s1 = MFMA32(a1, qf[d0], s1);
    }
}
template <int ND>
DI void softmax_tile_ref(f32x16& s0, f32x16& s1, f32x16* o, float& negm, float& l) {
    float mx = max32(s0, s1); { const auto rr = __builtin_amdgcn_permlane32_swap(__float_as_uint(mx), __float_as_uint(mx), false, false); mx = fmax3(__uint_as_float(rr[0]), __uint_as_float(rr[1]), mx); }
    if (__any(mx > 8.0f)) {
        const float delta = mx > 8.0f ? mx : 0.f, f = __builtin_amdgcn_exp2f(-delta);
        s0 = s0 - delta; s1 = s1 - delta; negm = negm - delta; l *= f;
#pragma unroll
        for (int db = 0; db < ND; ++db) o[db] *= f;
    }
#pragma unroll
    for (int i = 0; i < 16; ++i) { s0[i] = __builtin_amdgcn_exp2f(s0[i]); s1[i] = __builtin_amdgcn_exp2f(s1[i]); }
    const f32x16 t = s0 + s1;
    float rs = sum16(t); { const auto rr = __builtin_amdgcn_permlane32_swap(__float_as_uint(rs), __float_as_uint(rs), false, false); rs = __uint_as_float(rr[0]) + __uint_as_float(rr[1]); }
    l += rs;
}
template <int DH>
DI void load_q_frags(const bf16* qrow, const float* w, float scale, bf16x8* qf, int lane) {
    const int h = lane >> 5;
    v4u raw[DH / 16]; float ss = 0.f;
#pragma unroll
    for (int d0 = 0; d0 < DH / 16; ++d0) { raw[d0] = *(const v4u*)(qrow + 16 * d0 + 8 * h);
        const float a = bflo(raw[d0].x), b = bfhi(raw[d0].x), c = bflo(raw[d0].y), d = bfhi(raw[d0].y), e = bflo(raw[d0].z), f = bfhi(raw[d0].z), g = bflo(raw[d0].w), k = bfhi(raw[d0].w);
        ss += ((a * a + b * b) + (c * c + d * d)) + ((e * e + f * f) + (g * g + k * k)); }
    ss += __shfl_xor(ss, 32);
    const float r = scale / sqrtf(ss * (1.f / DH) + EPS);
#pragma unroll
    for (int d0 = 0; d0 < DH / 16; ++d0) { const f32x4 w0 = *(const f32x4*)(w + 16 * d0 + 8 * h), w1 = *(const f32x4*)(w + 16 * d0 + 8 * h + 4);
        v4u o; o.x = pk2(bflo(raw[d0].x) * r * w0.x, bfhi(raw[d0].x) * r * w0.y); o.y = pk2(bflo(raw[d0].y) * r * w0.z, bfhi(raw[d0].y) * r * w0.w);
        o.z = pk2(bflo(raw[d0].z) * r * w1.x, bfhi(raw[d0].z) * r * w1.y); o.w = pk2(bflo(raw[d0].w) * r * w1.z, bfhi(raw[d0].w) * r * w1.w);
        qf[d0] = __builtin_bit_cast(bf16x8, o); }
}
template <int DH>
DI void tile_gload(const bf16* base, size_t pitch, v4u* regs, int tid) {
    constexpr int CPR = DH / 8;
#pragma unroll
    for (int k = 0; k < DH / 64; ++k) { const int id = tid + NTHR * k, row = id / CPR, ch = id % CPR; regs[k] = *(const v4u*)(base + (size_t)row * pitch + ch * 8); }
}
template <int DH, int PADE>
DI void tile_lstore(LAS char* sm, const v4u* regs, int tid) {
    constexpr int CPR = DH / 8, PB = (DH + PADE) * 2;
#pragma unroll
    for (int k = 0; k < DH / 64; ++k) { const int id = tid + NTHR * k, row = id / CPR, ch = id % CPR; *(LAS v4u*)(sm + row * PB + ch * 16) = regs[k]; }
}
DI float sigmoidf_(float x) { return 1.0f / (1.0f + __expf(-x)); }

DI void nsa_tile_fused(LAS const char* ksm, LAS const char* vsm, const bf16x8* qf, const f32x16& c0, f32x16* o, float& nref, float& l, int lane) {
    constexpr int KP = 144, VP = 192;
    LAS const char* kp = ksm + (lane & 31) * KP + (lane >> 5) * 16;
    const int h = lane >> 5, q4 = (lane & 15) >> 2, p = lane & 3, blk = (lane >> 4) & 1;
    LAS const char* vp = vsm + (4 * h + q4) * VP + (16 * blk) * 2 + 8 * p;
    f32x16 s0 = MFMA32(*(LAS const bf16x8*)(kp), qf[0], c0);
#pragma unroll
    for (int d0 = 1; d0 < 4; ++d0) s0 = MFMA32(*(LAS const bf16x8*)(kp + d0 * 32), qf[d0], s0);
    f32x16 s1 = MFMA32(*(LAS const bf16x8*)(kp + 32 * KP), qf[0], c0);
#pragma unroll
    for (int d0 = 1; d0 < 4; ++d0) s1 = MFMA32(*(LAS const bf16x8*)(kp + 32 * KP + d0 * 32), qf[d0], s1);
#define PV_STEP(S4, PB, DB) { const s16x4 lo = tr_read(vp + (16 * (S4)) * VP + (DB) * 64), hi = tr_read(vp + (16 * (S4) + 8) * VP + (DB) * 64); \
        const bf16x8 va = __builtin_shufflevector(lo, hi, 0, 1, 2, 3, 4, 5, 6, 7); o[DB] = MFMA32(va, PB, o[DB]); }
#pragma unroll
    for (int i = 0; i < 16; ++i) s0[i] = __builtin_amdgcn_exp2f(s0[i]);
    float rs = sum16(s0);
    { const bf16x8 pb0 = pack8a(s0), pb1 = pack8b(s0);
      PV_STEP(0, pb0, 0) PV_STEP(1, pb1, 0) PV_STEP(0, pb0, 1) PV_STEP(1, pb1, 1) }
#pragma unroll
    for (int i = 0; i < 16; ++i) s1[i] = __builtin_amdgcn_exp2f(s1[i]);
    rs += sum16(s1);
    { const bf16x8 pb2 = pack8a(s1), pb3 = pack8b(s1);
      PV_STEP(2, pb2, 0) PV_STEP(3, pb3, 0) PV_STEP(2, pb2, 1) PV_STEP(3, pb3, 1) }
#undef PV_STEP
    { const auto rr = __builtin_amdgcn_permlane32_swap(__float_as_uint(rs), __float_as_uint(rs), false, false); rs = __uint_as_float(rr[0]) + __uint_as_float(rr[1]); }
    l += rs;
    if (__any(l > 65536.0f)) {
        const unsigned e = l > 65536.0f ? (__float_as_uint(l) >> 23) - 127u : 0u;
        const float f = __uint_as_float((127u - e) << 23);
        nref -= (float)e; l *= f; o[0] *= f; o[1] *= f;
    }
}
DI void store_pair16(bf16* rowbase  , v2u a, v2u b, int h) {
    const auto rx = __builtin_amdgcn_permlane32_swap(a.x, b.x, false, false), ry = __builtin_amdgcn_permlane32_swap(a.y, b.y, false, false);
    *(v4u*)(rowbase + 8 * h) = (v4u){(unsigned)rx[0], (unsigned)ry[0], (unsigned)rx[1], (unsigned)ry[1]};
}
constexpr int NSA_K_OFF = 0, NSA_V_OFF = 18432, NSA_IMP_OFF = 43008, NSA_IMP_PITCH = 36, NSA_SEL_OFF = NSA_IMP_OFF + 4 * 64 * NSA_IMP_PITCH * 4, NSA_TOT_OFF = NSA_SEL_OFF + 256;
template <int NQ>
DI void nsa_cmp_branch(LAS const char* ksm, LAS const char* vsm, LAS float* imph, const bf16x8* qf, int tpos, float gate0, LAS char* totp, int lane) {
    constexpr int KP = 144, VP = 192;
    const int h = lane >> 5;
    f32x16 s[NQ];
    qk_tile<64>(ksm, qf, s[0], s[1], lane);
    if (NQ == 4) qk_tile<64>(ksm + 64 * KP, qf, s[NQ - 2], s[NQ - 1], lane);
    const int nmax = tpos >= 31 ? min(126, (tpos - 31) >> 4) : -1;
    float mx = -INFINITY;
    int hh = 4 * h; asm volatile("" : "+v"(hh));
    const int nm = nmax - hh;
#pragma unroll
    for (int q = 0; q < NQ; ++q)
#pragma unroll
        for (int i = 0; i < 16; ++i) { const int c = 32 * q + (i & 3) + 8 * (i >> 2); s[q][i] = (c <= nm) ? s[q][i] : -INFINITY; mx = fmaxf(mx, s[q][i]); }
    { const auto rr = __builtin_amdgcn_permlane32_swap(__float_as_uint(mx), __float_as_uint(mx), false, false); mx = fmaxf(__uint_as_float(rr[0]), __uint_as_float(rr[1])); }
    const float mm = (mx == -INFINITY) ? 0.f : mx;
    float rs = 0.f;
#pragma unroll
    for (int q = 0; q < NQ; ++q) {
#pragma unroll
        for (int i = 0; i < 16; ++i) s[q][i] = __builtin_amdgcn_exp2f(s[q][i] - mm);
        rs += sum16(s[q]); }
    { const auto rr = __builtin_amdgcn_permlane32_swap(__float_as_uint(rs), __float_as_uint(rs), false, false); rs = __uint_as_float(rr[0]) + __uint_as_float(rr[1]); }
    const float inv = rs > 0.f ? 1.0f / rs : 0.f;
    if (NQ == 4) {
        LAS float* ip = imph + h;
#pragma unroll
        for (int G = 0; G < 16; ++G) { const int q = G >> 2, g4 = G & 3;
            const float sum4 = (s[q][4 * g4] + s[q][4 * g4 + 1]) + (s[q][4 * g4 + 2] + s[q][4 * g4 + 3]);
            const float last = s[q][4 * g4 + 3], prev = G ? s[(G - 1) >> 2][4 * ((G - 1) & 3) + 3] : 0.f;
            const auto rr = __builtin_amdgcn_permlane32_swap(__float_as_uint(prev), __float_as_uint(last), false, false);
            const float extra = h ? __uint_as_float(rr[0]) : __uint_as_float(rr[1]);
            ip[2 * G] = (sum4 + extra) * inv; }
    }
    f32x16 oc[2];
#pragma unroll
    for (int i = 0; i < 16; ++i) { oc[0][i] = 0.f; oc[1][i] = 0.f; }
    pv_tile<64, 2>(vsm, s[0], s[1], oc, 0, lane);
    if (NQ == 4) pv_tile<64, 2>(vsm + 64 * VP, s[NQ - 2], s[NQ - 1], oc, 0, lane);
    const float f = gate0 * inv;
#pragma unroll
    for (int c = 0; c < 8; ++c) { const f32x16& x = oc[c >> 2]; const int e = 4 * (c & 3); *(LAS f32x4*)(totp + c * 1024) = (f32x4){x[e] * f, x[e + 1] * f, x[e + 2] * f, x[e + 3] * f}; }
}
template <int MODE>
DI void nsa_unit(const Ptrs& P, LAS unsigned char* lds, int b, int g, int qi, int tid, int wave, int lane) {
    constexpr int KP = 144, VP = 192;
    const int r = lane & 31, h = lane >> 5;
    const int hd = g * 4 + (wave >> 1), tl = 32 * (wave & 1) + r;
    const size_t tok = (size_t)b * SEQ + 64 * qi + tl;
    const int tpos = 64 * qi + tl;
    LAS char* ksm = (LAS char*)lds + NSA_K_OFF; LAS char* vsm = (LAS char*)lds + NSA_V_OFF;
    LAS float* imp = (LAS float*)(lds + NSA_IMP_OFF); LAS unsigned* selm = (LAS unsigned*)(lds + NSA_SEL_OFF);
    v4u ckr[2], cvr[2];
    { const bf16* kc = P.KCMP + (size_t)(b * 2 + g) * 128 * 64; const bf16* vc = P.VCMP + (size_t)(b * 2 + g) * 128 * 64;
#pragma unroll
      for (int k = 0; k < 2; ++k) { const int id = tid + NTHR * k, row = id >> 3, ch = id & 7; ckr[k] = *(const v4u*)(kc + row * 64 + ch * 8); cvr[k] = *(const v4u*)(vc + row * 64 + ch * 8); } }
    const bf16* kvbase = P.PROJ + (size_t)b * SEQ * INP + g * 64;
    v4u kreg[1], vreg[1];
    tile_gload<64>(kvbase + C_KS, INP, kreg, tid); tile_gload<64>(kvbase + C_VS, INP, vreg, tid);
    bf16x8 qf[4];
    load_q_frags<64>(P.PROJ + tok * INP + C_Q + hd * 64, P.q_norm_w, 0.125f * LOG2E, qf, lane);
    float gate[3];
#pragma unroll
    for (int br = 0; br < 3; ++br) gate[br] = sigmoidf_(bf2f(P.PROJ[tok * INP + C_G + hd * 3 + br]));
    LAS char* totp = (LAS char*)lds + NSA_TOT_OFF + (wave * 512 + lane) * 16;

    __syncthreads();
    {
#pragma unroll
        for (int k = 0; k < 2; ++k) { const int id = tid + NTHR * k, row = id >> 3, ch = id & 7;
            *(LAS v4u*)(ksm + row * KP + ch * 16) = ckr[k]; *(LAS v4u*)(vsm + row * VP + ch * 16) = cvr[k]; }
    }
    __syncthreads();
    if (qi >= 16) nsa_cmp_branch<4>(ksm, vsm, imp + ((wave >> 1) * 64 + tl) * NSA_IMP_PITCH, qf, tpos, gate[0], totp, lane);
    else nsa_cmp_branch<2>(ksm, vsm, imp, qf, tpos, gate[0], totp, lane);
    __syncthreads();
    {
        const int tk = tid >> 3, sub = tid & 7;
        unsigned bits;
        if (qi >= 16) {
            float v[32];
#pragma unroll
            for (int c = 0; c < 8; ++c) { LAS const float* ip = imp + tk * NSA_IMP_PITCH + 4 * c;
                const f32x4 a = *(LAS const f32x4*)ip, b2 = *(LAS const f32x4*)(ip + 64 * NSA_IMP_PITCH), c2 = *(LAS const f32x4*)(ip + 128 * NSA_IMP_PITCH), d2 = *(LAS const f32x4*)(ip + 192 * NSA_IMP_PITCH);
                const f32x4 t = (a + b2) + (c2 + d2);
#pragma unroll
                for (int e = 0; e < 4; ++e) { const int j2 = 4 * c + e; v[j2] = (j2 >= 1 && j2 <= qi - 2) ? t[e] : -1.0f; } }
            bits = 0u;
#pragma unroll
            for (int k = 0; k < 4; ++k) { const int j = sub + 8 * k;
                float vj = v[8 * k];
#pragma unroll
                for (int t = 1; t < 8; ++t) vj = (sub == t) ? v[8 * k + t] : vj;
                int rank = 0;
#pragma unroll
                for (int j2 = 0; j2 < 32; ++j2) {
                    if ((j2 >> 3) < k) rank += (v[j2] >= vj) ? 1 : 0;
                    else if ((j2 >> 3) > k) rank += (v[j2] > vj) ? 1 : 0;
                    else rank += (v[j2] > vj || (v[j2] == vj && (j2 & 7) < sub)) ? 1 : 0; }
                if (j >= 1 && j <= qi - 2 && rank < 13) bits |= 1u << j; }
            bits |= __shfl_xor(bits, 1); bits |= __shfl_xor(bits, 2); bits |= __shfl_xor(bits, 4);
            bits |= 1u | (1u << qi) | (1u << (qi - 1));
        } else bits = (2u << qi) - 1u;
        if (sub == 0) selm[tk] = bits;
    }
    const int nsel = qi + 1, nwin = min(9, qi + 1), ntiles = nsel + nwin;
    f32x16 o[2]; float l = 0.f, nref = 0.f;
#pragma unroll
    for (int i = 0; i < 16; ++i) { o[0][i] = 0.f; o[1][i] = 0.f; }
    unsigned mysel = 0u;
    for (int tt = 0; tt < (MODE >= 5 ? 0 : ntiles); ++tt) {
        if (MODE != 2 || tt == 0) {
        __syncthreads();
        tile_lstore<64, 8>(ksm, kreg, tid); tile_lstore<64, 32>(vsm, vreg, tid);
        __syncthreads(); }
        if (tt == 0) mysel = selm[tl];
        if (MODE != 2 && tt + 1 < ntiles) { const int t2 = tt + 1; const bool w2 = t2 >= nsel; const int j2 = w2 ? qi - (t2 - nsel) : t2;
            tile_gload<64>(kvbase + (size_t)j2 * 64 * INP + (w2 ? C_KW : C_KS), INP, kreg, tid);
            tile_gload<64>(kvbase + (size_t)j2 * 64 * INP + (w2 ? C_VW : C_VS), INP, vreg, tid); }
        const bool win = tt >= nsel; const int j = win ? qi - (tt - nsel) : tt;
        if (tt == nsel) {
            const float f = l > 0.f ? gate[1] / l : 0.f;
#pragma unroll
            for (int c = 0; c < 8; ++c) { const f32x16& x = o[c >> 2]; const int e = 4 * (c & 3); LAS f32x4* tp = (LAS f32x4*)(totp + c * 1024); *tp = *tp + (f32x4){x[e] * f, x[e + 1] * f, x[e + 2] * f, x[e + 3] * f}; }
#pragma unroll
            for (int i = 0; i < 16; ++i) { o[0][i] = 0.f; o[1][i] = 0.f; }
            l = 0.f; nref = 0.f;
        }
        if (MODE == 1) continue;
        const bool dead = !win && !((mysel >> j) & 1u);
        f32x16 c0;
        { const float cv = dead ? -INFINITY : nref;
#pragma unroll
          for (int i = 0; i < 16; ++i) c0[i] = cv; }
        if (j == qi || (win && j == qi - 8)) {
            f32x16 s0, s1;
            qk_tile_c<64>(ksm, qf, c0, s0, s1, lane);
            int klo = 0, khi = 63;
            if (j == qi) khi = tl; else klo = tl + 1;
            mask_tile(s0, s1, klo, khi, h);
            softmax_tile_ref<2>(s0, s1, o, nref, l);
            pv_tile<64, 2>(vsm, s0, s1, o, 0, lane);
        } else nsa_tile_fused(ksm, vsm, qf, c0, o, nref, l, lane);
    }
    { const float f = l > 0.f ? gate[2] / l : 0.f;
      bf16* op = P.YMIX + tok * DM + 512 + hd * 64;
      LAS char* stg = (LAS char*)lds + NSA_IMP_OFF + wave * 4608;
#pragma unroll
      for (int c = 0; c < 8; ++c) { const f32x16& x = o[c >> 2]; const int e = 4 * (c & 3); const f32x4 t = *(LAS const f32x4*)(totp + c * 1024) + (f32x4){x[e] * f, x[e + 1] * f, x[e + 2] * f, x[e + 3] * f};
          v2u wv; wv.x = pk2(t[0], t[1]); wv.y = pk2(t[2], t[3]);
          *(LAS v2u*)(stg + r * 144 + (8 * c + 4 * h) * 2) = wv; }
      LDS_WAIT(); asm volatile("" ::: "memory");
      bf16* ob = op - (size_t)r * DM + (lane & 7) * 8;
#pragma unroll
      for (int k = 0; k < 4; ++k) { const int rr = (lane >> 3) + 8 * k; *(v4u*)(ob + (size_t)rr * DM) = *(LAS const v4u*)(stg + rr * 144 + (lane & 7) * 16); } }
}
template <int MODE>
DI void p3_nsa(const Ptrs& P, LAS unsigned char* lds, int vcu, int G, int tid, int wave, int lane) {
    for (int v = vcu; v < 256; v += G) {
        const int bg = v >> 3, s = v & 7;
#pragma unroll 1
        for (int k = 0; k < 4; ++k) { const int qi = (k == 0) ? 24 + ((0x13024567u >> (4 * s)) & 7) : (k == 1) ? 16 + ((0x13025467u >> (4 * s)) & 7) : (k == 2) ? 8 + ((0x10762534u >> (4 * s)) & 7) : s;
            nsa_unit<MODE>(P, lds, bg >> 1, bg & 1, qi, tid, wave, lane); }
    }
}

constexpr int XA_Q_OFF = 0, XA_K_OFF = 67584, XA_V_OFF = 101376, XA_XP_OFF = 138240, XA_XR_OFF = XA_XP_OFF + 16384;
DI void xattn_unit(const Ptrs& P, LAS unsigned char* lds, int b, int hd, int qt, int tid, int wave, int lane) {
    constexpr int KP = 528, VP = 576;
    const int r = lane & 31, h = lane >> 5, rb = wave >> 1, kh = wave & 1;
    const size_t tok0 = (size_t)b * SEQ + 128 * qt;
    LAS char* qsm = (LAS char*)lds + XA_Q_OFF; LAS char* ksm = (LAS char*)lds + XA_K_OFF; LAS char* vsm = (LAS char*)lds + XA_V_OFF;
    LAS const char* qrow = qsm + (32 * rb + r) * KP + h * 16;
    LAS char* xw = (LAS char*)lds + XA_XP_OFF + (wave * 64 + lane) * 16;
    LAS const char* xr0 = (LAS const char*)lds + XA_XP_OFF + (rb * 128 + lane) * 16;
    LAS float* xs = (LAS float*)(lds + XA_XR_OFF);
    const bf16* kb = P.XKV + (size_t)b * MEMT * 2048 + hd * 256; const bf16* vb = kb + 1024;
    v4u kreg[4], vreg[4];
    tile_gload<256>(kb, 2048, kreg, tid); tile_gload<256>(vb, 2048, vreg, tid);
    f32x4 sp0, sp1, sp2, sp3;
    { const float* sp = P.SSP1 + (tok0 + 32 * rb + r) * 16; sp0 = *(const f32x4*)sp; sp1 = *(const f32x4*)(sp + 4); sp2 = *(const f32x4*)(sp + 8); sp3 = *(const f32x4*)(sp + 12); }
    {
        const bf16* qb = P.XQ + tok0 * DM + hd * 256;
        v4u qreg[8];
#pragma unroll
        for (int k = 0; k < 8; ++k) { const int id = tid + NTHR * k, row = id >> 5, ch = id & 31; qreg[k] = *(const v4u*)(qb + (size_t)row * DM + ch * 8); }
        __syncthreads();
#pragma unroll
        for (int k = 0; k < 8; ++k) { const int id = tid + NTHR * k, row = id >> 5, ch = id & 31; *(LAS v4u*)(qsm + row * KP + ch * 16) = qreg[k]; }
    }
    f32x16 o[4]; float nref = 0.f, l = 0.f, cq = 0.f;
#pragma unroll
    for (int db = 0; db < 4; ++db)
#pragma unroll
        for (int i = 0; i < 16; ++i) o[db][i] = 0.f;
    tile_lstore<256, 8>(ksm, kreg, tid); tile_lstore<256, 32>(vsm, vreg, tid);
    tile_gload<256>(kb + (size_t)64 * 2048, 2048, kreg, tid); tile_gload<256>(vb + (size_t)64 * 2048, 2048, vreg, tid);
    __syncthreads();
#pragma unroll 1
    for (int tt = 0; tt < 4; ++tt) {
        if (tt == 0) {
            float ss = 0.f;
#pragma unroll
            for (int d0 = 0; d0 < 16; ++d0) { const v4u u = *(LAS const v4u*)(qrow + d0 * 32);
                const float a = bflo(u.x), b2 = bfhi(u.x), c = bflo(u.y), d = bfhi(u.y), e = bflo(u.z), f = bfhi(u.z), g = bflo(u.w), k = bfhi(u.w);
                ss += ((a * a + b2 * b2) + (c * c + d * d)) + ((e * e + f * f) + (g * g + k * k)); }
            ss += __shfl_xor(ss, 32);
            const f32x4 p0 = sp0, p1 = sp1, p2 = sp2, p3 = sp3;
            const float rt = 1.0f / sqrtf((((p0.x + p0.y) + (p0.z + p0.w)) + ((p1.x + p1.y) + (p1.z + p1.w)) + ((p2.x + p2.y) + (p2.z + p2.w)) + ((p3.x + p3.y) + (p3.z + p3.w))) * (1.f / DM) + EPS);
            cq = 0.0625f * LOG2E * rt / sqrtf(rt * rt * ss * (1.f / 256.f) + EPS);
        }
        f32x16 s;
        {
            LAS const char* kp = ksm + (32 * kh + r) * KP + h * 16;
#pragma unroll
            for (int i = 0; i < 16; ++i) s[i] = 0.f;
#pragma unroll
            for (int d0 = 0; d0 < 16; ++d0) {
                const bf16x8 a0 = *(LAS const bf16x8*)(kp + d0 * 32), bq = *(LAS const bf16x8*)(qrow + d0 * 32);
                s = MFMA32(a0, bq, s);
                if ((d0 & 3) == 3) __builtin_amdgcn_sched_barrier(0);
            }
        }
        s = s * cq + nref;
#pragma unroll
        for (int i = 0; i < 16; ++i) s[i] = __builtin_amdgcn_exp2f(s[i]);
        { float rs = sum16(s); { const auto rr = __builtin_amdgcn_permlane32_swap(__float_as_uint(rs), __float_as_uint(rs), false, false); rs = __uint_as_float(rr[0]) + __uint_as_float(rr[1]); }
          *(LAS bf16x8*)xw = pack8a(s); *(LAS bf16x8*)(xw + 8192) = pack8b(s); xs[wave * 64 + lane] = rs; }
        __syncthreads();
        if (tt + 1 < 4) {
            tile_lstore<256, 8>(ksm, kreg, tid);
            if (tt + 2 < 4) tile_gload<256>(kb + (size_t)(tt + 2) * 64 * 2048, 2048, kreg, tid);
        }
        {
            const bf16x8 pb0 = *(LAS const bf16x8*)xr0, pb1 = *(LAS const bf16x8*)(xr0 + 8192), pb2 = *(LAS const bf16x8*)(xr0 + 1024), pb3 = *(LAS const bf16x8*)(xr0 + 1024 + 8192);
            l += xs[rb * 128 + lane] + xs[rb * 128 + 64 + lane];
            pv_tile_packed<256, 4>(vsm, pb0, pb1, pb2, pb3, o, 128 * kh, lane);
        }
        if (__any(l > 65536.0f)) {
            const unsigned e = l > 65536.0f ? (__float_as_uint(l) >> 23) - 127u : 0u;
            const float f2 = __uint_as_float((127u - e) << 23);
            nref -= (float)e; l *= f2;
#pragma unroll
            for (int db = 0; db < 4; ++db) o[db] *= f2;
        }
        if (tt + 1 < 4) {
            __syncthreads();
            tile_lstore<256, 32>(vsm, vreg, tid);
            if (tt + 2 < 4) tile_gload<256>(vb + (size_t)(tt + 2) * 64 * 2048, 2048, vreg, tid);
        }
    }
    const float f = 1.0f / l;
    LAS char* stg = (LAS char*)lds + XA_Q_OFF + wave * 8704;
#pragma unroll
    for (int db = 0; db < 4; ++db)
#pragma unroll
        for (int g4 = 0; g4 < 4; ++g4) { v2u wv; wv.x = pk2(o[db][4 * g4] * f, o[db][4 * g4 + 1] * f); wv.y = pk2(o[db][4 * g4 + 2] * f, o[db][4 * g4 + 3] * f);
            *(LAS v2u*)(stg + r * 272 + (32 * db + 8 * g4 + 4 * h) * 2) = wv; }
    LDS_WAIT(); asm volatile("" ::: "memory");
    bf16* ob = P.YMIX + (tok0 + 32 * rb) * DM + hd * 256 + 128 * kh + (lane & 15) * 8;
#pragma unroll
    for (int k = 0; k < 8; ++k) { const int rr = (lane >> 4) + 4 * k; *(v4u*)(ob + (size_t)rr * DM) = *(LAS const v4u*)(stg + rr * 272 + (lane & 15) * 16); }
}
DI void p7_xattn(const Ptrs& P, LAS unsigned char* lds, int bx, int G, int tid, int wave, int lane) {
    pg8::StaticOrder SO; SO.init(NTOK, DM, G, bx); pg8::Unit un;
    int nun = 0; while (SO.next(nun, un)) ++nun;
    for (int ui = nun - 1; ui >= 0; --ui) { SO.next(ui, un);
        const int b = un.pm >> 3, qt0 = (un.pm & 7) * 2;
        xattn_unit(P, lds, b, un.pn, qt0, tid, wave, lane); xattn_unit(P, lds, b, un.pn, qt0 + 1, tid, wave, lane);
    }
}

DI unsigned umax3(unsigned a, unsigned b, unsigned c) { return max(max(a, b), c); }
DI unsigned umax16(const unsigned* k) {
    return umax3(umax3(umax3(k[0], k[1], k[2]), umax3(k[3], k[4], k[5]), umax3(k[6], k[7], k[8])), umax3(umax3(k[9], k[10], k[11]), umax3(k[12], k[13], k[14]), k[15]), 0u);
}
DI unsigned pair_umax(unsigned m) { const auto rr = __builtin_amdgcn_permlane32_swap(m, m, false, false); return max((unsigned)rr[0], (unsigned)rr[1]); }
DI void ce_desc(unsigned& a, unsigned& b) { const unsigned hi = max(a, b), lo = min(a, b); a = hi; b = lo; }
DI void bitonic_sort16_desc(unsigned* k) {
#pragma unroll
    for (int kk = 2; kk <= 16; kk <<= 1)
#pragma unroll
        for (int j = kk >> 1; j > 0; j >>= 1)
#pragma unroll
            for (int i = 0; i < 16; ++i) { const int l = i ^ j; if (l > i) { if ((i & kk) == 0) ce_desc(k[i], k[l]); else ce_desc(k[l], k[i]); } }
}
DI void bitonic_merge16_desc(unsigned* k) {
#pragma unroll
    for (int j = 8; j > 0; j >>= 1)
#pragma unroll
        for (int i = 0; i < 16; ++i) { const int l = i ^ j; if (l > i) ce_desc(k[i], k[l]); }
}
DI void top16_of_two_desc(unsigned* x, const unsigned* y) {
#pragma unroll
    for (int i = 0; i < 16; ++i) x[i] = max(x[i], y[15 - i]);
    bitonic_merge16_desc(x);
}
constexpr int PK_PITCH = 272;
constexpr int PK_SCR_OFF = 2 * 128 * PK_PITCH;
DI void p11_peer_topk(const Ptrs& P, LAS unsigned char* lds, int bx, int G, int tid, int wave, int lane) {
    const int r = lane & 31, h = lane >> 5;
    LAS char* ksm = (LAS char*)lds;
    LAS unsigned* tvl = (LAS unsigned*)(lds + PK_SCR_OFF + wave * 8192);
    LAS float* bsl = (LAS float*)(tvl + 1024); LAS int* bel = (LAS int*)(tvl + 1536);
    pg8::StaticOrder SO; SO.init(NTOK, 2048, G, bx); pg8::Unit un;
    int nun = 0; while (SO.next(nun, un)) ++nun;
    int prev_hd = -1;
    for (int k9 = 0; k9 < nun; ++k9) { const int ui = (nun == 4) ? ((0x0213 >> (4 * k9)) & 3) : nun - 1 - k9; SO.next(ui, un);
        const int hd = un.pn;
        bf16x8 qf0[8];
        { const size_t tokq = (size_t)un.pm * 256 + 32 * wave + r;
#pragma unroll
          for (int d0 = 0; d0 < 8; ++d0) qf0[d0] = *(const bf16x8*)(P.PQ + tokq * 2048 + hd * 256 + 16 * d0 + 8 * h); }
        if (hd != prev_hd) {
        __syncthreads();
        {
            const bf16* kb = P.PKEYS + (size_t)hd * 2 * 128 * 128;
#pragma unroll
            for (int k = 0; k < 8; ++k) { const int id = tid + NTHR * k, row = id >> 4, ch = id & 15; *(LAS v4u*)(ksm + row * PK_PITCH + ch * 16) = *(const v4u*)(kb + row * 128 + ch * 8); }
        }
        __syncthreads();
        prev_hd = hd; }
        {
        const size_t tok = (size_t)un.pm * 256 + 32 * wave + r;
#pragma unroll 1
        for (int c = 0; c < 2; ++c) {
            bf16x8 qf[8];
            if (c == 0) {
#pragma unroll
                for (int d0 = 0; d0 < 8; ++d0) qf[d0] = qf0[d0];
            } else {
#pragma unroll
                for (int d0 = 0; d0 < 8; ++d0) qf[d0] = *(const bf16x8*)(P.PQ + tok * 2048 + hd * 256 + c * 128 + 16 * d0 + 8 * h);
            }
            unsigned key[64];
            unsigned h4 = 4u * (unsigned)h; asm volatile("" : "+v"(h4));
#pragma unroll
            for (int nb = 0; nb < 4; ++nb) {
                f32x16 sc;
#pragma unroll
                for (int i = 0; i < 16; ++i) sc[i] = 64.f;
                LAS const char* kp = ksm + (c * 128 + 32 * nb + r) * PK_PITCH + h * 16;
#pragma unroll
                for (int d0 = 0; d0 < 8; ++d0) sc = MFMA32(*(LAS const bf16x8*)(kp + d0 * 32), qf[d0], sc);
#pragma unroll
                for (int i = 0; i < 16; ++i) key[16 * nb + i] = ((__float_as_uint(sc[i]) & ~0x7Fu) | h4) | (unsigned)(32 * nb + (i & 3) + 8 * (i >> 2));
            }
            bitonic_sort16_desc(key); bitonic_sort16_desc(key + 16); bitonic_sort16_desc(key + 32); bitonic_sort16_desc(key + 48);
            top16_of_two_desc(key, key + 16); top16_of_two_desc(key + 32, key + 48); top16_of_two_desc(key, key + 32);
            unsigned pk[16];
#pragma unroll
            for (int i = 0; i < 16; ++i) { const auto rr = __builtin_amdgcn_permlane32_swap(key[i], key[i], false, false); pk[i] = h ? (unsigned)rr[0] : (unsigned)rr[1]; }
            top16_of_two_desc(key, pk);
            if (h == 0) {
#pragma unroll
                for (int k = 0; k < 16; ++k) tvl[(c * 16 + k) * 32 + r] = key[k]; }
        }
        LDS_WAIT(); asm volatile("" ::: "memory");
        float t0[16], t1[16];
#pragma unroll
        for (int k = 0; k < 16; ++k) { t0[k] = __uint_as_float(tvl[k * 32 + r] & ~0x7Fu); t1[k] = __uint_as_float(tvl[(16 + k) * 32 + r] & ~0x7Fu); }
        unsigned cand[32];
        {
            int n = 0;
#pragma unroll
            for (int a = 0; a < 16; ++a)
#pragma unroll
                for (int b = 0; b < 16; ++b)
                    if ((a + 1) * (b + 1) <= 16) {
                        const unsigned key = (__float_as_uint(t0[a] + t1[b]) & ~0xFFu) | (unsigned)(a * 16 + b);
                        if ((n & 1) == 0) cand[n >> 1] = key; else cand[n >> 1] = h ? key : cand[n >> 1];
                        ++n;
                    }
#pragma unroll
            for (int q = 25; q < 32; ++q) cand[q] = 0u;
        }
        bitonic_sort16_desc(cand); bitonic_sort16_desc(cand + 16); top16_of_two_desc(cand, cand + 16);
        { unsigned pk[16];
#pragma unroll
          for (int i = 0; i < 16; ++i) { const auto rr = __builtin_amdgcn_permlane32_swap(cand[i], cand[i], false, false); pk[i] = h ? (unsigned)rr[0] : (unsigned)rr[1]; }
          top16_of_two_desc(cand, pk); }
        if (h == 0) {
            float bs[16]; int be[16];
#pragma unroll
            for (int k = 0; k < 16; ++k) { const unsigned w = cand[k]; const int ia = (int)((w >> 4) & 15u), ib = (int)(w & 15u);
                const int e0 = (int)(tvl[ia * 32 + r] & 0x7Fu), e1 = (int)(tvl[(16 + ib) * 32 + r] & 0x7Fu);
                bs[k] = __uint_as_float(w & ~0xFFu); be[k] = e0 * 128 + e1; }
            const float* sp = P.SSP2 + tok * 16; const f32x4 p0 = *(const f32x4*)sp, p1 = *(const f32x4*)(sp + 4), p2 = *(const f32x4*)(sp + 8), p3 = *(const f32x4*)(sp + 12);
            const float rt = 1.0f / sqrtf((((p0.x + p0.y) + (p0.z + p0.w)) + ((p1.x + p1.y) + (p1.z + p1.w)) + ((p2.x + p2.y) + (p2.z + p2.w)) + ((p3.x + p3.y) + (p3.z + p3.w))) * (1.f / DM) + EPS);
            const float mx = bs[0]; float sum = 0.f;
#pragma unroll
            for (int k = 0; k < 16; ++k) { bs[k] = __expf((bs[k] - mx) * rt); sum += bs[k]; }
            const float inv = 1.0f / sum;
            int* ip = P.PIDX + tok * 128 + hd * 16; float* gp = P.PGATE + tok * 128 + hd * 16;
#pragma unroll
            for (int k4 = 0; k4 < 4; ++k4) {
                *(v4u*)(ip + 4 * k4) = (v4u){(unsigned)be[4 * k4], (unsigned)be[4 * k4 + 1], (unsigned)be[4 * k4 + 2], (unsigned)be[4 * k4 + 3]};
                *(f32x4*)(gp + 4 * k4) = (f32x4){bs[4 * k4] * inv, bs[4 * k4 + 1] * inv, bs[4 * k4 + 2] * inv, bs[4 * k4 + 3] * inv};
            }
        }
        LDS_WAIT(); asm volatile("" ::: "memory");
        }
    }
}

template <int CTRL> DI float dpp_mov(float v) { return __uint_as_float((unsigned)__builtin_amdgcn_update_dpp(0, (int)__float_as_uint(v), CTRL, 0xF, 0xF, true)); }
template <int CTRL> DI int dpp_movi(int v) { return __builtin_amdgcn_update_dpp(0, v, CTRL, 0xF, 0xF, true); }
DI int wave_sum_i(int v) {
    v += dpp_movi<0xB1>(v); v += dpp_movi<0x4E>(v); v += dpp_movi<0x141>(v); v += dpp_movi<0x140>(v);
    return (__builtin_amdgcn_readlane(v, 0) + __builtin_amdgcn_readlane(v, 16)) + (__builtin_amdgcn_readlane(v, 32) + __builtin_amdgcn_readlane(v, 48));
}
DI float wave_max_f(float v) {
    v = fmaxf(v, dpp_mov<0xB1>(v)); v = fmaxf(v, dpp_mov<0x4E>(v)); v = fmaxf(v, dpp_mov<0x141>(v)); v = fmaxf(v, dpp_mov<0x140>(v));
    return fmaxf(fmaxf(rlane(v, 0), rlane(v, 16)), fmaxf(rlane(v, 32), rlane(v, 48)));
}
DI float reduce8_classes_f(float a0, float a1, float a2, float a3, float c0, float c1, float c2, float c3, bool b0, bool b1) {
    float xa01 = b0 ? a1 : a0; const float ya01 = b0 ? a0 : a1; xa01 += dpp_mov<0xB1>(ya01);
    float xa23 = b0 ? a3 : a2; const float ya23 = b0 ? a2 : a3; xa23 += dpp_mov<0xB1>(ya23);
    float xc01 = b0 ? c1 : c0; const float yc01 = b0 ? c0 : c1; xc01 += dpp_mov<0xB1>(yc01);
    float xc23 = b0 ? c3 : c2; const float yc23 = b0 ? c2 : c3; xc23 += dpp_mov<0xB1>(yc23);
    float wa = b1 ? xa23 : xa01; const float wa2 = b1 ? xa01 : xa23; wa += dpp_mov<0x4E>(wa2);
    float wc = b1 ? xc23 : xc01; const float wc2 = b1 ? xc01 : xc23; wc += dpp_mov<0x4E>(wc2);
    float w; { const auto r = __builtin_amdgcn_permlane32_swap(__float_as_uint(wa), __float_as_uint(wc), false, false); w = __uint_as_float(r[0]) + __uint_as_float(r[1]); }
    w += dpp_mov<0x124>(w); w += dpp_mov<0x128>(w);
    { const auto r = __builtin_amdgcn_permlane16_swap(__float_as_uint(w), __float_as_uint(w), false, false); w = __uint_as_float(r[0]) + __uint_as_float(r[1]); }
    return w;
}
DI float gelu_as(float v) {
    const float av = fabsf(v), t = __builtin_amdgcn_rcpf(av * 0.2316418882f + 1.0f);
    float q = t * 0.5307027145f + (-0.7265760135f); q = q * t + 0.7107068705f; q = q * t + (-0.142248368f); q = q * t + 0.127414796f; q = q * t;
    const float e = __builtin_amdgcn_exp2f((v * v) * (-0.72134752044f)), m = v * (q * e);
    return v < 0.f ? m : v - m;
}
DI int dot16_i8(const v4u& a, const v4u& b) {
    int c = __builtin_amdgcn_sdot4((int)a.x, (int)b.x, 0, false);
    c = __builtin_amdgcn_sdot4((int)a.y, (int)b.y, c, false); c = __builtin_amdgcn_sdot4((int)a.z, (int)b.z, c, false); c = __builtin_amdgcn_sdot4((int)a.w, (int)b.w, c, false);
    return c;
}
DI void axpy4_u8(float* acc, float a, unsigned u) {
    acc[0] += a * (float)(u & 0xffu); acc[1] += a * (float)((u >> 8) & 0xffu); acc[2] += a * (float)((u >> 16) & 0xffu); acc[3] += a * (float)(u >> 24);
}
DI unsigned quant4(float a, float b, float c, float d, float inv) {
    return ((unsigned)(int)__builtin_rintf(a * inv) & 0xffu) | (((unsigned)(int)__builtin_rintf(b * inv) & 0xffu) << 8) | (((unsigned)(int)__builtin_rintf(c * inv) & 0xffu) << 16) | (((unsigned)(int)__builtin_rintf(d * inv) & 0xffu) << 24);
}
typedef float f32x2 __attribute__((ext_vector_type(2)));
constexpr int PEER_SLICE_SHIFT = 7, PEER_NSLICE = NEXP >> PEER_SLICE_SHIFT;
constexpr int P12_WAVE_LDS = 8192 + 512;
DI void axpy16_fp4(f32x2* acc, float a, const v4u& rw) {
    v2u uq = {rw.z, rw.w};
    asm volatile("" : "+v"(uq.x), "+v"(uq.y) : "v"(a));
    const f32x2 aa = {a, a};
    f32x2 t[4];
    t[0] = __builtin_amdgcn_cvt_scalef32_pk_f32_fp4(uq.x, 1.0f, 0); t[1] = __builtin_amdgcn_cvt_scalef32_pk_f32_fp4(uq.x, 1.0f, 1); t[2] = __builtin_amdgcn_cvt_scalef32_pk_f32_fp4(uq.x, 1.0f, 2); t[3] = __builtin_amdgcn_cvt_scalef32_pk_f32_fp4(uq.x, 1.0f, 3);
    asm volatile("" : "+v"(t[0]), "+v"(t[1]), "+v"(t[2]), "+v"(t[3]));
#pragma unroll
    for (int j = 0; j < 4; ++j) acc[j] = __builtin_elementwise_fma(aa, t[j], acc[j]);
    t[0] = __builtin_amdgcn_cvt_scalef32_pk_f32_fp4(uq.y, 1.0f, 0); t[1] = __builtin_amdgcn_cvt_scalef32_pk_f32_fp4(uq.y, 1.0f, 1); t[2] = __builtin_amdgcn_cvt_scalef32_pk_f32_fp4(uq.y, 1.0f, 2); t[3] = __builtin_amdgcn_cvt_scalef32_pk_f32_fp4(uq.y, 1.0f, 3);
    asm volatile("" : "+v"(t[0]), "+v"(t[1]), "+v"(t[2]), "+v"(t[3]));
#pragma unroll
    for (int j = 0; j < 4; ++j) acc[4 + j] = __builtin_elementwise_fma(aa, t[j], acc[4 + j]);
}
DI int dot16_n4(const v4u& hq, const v4u& dq) {
    int ca, c;
    asm("v_dot8_i32_i4 %0, %1, %2, 0" : "=v"(ca) : "v"(hq.x), "v"(dq.x));
    asm("v_dot8_i32_i4 %0, %1, %2, %3" : "=v"(ca) : "v"(hq.y), "v"(dq.y), "v"(ca));
    ca <<= 4;
    asm("v_dot8_i32_i4 %0, %1, %2, %3" : "=v"(c) : "v"(hq.z), "v"(dq.x), "v"(ca));
    asm("v_dot8_i32_i4 %0, %1, %2, %3" : "=v"(c) : "v"(hq.w), "v"(dq.y), "v"(c));
    return c;
}
template <int Q> DI float mul_quad_bcast(float a, float s) {
    float r; asm("s_nop 1\n\tv_mul_f32_dpp %0, %1, %2 quad_perm:[%3,%3,%3,%3] row_mask:0xf bank_mask:0xf" : "=v"(r) : "v"(a), "v"(s), "n"(Q)); return r;
}
DI unsigned nib_pack8(unsigned v0, unsigned v1) {
    unsigned t0 = (v0 | (v0 >> 4)) & 0x00FF00FFu, t1 = (v1 | (v1 >> 4)) & 0x00FF00FFu;
    t0 = (t0 | (t0 >> 8)) & 0xFFFFu; t1 = (t1 | (t1 >> 8)) & 0xFFFFu;
    return t0 | (t1 << 16);
}
DI void split_ab8(unsigned x0, unsigned x1, unsigned& a, unsigned& b) {
    const unsigned l0 = x0 & 0x0F0F0F0Fu, l1 = x1 & 0x0F0F0F0Fu;
    const unsigned h0 = (((x0 >> 4) & 0x0F0F0F0Fu) + ((x0 >> 3) & 0x01010101u)) & 0x0F0F0F0Fu, h1 = (((x1 >> 4) & 0x0F0F0F0Fu) + ((x1 >> 3) & 0x01010101u)) & 0x0F0F0F0Fu;
    a = nib_pack8(h0, h1); b = nib_pack8(l0, l1);
}
DI float reduce4_classes_f(float p0, float p1, float p2, float p3, bool b0, bool b1) {
    float x01 = b0 ? p1 : p0; const float y01 = b0 ? p0 : p1; x01 += dpp_mov<0xB1>(y01);
    float x23 = b0 ? p3 : p2; const float y23 = b0 ? p2 : p3; x23 += dpp_mov<0xB1>(y23);
    float w = b1 ? x23 : x01; const float w2 = b1 ? x01 : x23; w += dpp_mov<0x4E>(w2);
    w += dpp_mov<0x124>(w); w += dpp_mov<0x128>(w);
    { const auto r = __builtin_amdgcn_permlane16_swap(__float_as_uint(w), __float_as_uint(w), false, false); w = __uint_as_float(r[0]) + __uint_as_float(r[1]); }
    { const auto r = __builtin_amdgcn_permlane32_swap(__float_as_uint(w), __float_as_uint(w), false, false); w = __uint_as_float(r[0]) + __uint_as_float(r[1]); }
    return w;
}
template <int MODE>
DI void p12_peer_gather(const Ptrs& P, LAS unsigned char* lds, const float* obase, float* odst, int gw, int NGW, int wave, int lane) {
    LAS v4u* sorted = (LAS v4u*)(lds + wave * P12_WAVE_LDS); LAS unsigned* hist = (LAS unsigned*)(lds + wave * P12_WAVE_LDS + 8192);
    const bool b0 = (lane & 1) != 0, b1 = (lane & 2) != 0; const int cls = lane & 3;
    const int l16 = 16 * lane, l4 = 1024 + 4 * lane;
    const __amdgpu_buffer_rsrc_t rtab = __builtin_amdgcn_make_buffer_rsrc((void*)P.PDOWN, 0, NEXP * PEER_ROW_BYTES, 0x00020000);
    for (int tg = gw; tg < NTOK / 4; tg += NGW) {
        __syncthreads();
        v4u hq[4]; f32x2 acc[4][8]; float asl[4]; float shv = 0.f;
        int pi0[4], pi1[4]; float pga[4], pgb[4];
#pragma unroll
        for (int u = 0; u < 4; ++u) { const size_t o = ((size_t)tg * 4 + u) * 128 + lane; pi0[u] = P.PIDX[o]; pi1[u] = P.PIDX[o + 64]; pga[u] = P.PGATE[o]; pgb[u] = P.PGATE[o + 64]; }
        v4u hb8g[4]; float shvg[4];
#pragma unroll
        for (int u = 0; u < 4; ++u) { const size_t t = (size_t)tg * 4 + u; hb8g[u] = *(const v4u*)(P.H8 + t * DM + 16 * lane); shvg[u] = P.SHV[t]; }
#pragma unroll
        for (int u = 0; u < 4; ++u) {
            const int i0 = pi0[u], i1 = pi1[u];
            const float ga = pga[u], gb = pgb[u];
            hist[lane] = 0u; hist[64 + lane] = 0u;
            LDS_WAIT(); asm volatile("" ::: "memory");
            const unsigned r0 = __hip_atomic_fetch_add(&hist[i0 >> PEER_SLICE_SHIFT], 1u, __ATOMIC_RELAXED, __HIP_MEMORY_SCOPE_WORKGROUP);
            const unsigned r1 = __hip_atomic_fetch_add(&hist[i1 >> PEER_SLICE_SHIFT], 1u, __ATOMIC_RELAXED, __HIP_MEMORY_SCOPE_WORKGROUP);
            LDS_WAIT(); asm volatile("" ::: "memory");
            const unsigned c0 = hist[2 * lane], c1 = hist[2 * lane + 1]; unsigned incl = c0 + c1;
#pragma unroll
            for (int s2 = 1; s2 < 64; s2 <<= 1) { const unsigned t = __shfl_up(incl, s2); if (lane >= s2) incl += t; }
            const unsigned excl = incl - (c0 + c1);
            LDS_WAIT(); asm volatile("" ::: "memory");
            hist[2 * lane] = excl; hist[2 * lane + 1] = excl + c0;
            LDS_WAIT(); asm volatile("" ::: "memory");
            const unsigned p0 = hist[i0 >> PEER_SLICE_SHIFT] + r0, p1 = hist[i1 >> PEER_SLICE_SHIFT] + r1;
            sorted[u * 128 + p0] = (v4u){__float_as_uint(ga), 0u, (unsigned)i0, 0u};
            sorted[u * 128 + p1] = (v4u){__float_as_uint(gb), 0u, (unsigned)i1, 0u};
            LDS_WAIT(); asm volatile("" ::: "memory");
        }
#pragma unroll
        for (int u = 0; u < 4; ++u) { const size_t t = (size_t)tg * 4 + u;
            const v4u hb8 = hb8g[u];
            shv = (cls == u) ? shvg[u] : shv;
            { unsigned a0, b0v, a1, b1v; split_ab8(hb8.x, hb8.y, a0, b0v); split_ab8(hb8.z, hb8.w, a1, b1v); hq[u] = (v4u){a0, a1, b0v, b1v}; }
            asl[u] = 0.f;
#pragma unroll
            for (int j = 0; j < 8; ++j) acc[u][j] = (f32x2){0.f, 0.f}; }
        v4u rw0[4], rw1[4], rw2[4]; unsigned sc0[4], sc1[4], sc2[4];
#define P12_FETCH(BI, RW, SC) { _Pragma("unroll") for (int k = 0; k < 4; ++k) { const unsigned w0 = (unsigned)__builtin_amdgcn_readfirstlane((int)sorted[k * 128 + (BI)].z) & (MODE == 1 ? 63u : 0xffffffffu); \
        const int ro = (int)(w0 * (unsigned)PEER_ROW_BYTES);               \
        RW[k] = __builtin_bit_cast(v4u, __builtin_amdgcn_raw_buffer_load_b128(rtab, l16, ro, 0)); SC[k] = (unsigned)__builtin_amdgcn_raw_buffer_load_b32(rtab, l4, ro, 0); } }
#define P12_RL(V, L) __uint_as_float((unsigned)__builtin_amdgcn_readlane((int)__float_as_uint(V), (L)))
#define P12_MIX(AS, SCW) ({ float r_; asm("v_fma_mix_f32 %0, %1, %2, 0 op_sel_hi:[0,1,0]" : "=v"(r_) : "s"(AS), "v"(SCW)); r_; })
#define P12_ITER(I, RWX, SCX, RWY, SCY, RWZ, SCZ, F) { const int bi_ = 2 * (I); \
        if (F) P12_FETCH(bi_ + 2, RWZ, SCZ) \
        __builtin_amdgcn_sched_barrier(0); \
        const float gt_ = *(LAS const float*)((LAS const char*)sorted + (cls * 128 + bi_ + (lane >> 5)) * 16); \
        const float w_ = reduce8_classes_f((float)dot16_n4(hq[0], RWX[0]) * __uint_as_float(SCX[0]), (float)dot16_n4(hq[1], RWX[1]) * __uint_as_float(SCX[1]), \
                                           (float)dot16_n4(hq[2], RWX[2]) * __uint_as_float(SCX[2]), (float)dot16_n4(hq[3], RWX[3]) * __uint_as_float(SCX[3]), \
                                           (float)dot16_n4(hq[0], RWY[0]) * __uint_as_float(SCY[0]), (float)dot16_n4(hq[1], RWY[1]) * __uint_as_float(SCY[1]), \
                                           (float)dot16_n4(hq[2], RWY[2]) * __uint_as_float(SCY[2]), (float)dot16_n4(hq[3], RWY[3]) * __uint_as_float(SCY[3]), b0, b1); \
        const float a_ = gelu_as(w_ * shv) * gt_; \
        axpy16_fp4(acc[0], P12_MIX(P12_RL(a_, 0), SCX[0]), RWX[0]); axpy16_fp4(acc[1], P12_MIX(P12_RL(a_, 1), SCX[1]), RWX[1]); \
        axpy16_fp4(acc[2], P12_MIX(P12_RL(a_, 2), SCX[2]), RWX[2]); axpy16_fp4(acc[3], P12_MIX(P12_RL(a_, 3), SCX[3]), RWX[3]); \
        __builtin_amdgcn_sched_barrier(0); \
        if (F) P12_FETCH(bi_ + 3, RWX, SCX) \
        __builtin_amdgcn_sched_barrier(0); \
        axpy16_fp4(acc[0], P12_MIX(P12_RL(a_, 32), SCY[0]), RWY[0]); axpy16_fp4(acc[1], P12_MIX(P12_RL(a_, 33), SCY[1]), RWY[1]); \
        axpy16_fp4(acc[2], P12_MIX(P12_RL(a_, 34), SCY[2]), RWY[2]); axpy16_fp4(acc[3], P12_MIX(P12_RL(a_, 35), SCY[3]), RWY[3]); \
        __builtin_amdgcn_sched_barrier(0); }
        P12_FETCH(0, rw0, sc0) P12_FETCH(1, rw1, sc1)
#pragma unroll 1
        for (int seg = 0; seg < 63; seg += 15) {
            if (seg) __builtin_amdgcn_s_barrier();
            const int send = seg + 15 < 63 ? seg + 15 : 63;
#pragma unroll 1
            for (int it = seg; it < send; it += 3) {
                P12_ITER(it, rw0, sc0, rw1, sc1, rw2, sc2, 1)
                P12_ITER(it + 1, rw2, sc2, rw0, sc0, rw1, sc1, 1)
                P12_ITER(it + 2, rw1, sc1, rw2, sc2, rw0, sc0, 1)
            }
        }
        v2u xr[4][4];
#pragma unroll
        for (int u = 0; u < 4; ++u) { const bf16* xp = P.HN + ((size_t)tg * 4 + u) * DM + 4 * lane;
#pragma unroll
            for (int j = 0; j < 4; ++j) xr[u][j] = *(const v2u*)(xp + 256 * j); }
        P12_ITER(63, rw0, sc0, rw1, sc1, rw2, sc2, 0)
#undef P12_FETCH
#undef P12_RL
#undef P12_MIX
#undef P12_ITER
#pragma unroll
        for (int u = 0; u < 4; ++u) { const size_t t = (size_t)tg * 4 + u;
            float* op = odst + t * DM + 4 * lane;
            const v2u x0 = xr[u][0], x1 = xr[u][1], x2 = xr[u][2], x3 = xr[u][3];
            const float pz = (MODE == 2) ? asl[u] * 1e-30f : 0.f;
            *(f32x4*)(op) = (f32x4){bflo(x0.x) + acc[u][0].x + pz, bfhi(x0.x) + acc[u][0].y, bflo(x0.y) + acc[u][1].x, bfhi(x0.y) + acc[u][1].y};
            *(f32x4*)(op + 256) = (f32x4){bflo(x1.x) + acc[u][2].x, bfhi(x1.x) + acc[u][2].y, bflo(x1.y) + acc[u][3].x, bfhi(x1.y) + acc[u][3].y};
            *(f32x4*)(op + 512) = (f32x4){bflo(x2.x) + acc[u][4].x, bfhi(x2.x) + acc[u][4].y, bflo(x2.y) + acc[u][5].x, bfhi(x2.y) + acc[u][5].y};
            *(f32x4*)(op + 768) = (f32x4){bflo(x3.x) + acc[u][6].x, bfhi(x3.x) + acc[u][6].y, bflo(x3.y) + acc[u][7].x, bfhi(x3.y) + acc[u][7].y}; }
    }
}

struct Args { const float* in[25]; float* out; unsigned char* ws; int ph_lo, ph_hi; };
__global__ void __launch_bounds__(NTHR, 2) layer_fwd(Args args) {
    extern __shared__ __attribute__((aligned(16))) unsigned char lds_raw[];
    LAS unsigned char* lds = (LAS unsigned char*)lds_raw;
    const int tid = threadIdx.x, lane = tid & 63, wave = __builtin_amdgcn_readfirstlane(tid >> 6);
    const int G = gridDim.x; const int bx = blockIdx.x;
    const int vcu = (G % 8 == 0) ? (bx % 8) * (G / 8) + bx / 8 : bx;
    const int gw = vcu * NWAVES + wave, NGW = G * NWAVES;
    unsigned char* ws = args.ws;
    Ptrs P;
    P.x = args.in[0]; P.mem = args.in[1]; P.mix_norm_w = args.in[2]; P.w_in = args.in[3]; P.conv_w = args.in[4]; P.conv_b = args.in[5]; P.cmp_pe = args.in[6];
    P.cmp_w1 = args.in[7]; P.cmp_w2 = args.in[8]; P.q_norm_w = args.in[9]; P.k_norm_w = args.in[10]; P.w_out = args.in[11]; P.xattn_norm_w = args.in[12];
    P.mem_norm_w = args.in[13]; P.xq = args.in[14]; P.xk = args.in[15]; P.xv = args.in[16]; P.xo = args.in[17]; P.xq_norm_w = args.in[18]; P.xk_norm_w = args.in[19];
    P.ffn_norm_w = args.in[20]; P.peer_wq = args.in[21]; P.peer_keys = args.in[22]; P.peer_down = args.in[23]; P.peer_up = args.in[24];
    P.out = args.out;
    P.WIN = (bf16*)(ws + WS_WIN); P.WOUT = (bf16*)(ws + WS_WOUT); P.XQT = (bf16*)(ws + WS_XQT); P.XKVT = (bf16*)(ws + WS_XKVT); P.XOT = (bf16*)(ws + WS_XOT);
    P.PWQT = (bf16*)(ws + WS_PWQT); P.PKEYS = (bf16*)(ws + WS_PKEYS); P.KCMP = (bf16*)(ws + WS_KCMP); P.VCMP = (bf16*)(ws + WS_VCMP); P.MN = (bf16*)(ws + WS_MN);
    P.XKV = (bf16*)(ws + WS_XKV); P.PDOWN = ws + WS_PDOWN; P.PUP = ws + WS_PUP; P.PSC = (float*)(ws + WS_PSC); P.CW1T = (bf16*)(ws + WS_CW1T); P.SSP1 = (float*)(ws + WS_SSP1); P.SHV = (float*)(ws + WS_SHV); P.SAM = (float*)(ws + WS_SAM); P.SBKV = (float*)(ws + WS_SBKV); P.CMXK = (float*)(ws + WS_CMXK); P.CMXV = (float*)(ws + WS_CMXV); P.SSP2 = (float*)(ws + WS_SSP2); P.SA1 = (float*)(ws + WS_SA1); P.SB1 = (float*)(ws + WS_SB1); P.CMX = (float*)(ws + WS_CMX); P.HN8 = ws + WS_HN; P.WIN8 = ws + WS_WIN; P.H8 = ws + WS_PUP; P.PWQ8 = ws + WS_PWQT; P.SH = (float*)(ws + WS_SH); P.SBQ = (float*)(ws + WS_SBQ); P.CMXQ = (float*)(ws + WS_CMXQ); P.HN = (bf16*)(ws + WS_HN); P.YMIX = (bf16*)(ws + WS_YMIX);
    P.PROJ = (bf16*)(ws + WS_PROJ); P.XQ = (bf16*)(ws + WS_XQ); P.PQ = (bf16*)(ws + WS_PQ); P.B1P = (float*)(ws + WS_B1P); P.PGATE = (float*)(ws + WS_PGATE); P.PIDX = (int*)(ws + WS_PIDX);

    volatile LAS unsigned* MISC = (volatile LAS unsigned*)(lds + MISC_OFF);
    if (tid < 64) MISC[tid] = 0u;
    __syncthreads();
    const int lo = args.ph_lo, hi = args.ph_hi;
    const bool multi = (hi - lo) > 1;
    XcdBarrier bar; bar.bar = (unsigned*)(ws + WS_CTL) + CW_BAR; bar.x = 0; bar.st = MISC + 8;
    if (multi) bar = xcd_barrier_post((unsigned*)(ws + WS_CTL) + CW_BAR, MISC + 8);
#ifndef ONLY_PHASE
#define ONLY_PHASE -1
#endif
#define IN(k) ((ONLY_PHASE < 0 || (k) == ONLY_PHASE) && lo <= (k) && (k) < hi)
#define SEAM(k) do { if (IN(k) && IN((k) + 1)) xcd_barrier(bar); } while (0)

#ifndef REPMASK
#define REPMASK 0
#endif
#ifndef P12_PROBE_MODE
#define P12_PROBE_MODE 0
#endif
#ifndef P3_PROBE_MODE
#define P3_PROBE_MODE 0
#endif
#ifndef P0_PROBE_MASK
#define P0_PROBE_MASK 7
#endif
#define NREP(k) (((REPMASK) >> (k)) & 1 ? 2 : 1)
    float* const dummy = (float*)(ws + WS_PROJ);
    if (IN(0)) { for (int rep = 0; rep < NREP(0); ++rep) { const int pm = (rep + 1 < NREP(0)) ? P0_PROBE_MASK : 7; p0_prologue(P, lds, gw, NGW, wave, lane, 0, pm); if (multi && pm == 7) xcd_barrier(bar); p0_prologue(P, lds, gw, NGW, wave, lane, 1, pm); } } SEAM(0);
    if (IN(1)) { for (int rep = 0; rep < NREP(1); ++rep) {
        { pg8::Gemm g{(const bf16*)P.HN8, (const bf16*)P.WIN8, NTOK, INP, DM / 2}; pg8::ProjOrder S; S.init(NTOK, G, vcu);
          pg8::EpiI8Bf16 E{P.PROJ, INP, P.SA1, P.SB1};
          pg8::gemm_phase<pg8::EpiI8Bf16, pg8::ProjOrder, true, true, true>(lds, g, S, E); }
 }
        asm volatile("s_waitcnt vmcnt(0)" ::: "memory"); __syncthreads();
        for (int mt = vcu >> 1; mt < NTOK / 256; mt += G >> 1) { proj_post_conv(P, mt, (vcu & 1) * 256, wave, lane); if (vcu & 1) proj_post_knorm(P, mt, wave, lane); }
    } SEAM(1);
    if (IN(2)) { for (int rep = 0; rep < NREP(2); ++rep) p2_misc(P, lds, vcu, G, tid, wave, lane, rep == 0); } SEAM(2);
    if (IN(3)) { for (int rep = 0; rep < NREP(3); ++rep) { if (rep + 1 < NREP(3)) p3_nsa<P3_PROBE_MODE>(P, lds, vcu, G, tid, wave, lane); else p3_nsa<0>(P, lds, vcu, G, tid, wave, lane); } } SEAM(3);
    if (IN(4)) { for (int rep = 0; rep < NREP(4); ++rep) { pg8::Gemm g{P.YMIX, P.WOUT, NTOK, DM, DM}; pg8::StaticOrder S; S.init(NTOK, DM, G, bx);
        pg8::EpiResBf16N<false> E{P.x, P.HN, P.SSP1, DM};
        pg8::gemm_phase<pg8::EpiResBf16N<false>, pg8::StaticOrder, true, true>(lds, g, S, E); } } SEAM(4);
    if (IN(6)) { for (int rep = 0; rep < NREP(6); ++rep) { pg8::Gemm g{P.HN, P.XQT, NTOK, DM, DM}; pg8::StaticOrder S; S.init(NTOK, DM, G, bx);
        pg8::EpiBf16<0> E{P.XQ, DM, nullptr, 0, 0, 1.f};
        pg8::gemm_phase<pg8::EpiBf16<0>, pg8::StaticOrder, true, true>(lds, g, S, E); }
        asm volatile("s_waitcnt vmcnt(0)" ::: "memory"); __syncthreads();
        for (int rep = 0; rep < NREP(7); ++rep) p7_xattn(P, lds, bx, G, tid, wave, lane); } SEAM(7);
    if (IN(8)) { for (int rep = 0; rep < NREP(8); ++rep) { pg8::Gemm g{P.YMIX, P.XOT, NTOK, DM, DM}; pg8::StaticOrder S; S.init(NTOK, DM, G, bx);
        pg8::EpiResBf16N<true> E{P.HN, (rep + 1 < NREP(8)) ? (bf16*)dummy : P.HN, P.SSP2, DM};
        pg8::gemm_phase<pg8::EpiResBf16N<true>, pg8::StaticOrder, true, true>(lds, g, S, E); } } SEAM(8);
    if (IN(9)) { for (int rep = 0; rep < NREP(9); ++rep) p9_quant_h(P, gw, NGW, lane); } SEAM(9);
    if (IN(10)) { for (int rep = 0; rep < NREP(10); ++rep) { pg8::Gemm g{(const bf16*)P.H8, (const bf16*)P.PWQ8, NTOK, 2048, DM / 2}; pg8::StaticOrder S; S.init(NTOK, 2048, G, bx);
        pg8::EpiI8Bf16 E{P.PQ, 2048, P.SH, P.SBQ};
        pg8::gemm_phase<pg8::EpiI8Bf16, pg8::StaticOrder, true, true, true>(lds, g, S, E); }
        asm volatile("s_waitcnt vmcnt(0)" ::: "memory"); __syncthreads();
        for (int rep = 0; rep < NREP(11); ++rep) p11_peer_topk(P, lds, bx, G, tid, wave, lane); } SEAM(11);
    if (IN(12)) { for (int rep = 0; rep < NREP(12); ++rep) if (rep + 1 < NREP(12)) p12_peer_gather<P12_PROBE_MODE>(P, lds, P.out, dummy, gw, NGW, wave, lane); else p12_peer_gather<0>(P, lds, P.out, P.out, gw, NGW, wave, lane); }
#undef IN
#undef SEAM
}

#ifndef MK_PER_PHASE
#define MK_PER_PHASE 0
#endif
extern "C" void kernel_launch(void* const* d_in, const int* in_sizes, int n_in, void* d_out, int out_size, void* d_ws, size_t ws_size, hipStream_t stream) {
    static int grid = 0;
    if (grid == 0) {
        if (n_in != 25 || in_sizes[0] != NTOK * DM || out_size != NTOK * DM || ws_size < WS_END) {
            fprintf(stderr, "kernel_launch: unexpected shapes (n_in %d, in0 %d, out %d, ws %zu); nothing launched\n", n_in, n_in > 0 ? in_sizes[0] : -1, out_size, ws_size); grid = -1; return; }
        int dev = 0, cus = 0, per_cu = 0;
        if (hipGetDevice(&dev) != hipSuccess || hipDeviceGetAttribute(&cus, hipDeviceAttributeMultiprocessorCount, dev) != hipSuccess) { grid = -1; return; }
        if (hipFuncSetAttribute((const void*)layer_fwd, hipFuncAttributeMaxDynamicSharedMemorySize, LDS_BYTES) != hipSuccess) { fprintf(stderr, "kernel_launch: hipFuncSetAttribute failed\n"); grid = -1; return; }
        if (hipOccupancyMaxActiveBlocksPerMultiprocessor(&per_cu, (const void*)layer_fwd, NTHR, LDS_BYTES) != hipSuccess || per_cu < 1)
            fprintf(stderr, "kernel_launch: note: occupancy query reports %d workgroups per CU\n", per_cu);
        (void)hipGetLastError();
        grid = cus;
        if (grid != 256) fprintf(stderr, "kernel_launch: note: %d CUs\n", grid);
    }
    if (grid < 0) return;
    if (hipMemsetAsync((char*)d_ws + WS_CTL, 0, CTL_ZERO_BYTES, stream) != hipSuccess) return;
    Args a{};
    for (int i = 0; i < 25; ++i) a.in[i] = (const float*)d_in[i];
    a.out = (float*)d_out; a.ws = (unsigned char*)d_ws;
#if MK_PER_PHASE
    for (int p = 0; p < NPHASE; ++p) { a.ph_lo = p; a.ph_hi = p + 1; hipLaunchKernelGGL(layer_fwd, dim3(grid), dim3(NTHR), LDS_BYTES, stream, a); }
#else
    a.ph_lo = 0; a.ph_hi = NPHASE; hipLaunchKernelGGL(layer_fwd, dim3(grid), dim3(NTHR), LDS_BYTES, stream, a);
#endif
}
```
